# Optimizing an MI355X kernel written in HIP

```python
import jax, jax.numpy as jnp
from jax import lax
import numpy as np

D_MODEL = 1024
BATCH = 8
SEQ = 8192
DEPTH = 1

HEAD_DIM = 64
N_HEADS_DIL = 8
N_HEADS_SB = 8
D_DIL = N_HEADS_DIL * HEAD_DIM
D_SB = N_HEADS_SB * HEAD_DIM
D_MIX = D_DIL + D_SB
DILATION_PATTERNS = ((128, 1), (512, 4), (2048, 16))
SB_BLOCK = 128
N_GROUPS = 4
EXPERTS_PER_GROUP = 8
N_EXPERTS = N_GROUPS * EXPERTS_PER_GROUP
TOP_K = 2
D_FF_EXPERT = D_MODEL // 2
MOE_BLOCK = 128
NORM_EPS = 1e-6

kernel_name = "hymba_dilated_stickbreak_hmoe_block"


def _rmsnorm(x, g):
    xf = x.astype(jnp.float32)
    y = xf * lax.rsqrt(jnp.mean(xf * xf, axis=-1, keepdims=True) + NORM_EPS)
    return (y * g.astype(jnp.float32)).astype(x.dtype)


def _modulate(h, shift, scale):
    return h * (1 + scale[:, None, :]) + shift[:, None, :]


def _alibi_slopes(n_heads):
    return np.array([2.0 ** (-8.0 * (i + 1) / n_heads) for i in range(n_heads)], dtype=np.float32)


def _dilated_window_attention(q, k, v, window, dilation, slopes):
    b, s, h, e = q.shape
    n = window // dilation
    unit = n * dilation
    s_pad = -(-s // unit) * unit
    nb = s_pad // unit
    pad = ((0, 0), (0, s_pad - s), (0, 0), (0, 0))

    def split(t):
        return jnp.pad(t, pad).reshape(b, nb, n, dilation, h, e)

    def with_prev(t):
        prev = jnp.pad(t[:, :-1], ((0, 0), (1, 0), (0, 0), (0, 0), (0, 0), (0, 0)))
        return jnp.concatenate([prev, t], axis=2)

    qb = split(q)
    kc = with_prev(split(k))
    vc = with_prev(split(v)).astype(jnp.float32)
    scores = jnp.einsum('bgidhe,bgjdhe->bgdhij', qb, kc,
                        preferred_element_type=jnp.float32) * (e ** -0.5)
    i_idx = np.arange(n)[:, None]
    j_idx = np.arange(2 * n)[None, :]
    steps = i_idx + n - j_idx
    blk = np.arange(nb)[:, None, None]
    valid = (steps >= 0) & (steps <= n) & (blk * n + j_idx - n >= 0)
    bias = -slopes[:, None, None] * (steps * dilation).astype(np.float32)[None]
    logits = jnp.where(valid[None, :, None, None], scores + jnp.asarray(bias)[None, None, None], -jnp.inf)
    m = jnp.max(logits, axis=-1)
    p = jnp.exp(logits - m[..., None])
    den = jnp.sum(p, axis=-1)
    den_t = den.transpose(0, 1, 4, 2, 3)
    o = jnp.einsum('bgdhij,bgjdhe->bgidhe', p, vc) / den_t[..., None]
    o = o.reshape(b, s_pad, h, e)[:, :s]
    m = m.transpose(0, 1, 4, 2, 3).reshape(b, s_pad, h)[:, :s]
    den = den_t.reshape(b, s_pad, h)[:, :s]
    return o, m, den


def _dilated_mixture(q, k, v):
    slopes = _alibi_slopes(q.shape[2])
    outs, maxes, dens = [], [], []
    for window, dilation in DILATION_PATTERNS:
        o, m, den = _dilated_window_attention(q, k, v, window, dilation, slopes)
        outs.append(o)
        maxes.append(m)
        dens.append(den)
    outs = jnp.stack(outs)
    maxes = jnp.stack(maxes)
    dens = jnp.stack(dens)
    w = dens * jnp.exp(maxes - jnp.max(maxes, axis=0, keepdims=True))
    w = w / jnp.sum(w, axis=0, keepdims=True)
    return jnp.sum(w[..., None] * outs, axis=0).astype(q.dtype)


def _stick_breaking_attention(q, k, v):
    b, s, h, e = q.shape
    nb = s // SB_BLOCK
    qblocks = q.reshape(b, nb, SB_BLOCK, h, e).transpose(1, 0, 2, 3, 4)
    key_pos = jnp.arange(s)
    vf = v.astype(jnp.float32)

    def block(args):
        qb, idx = args
        z = jnp.einsum('bqhe,bshe->bhqs', qb, k, preferred_element_type=jnp.float32) * (e ** -0.5)
        q_pos = idx * SB_BLOCK + jnp.arange(SB_BLOCK)
        causal = key_pos[None, :] < q_pos[:, None]
        log_beta = jax.nn.log_sigmoid(z)
        log_keep = jnp.where(causal, jax.nn.log_sigmoid(-z), 0.0)
        between = lax.cumsum(log_keep, axis=3, reverse=True) - log_keep
        weights = jnp.where(causal, jnp.exp(log_beta + between), 0.0)
        return jnp.einsum('bhqs,bshe->bqhe', weights, vf)

    out = lax.map(block, (qblocks, jnp.arange(nb)))
    return out.transpose(1, 0, 2, 3, 4).reshape(b, s, h, e).astype(q.dtype)


def _hierarchical_moe(h, w_group, w_expert, w_gate, w_up, w_down):
    n, d = h.shape
    group_prob = jax.nn.softmax((h @ w_group).astype(jnp.float32), axis=-1)
    group = jnp.argmax(group_prob, axis=-1)
    group_gate = jnp.take_along_axis(group_prob, group[:, None], axis=1)
    exp_logits = (h @ w_expert).astype(jnp.float32).reshape(n, N_GROUPS, EXPERTS_PER_GROUP)
    exp_logits = jnp.take_along_axis(exp_logits, group[:, None, None], axis=1)[:, 0]
    top_p, top_local = lax.top_k(jax.nn.softmax(exp_logits, axis=-1), TOP_K)
    top_p = top_p / jnp.sum(top_p, axis=-1, keepdims=True)
    weight = (group_gate * top_p).reshape(-1)
    expert = (group[:, None] * EXPERTS_PER_GROUP + top_local).reshape(-1)
    token = jnp.repeat(jnp.arange(n), TOP_K)

    order = jnp.argsort(expert)
    e_sorted = expert[order]
    tok_sorted = token[order]
    w_sorted = weight[order]
    counts = jnp.zeros((N_EXPERTS,), jnp.int32).at[expert].add(1)
    padded = (counts + MOE_BLOCK - 1) // MOE_BLOCK * MOE_BLOCK
    start = jnp.cumsum(counts) - counts
    pad_end = jnp.cumsum(padded)
    pad_start = pad_end - padded
    nk = n * TOP_K
    dest = pad_start[e_sorted] + jnp.arange(nk) - start[e_sorted]
    cap = -(-nk // MOE_BLOCK) * MOE_BLOCK + N_EXPERTS * MOE_BLOCK
    n_blocks = cap // MOE_BLOCK
    buf = jnp.zeros((cap, d), h.dtype).at[dest].set(h[tok_sorted])
    block_expert = jnp.minimum(
        jnp.searchsorted(pad_end, jnp.arange(n_blocks) * MOE_BLOCK, side='right'), N_EXPERTS - 1)

    def expert_block(args):
        xb, e = args
        return (jax.nn.silu(xb @ w_gate[e]) * (xb @ w_up[e])) @ w_down[e]

    y = lax.map(expert_block, (buf.reshape(n_blocks, MOE_BLOCK, d), block_expert)).reshape(cap, d)
    contrib = y[dest] * w_sorted[:, None].astype(y.dtype)
    return jnp.zeros((n, d), y.dtype).at[tok_sorted].add(contrib)


def setup_inputs(seed: int = 0) -> dict:
    key = jax.random.key(seed)
    ks = jax.random.split(key, 16)
    d = D_MODEL

    def nrm(k, shape, std):
        return jax.random.normal(k, shape, jnp.float32) * std

    return {
        "x": nrm(ks[0], (BATCH, SEQ, d), 1.0),
        "c": nrm(ks[1], (BATCH, d), 1.0),
        "w_ada": nrm(ks[2], (DEPTH, d, 6 * d), 0.5 * d ** -0.5),
        "b_ada": nrm(ks[3], (DEPTH, 6 * d), 0.02),
        "g_mix": 1.0 + nrm(ks[4], (DEPTH, d), 0.02),
        "w_in": nrm(ks[5], (DEPTH, d, 3 * D_MIX), d ** -0.5),
        "g_dil_out": 1.0 + nrm(ks[6], (DEPTH, D_DIL), 0.02),
        "g_sb_out": 1.0 + nrm(ks[7], (DEPTH, D_SB), 0.02),
        "w_out": nrm(ks[8], (DEPTH, D_MIX, d), D_MIX ** -0.5),
        "g_ffn": 1.0 + nrm(ks[9], (DEPTH, d), 0.02),
        "w_group": nrm(ks[10], (DEPTH, d, N_GROUPS), d ** -0.5),
        "w_expert": nrm(ks[11], (DEPTH, d, N_EXPERTS), d ** -0.5),
        "w_gate": nrm(ks[12], (DEPTH, N_EXPERTS, d, D_FF_EXPERT), d ** -0.5),
        "w_up": nrm(ks[13], (DEPTH, N_EXPERTS, d, D_FF_EXPERT), d ** -0.5),
        "w_down": nrm(ks[14], (DEPTH, N_EXPERTS, D_FF_EXPERT, d), D_FF_EXPERT ** -0.5),
        "g_final": 1.0 + nrm(ks[15], (d,), 0.02),
    }


def reference(x, c, w_ada, b_ada, g_mix, w_in, g_dil_out, g_sb_out, w_out, g_ffn,
              w_group, w_expert, w_gate, w_up, w_down, g_final):
    b, s, d = x.shape
    cond = jax.nn.silu(c)
    for layer in range(DEPTH):
        mod = cond @ w_ada[layer] + b_ada[layer]
        shift_mix, scale_mix, gate_mix, shift_ffn, scale_ffn, gate_ffn = jnp.split(mod, 6, axis=-1)

        h = _modulate(_rmsnorm(x, g_mix[layer]), shift_mix, scale_mix)
        qkv = h @ w_in[layer]
        q_d, k_d, v_d, q_s, k_s, v_s = jnp.split(
            qkv, [D_DIL, 2 * D_DIL, 3 * D_DIL, 3 * D_DIL + D_SB, 3 * D_DIL + 2 * D_SB], axis=-1)
        heads_d = lambda t: t.reshape(b, s, N_HEADS_DIL, HEAD_DIM)
        heads_s = lambda t: t.reshape(b, s, N_HEADS_SB, HEAD_DIM)
        o_dil = _dilated_mixture(heads_d(q_d), heads_d(k_d), heads_d(v_d)).reshape(b, s, D_DIL)
        o_sb = _stick_breaking_attention(heads_s(q_s), heads_s(k_s), heads_s(v_s)).reshape(b, s, D_SB)
        mixed = jnp.concatenate([_rmsnorm(o_dil, g_dil_out[layer]),
                                 _rmsnorm(o_sb, g_sb_out[layer])], axis=-1)
        x = x + gate_mix[:, None, :] * (mixed @ w_out[layer])

        h2 = _modulate(_rmsnorm(x, g_ffn[layer]), shift_ffn, scale_ffn).reshape(b * s, d)
        y = _hierarchical_moe(h2, w_group[layer], w_expert[layer],
                              w_gate[layer], w_up[layer], w_down[layer]).reshape(b, s, d)
        x = x + gate_ffn[:, None, :] * y
    return _rmsnorm(x, g_final)
```

```cpp
#include <hip/hip_runtime.h>
#include <cstdio>
#include <cstdint>

#ifndef MK_N_LAUNCHES
#define MK_N_LAUNCHES 9
#endif

#define GAS __attribute__((address_space(1)))
#define LAS __attribute__((address_space(3)))
typedef unsigned short bf16;
typedef short bf16x8 __attribute__((ext_vector_type(8)));
typedef float f32x4 __attribute__((ext_vector_type(4)));
typedef float f32x16 __attribute__((ext_vector_type(16)));
typedef unsigned u32x4 __attribute__((ext_vector_type(4)));
typedef unsigned u32x2 __attribute__((ext_vector_type(2)));
typedef int i32x4 __attribute__((ext_vector_type(4)));

constexpr int NB = 8, SEQ = 8192, D = 1024, M = NB * SEQ;
constexpr int HD = 64, NH = 8, DH = 512;
constexpr int NE = 32, EPG = 8, NGRP = 4, DFF = 512;
constexpr float NORM_EPS = 1e-6f;
constexpr float LOG2E = 1.4426950408889634f;
constexpr float C2 = 0.125f * LOG2E;
constexpr int NWAVES = 8, NTHREADS = 512;
constexpr int LIST_CAP = M;
constexpr int MAX_TILES = (2 * M) / 256 + NE;

constexpr size_t MiB = 1u << 20;
constexpr size_t WS_CTL = 0, CTL_ZERO_BYTES = 2 * MiB;
constexpr size_t WS_MOD = 2 * MiB;
constexpr size_t WS_WIN = 4 * MiB;
constexpr size_t WS_WOUT = 10 * MiB;
constexpr size_t WS_WGU = 12 * MiB;
constexpr size_t WS_WD = 76 * MiB;
constexpr size_t WS_LIST = 108 * MiB;
constexpr size_t WS_TOKSLOT = 116 * MiB;
constexpr size_t WS_TOKW = 117 * MiB;
constexpr size_t WS_H = 120 * MiB;
constexpr size_t WS_QKV = 248 * MiB;
constexpr size_t WS_PART = 632 * MiB;
constexpr size_t WS_O = 768 * MiB;
constexpr size_t WS_END = 896 * MiB;
static_assert(WS_QKV + (size_t)MAX_TILES * 256 * 1024 * 2 <= WS_PART && WS_PART + (size_t)MAX_TILES * 256 * 512 * 2 <= WS_O, "overlays");
constexpr int CW_BAR = 4096;
constexpr int CW_CNT = 16384;
constexpr int CW_SSQ = 65536;
static_assert((CW_SSQ + 2 * M) * 4 <= (int)CTL_ZERO_BYTES, "ctl");

constexpr int LDS_MAIN = 147456;
constexpr int MISC_OFF = LDS_MAIN;
constexpr int LDS_BYTES = LDS_MAIN + 1024;

__device__ __forceinline__ float bf2f(bf16 v) { return __uint_as_float((unsigned)v << 16); }
__device__ __forceinline__ unsigned f2bf(float f) { unsigned u = __float_as_uint(f); return (u + 0x7fffu + ((u >> 16) & 1u)) >> 16; }
__device__ __forceinline__ unsigned pk2(float lo, float hi) { return f2bf(lo) | (f2bf(hi) << 16); }
__device__ __forceinline__ float wave_sum(float v) {
#pragma unroll
    for (int o = 1; o < 64; o <<= 1) v += __shfl_xor(v, o);
    return v;
}
__device__ __forceinline__ int crow(int r, int hi) { return (r & 3) + 8 * (r >> 2) + 4 * hi; }
#define MFMA32(a, b, c) __builtin_amdgcn_mfma_f32_32x32x16_bf16((a), (b), (c), 0, 0, 0)

#define XB_TMO      128
#define XB_XCNT(j)  (256  + 64 * (j))
#define XB_XSUB(j)  (1280 + 64 * (j))
#define XB_XGEN(j)  (2304 + 64 * (j))
#define XB_TOP      3328
#define XB_TOPGEN   3392
#define XCD_BAR_WORDS 3456
#define XB_SPIN_CAP (1u << 18)
__device__ __forceinline__ unsigned xb_ld(unsigned* p)              { return __hip_atomic_load(p, __ATOMIC_RELAXED, __HIP_MEMORY_SCOPE_AGENT); }
__device__ __forceinline__ unsigned xb_add(unsigned* p, unsigned v) { return __hip_atomic_fetch_add(p, v, __ATOMIC_RELAXED, __HIP_MEMORY_SCOPE_AGENT); }
__device__ __forceinline__ unsigned xb_xcc_id() { return (unsigned)__builtin_amdgcn_s_getreg((3 << 11) | 20) & 0xFu; }
#define XB_SPIN(cond, bar) do { unsigned _sp = 0; while (cond) { __builtin_amdgcn_s_sleep(1); \
    if ((++_sp & 255u) == 0u) { if (xb_ld(&(bar)[XB_TMO])) break; if (_sp > XB_SPIN_CAP) { atomicAdd(&(bar)[XB_TMO], 1u); break; } } } } while (0)
struct XcdBarrier { unsigned* bar; unsigned x; volatile LAS unsigned* st; };
__device__ __forceinline__ XcdBarrier xcd_barrier_post(unsigned* bar, volatile LAS unsigned* st) {
    XcdBarrier b; b.bar = bar; b.x = xb_xcc_id(); b.st = st;
    if (threadIdx.x == 0) (void)xb_add(&bar[XB_XCNT(b.x)], 1u);
    return b;
}
__device__ __forceinline__ void xcd_barrier_complete(unsigned* bar, unsigned x, unsigned& nloc, unsigned& nx) {
    const unsigned G = gridDim.x * gridDim.y * gridDim.z;
    unsigned sum, cnt, mine, sp = 0u;
    for (;;) {
        sum = 0u; cnt = 0u; mine = 0u;
#pragma unroll
        for (unsigned j = 0; j < 16; ++j) { const unsigned c = xb_ld(&bar[XB_XCNT(j)]); sum += c; cnt += (c > 0u) ? 1u : 0u; mine = (j == x) ? c : mine; }
        if (sum == G) break;
        __builtin_amdgcn_s_sleep(1);
        if ((++sp & 255u) == 0u) { if (xb_ld(&bar[XB_TMO])) break; if (sp > XB_SPIN_CAP) { atomicAdd(&bar[XB_TMO], 1u); break; } }
    }
    nloc = mine > 0u ? mine : 1u; nx = cnt > 0u ? cnt : 1u;
}
__device__ __forceinline__ void xcd_barrier(const XcdBarrier& b) {
    asm volatile("s_waitcnt vmcnt(0)" ::: "memory");
    __syncthreads();
    if (threadIdx.x == 0) {
        unsigned* bar = b.bar;
        __builtin_amdgcn_s_waitcnt(0);
        unsigned nloc = b.st[0], nx = b.st[1];
        if (nloc == 0u) { xcd_barrier_complete(bar, b.x, nloc, nx); b.st[0] = nloc; b.st[1] = nx; }
        const unsigned old = xb_add(&bar[XB_XSUB(b.x)], 1u);
        const unsigned gen = old / nloc;
        if (old + 1u == (gen + 1u) * nloc) {
            __builtin_amdgcn_fence(__ATOMIC_RELEASE, "agent");
            asm volatile("s_waitcnt vmcnt(0)" ::: "memory");
            const unsigned og = xb_add(&bar[XB_TOP], 1u);
            const unsigned tg = og / nx;
            if (og + 1u == (tg + 1u) * nx) xb_add(&bar[XB_TOPGEN], 1u);
            else XB_SPIN(xb_ld(&bar[XB_TOPGEN]) == tg, bar);
            __builtin_amdgcn_fence(__ATOMIC_ACQUIRE, "agent");
            xb_add(&bar[XB_XGEN(b.x)], 1u);
            asm volatile("s_waitcnt vmcnt(0)" ::: "memory");
        } else {
            XB_SPIN(xb_ld(&bar[XB_XGEN(b.x)]) == gen, bar);
            __builtin_amdgcn_fence(__ATOMIC_ACQUIRE, "agent");
            asm volatile("s_waitcnt vmcnt(0)" ::: "memory");
        }
    }
    __syncthreads();
}

struct Frame {
    LAS unsigned char* lds;
    volatile LAS unsigned* MISC;
    unsigned* ctl;
    int tid, lane, wave, vcu, G;
    const float *x, *c, *w_ada, *b_ada, *g_mix, *w_in, *g_dil, *g_sb, *w_out, *g_ffn, *w_group, *w_expert, *w_gate, *w_up, *w_down, *g_final;
    float* out; unsigned char* ws;
    float* mod; bf16 *WinT, *WoutT, *WguT, *WdT, *HB, *QKV, *OB, *HM, *YB;
    int* list; i32x4* tokslot; float* tokw; float* ssq; unsigned* cnt;
};

__device__ __forceinline__ void phase_mod(Frame& F) {
    LAS float* sc = (LAS float*)F.lds;
    LAS float* red = sc + 8192;
    for (int i = F.tid; i < NB * D; i += NTHREADS) { const float v = F.c[i]; sc[i] = v / (1.f + __expf(-v)); }
    __syncthreads();
    for (int unit = blockIdx.x; unit < 96; unit += F.G) {
        const int j = unit * 64 + F.lane;
        float acc[8];
#pragma unroll
        for (int b = 0; b < 8; ++b) acc[b] = 0.f;
        const float* wp = F.w_ada + (size_t)(F.wave * 128) * 6144 + j;
#pragma unroll 8
        for (int kk = 0; kk < 128; ++kk) { const float wv = wp[(size_t)kk * 6144];
#pragma unroll
            for (int b = 0; b < 8; ++b) acc[b] += sc[b * 1024 + F.wave * 128 + kk] * wv; }
#pragma unroll
        for (int b = 0; b < 8; ++b) red[(F.wave * 8 + b) * 64 + F.lane] = acc[b];
        __syncthreads();
        { const int b = F.wave; float s = 0.f;
#pragma unroll
          for (int w = 0; w < 8; ++w) s += red[(w * 8 + b) * 64 + F.lane];
          F.mod[b * 6144 + j] = s + F.b_ada[j]; }
        __syncthreads();
    }
}

template <class RowMap>
__device__ __forceinline__ void transpose_item(const float* W, int K, int N, bf16* WT, RowMap rm, const float* gk, LAS float* scr, int item, int lane) {
    const int nblk = N / 32, kb = item / nblk, nb = item % nblk, k0 = 64 * kb, n0 = 32 * nb;
#pragma unroll 8
    for (int i = 0; i < 32; ++i) { const int kk = 2 * i + (lane >> 5); float v = W[(size_t)(k0 + kk) * N + n0 + (lane & 31)]; if (gk) v *= gk[k0 + kk]; scr[kk * 33 + (lane & 31)] = v; }
    asm volatile("s_waitcnt lgkmcnt(0)" ::: "memory");
    const int c = lane & 7;
#pragma unroll
    for (int j = 0; j < 4; ++j) { const int n = (lane >> 3) + 8 * j; const LAS float* s = scr + (8 * c) * 33 + n;
        u32x4 o; o.x = pk2(s[0 * 33], s[1 * 33]); o.y = pk2(s[2 * 33], s[3 * 33]); o.z = pk2(s[4 * 33], s[5 * 33]); o.w = pk2(s[6 * 33], s[7 * 33]);
        *(u32x4*)(WT + (size_t)rm(n0 + n) * K + k0 + 8 * c) = o; }
    asm volatile("s_waitcnt lgkmcnt(0)" ::: "memory");
}
struct RmId { __device__ __forceinline__ int operator()(int n) const { return n; } };
struct RmGU { int up; __device__ __forceinline__ int operator()(int n) const { return 8 * (n >> 2) + 4 * up + (n & 3); } };

__device__ __forceinline__ void phase_prep(Frame& F) {
    LAS float* scr = (LAS float*)(F.lds + F.wave * 16384);
    const int gw = F.vcu * NWAVES + F.wave, NGW = F.G * NWAVES;
    constexpr int I_IN = 16 * 96, I_OUT = 16 * 32, I_G = 16 * 16, I_D = 8 * 32;
    constexpr int NITEMS = I_IN + I_OUT + NE * (2 * I_G + I_D);
    for (int it = gw; it < NITEMS; it += NGW) {
        int r = it;
        if (r < I_IN) { transpose_item(F.w_in, D, 3 * D, F.WinT, RmId{}, nullptr, scr, r, F.lane); continue; } r -= I_IN;
        if (r < I_OUT) {
            const int kb = r / 32; const float* gk = (kb < 8) ? F.g_dil : (F.g_sb - 512);
            transpose_item(F.w_out, D, D, F.WoutT, RmId{}, gk, scr, r, F.lane); continue; } r -= I_OUT;
        const int e = r / (2 * I_G + I_D); r -= e * (2 * I_G + I_D);
        if (r < I_G) { transpose_item(F.w_gate + (size_t)e * D * DFF, D, DFF, F.WguT + (size_t)e * D * D, RmGU{0}, nullptr, scr, r, F.lane); continue; } r -= I_G;
        if (r < I_G) { transpose_item(F.w_up + (size_t)e * D * DFF, D, DFF, F.WguT + (size_t)e * D * D, RmGU{1}, nullptr, scr, r, F.lane); continue; } r -= I_G;
        transpose_item(F.w_down + (size_t)e * DFF * D, DFF, D, F.WdT + (size_t)e * D * DFF, RmId{}, nullptr, scr, r, F.lane);
    }
    for (int ch = gw; ch < M / 32; ch += NGW) {
        const int b = ch / (SEQ / 32);
        f32x4 gs[4], sh[4];
#pragma unroll
        for (int j = 0; j < 4; ++j) { const int col = 4 * F.lane + 256 * j;
            const f32x4 g = *(const f32x4*)(F.g_mix + col), scl = *(const f32x4*)(F.mod + b * 6144 + 1024 + col); sh[j] = *(const f32x4*)(F.mod + b * 6144 + col);
            gs[j] = g * (scl + 1.0f); }
        for (int rr = 0; rr < 32; ++rr) {
            const size_t m = (size_t)ch * 32 + rr;
            const f32x4* xr = (const f32x4*)(F.x + m * D) + F.lane;
            f32x4 v[4]; float s = 0.f;
#pragma unroll
            for (int j = 0; j < 4; ++j) { v[j] = xr[64 * j]; s += (v[j].x * v[j].x + v[j].y * v[j].y) + (v[j].z * v[j].z + v[j].w * v[j].w); }
            const float rs = 1.0f / sqrtf(wave_sum(s) * (1.f / D) + NORM_EPS);
            unsigned long long* o8 = (unsigned long long*)(F.HB + m * D) + F.lane;
#pragma unroll
            for (int j = 0; j < 4; ++j) { const f32x4 y = v[j] * rs * gs[j] + sh[j];
                o8[64 * j] = (unsigned long long)pk2(y.x, y.y) | ((unsigned long long)pk2(y.z, y.w) << 32); }
        }
    }
}

template <int NI>
__device__ __forceinline__ void sg_mainloop(f32x16 (&acc)[NI][2], const bf16* const (&pa)[2], const bf16* const (&pb)[NI], int kbeg, int kend) {
#pragma unroll 2
    for (int k = kbeg; k < kend; k += 32) {
        bf16x8 a[2][2], b[NI][2];
#pragma unroll
        for (int s = 0; s < 2; ++s) {
#pragma unroll
            for (int mi = 0; mi < 2; ++mi) a[mi][s] = *(const bf16x8*)(pa[mi] + k + 16 * s);
#pragma unroll
            for (int ni = 0; ni < NI; ++ni) b[ni][s] = *(const bf16x8*)(pb[ni] + k + 16 * s);
        }
#pragma unroll
        for (int s = 0; s < 2; ++s)
#pragma unroll
            for (int ni = 0; ni < NI; ++ni)
#pragma unroll
                for (int mi = 0; mi < 2; ++mi) acc[ni][mi] = MFMA32(b[ni][s], a[mi][s], acc[ni][mi]);
    }
}
template <int NI> __device__ __forceinline__ void sg_zero(f32x16 (&acc)[NI][2]) {
#pragma unroll
    for (int ni = 0; ni < NI; ++ni)
#pragma unroll
        for (int mi = 0; mi < 2; ++mi)
#pragma unroll
            for (int i = 0; i < 16; ++i) acc[ni][mi][i] = 0.f;
}

__device__ __forceinline__ void phase_qkv_simple(Frame& F) {
    const int r = F.lane & 31, h = F.lane >> 5, wm = F.wave >> 1, wn = F.wave & 1;
    constexpr int NPN = 3 * D / 128;
    for (int u = F.vcu; u < (M / 256) * NPN; u += F.G) {
        const int pm = u / NPN, pn = u % NPN, m0 = pm * 256 + wm * 64, n0 = pn * 128 + wn * 64;
        const bf16* pa[2] = {F.HB + (size_t)(m0 + r) * D + 8 * h, F.HB + (size_t)(m0 + 32 + r) * D + 8 * h};
        const bf16* pb[2] = {F.WinT + (size_t)(n0 + r) * D + 8 * h, F.WinT + (size_t)(n0 + 32 + r) * D + 8 * h};
        f32x16 acc[2][2]; sg_zero<2>(acc);
        sg_mainloop<2>(acc, pa, pb, 0, D);
#pragma unroll
        for (int ni = 0; ni < 2; ++ni)
#pragma unroll
            for (int mi = 0; mi < 2; ++mi)
#pragma unroll
                for (int g = 0; g < 4; ++g) {
                    const int n = n0 + 32 * ni + 8 * g + 4 * h, t = n >> 9, col = n & 511; const int m = m0 + 32 * mi + r;
                    const float sc = (t == 0 || t == 3) ? C2 : 1.0f;
                    u32x2 w; w.x = pk2(acc[ni][mi][4 * g] * sc, acc[ni][mi][4 * g + 1] * sc); w.y = pk2(acc[ni][mi][4 * g + 2] * sc, acc[ni][mi][4 * g + 3] * sc);
                    *(u32x2*)(F.QKV + (size_t)t * M * DH + (size_t)m * DH + col) = w;
                }
    }
}

__device__ __forceinline__ void load_row64(const bf16* p, float (&q)[64]) {
#pragma unroll
    for (int i = 0; i < 8; ++i) { const u32x4 w = *(const u32x4*)(p + 8 * i);
        q[8 * i + 0] = __uint_as_float(w.x << 16); q[8 * i + 1] = __uint_as_float(w.x & 0xffff0000u); q[8 * i + 2] = __uint_as_float(w.y << 16); q[8 * i + 3] = __uint_as_float(w.y & 0xffff0000u);
        q[8 * i + 4] = __uint_as_float(w.z << 16); q[8 * i + 5] = __uint_as_float(w.z & 0xffff0000u); q[8 * i + 6] = __uint_as_float(w.w << 16); q[8 * i + 7] = __uint_as_float(w.w & 0xffff0000u); }
}
__device__ __forceinline__ float dot_row64(const bf16* p, const float (&q)[64]) {
    float s0 = 0.f, s1 = 0.f;
#pragma unroll
    for (int i = 0; i < 8; ++i) { const u32x4 w = *(const u32x4*)(p + 8 * i);
        s0 += q[8 * i + 0] * __uint_as_float(w.x << 16); s1 += q[8 * i + 1] * __uint_as_float(w.x & 0xffff0000u); s0 += q[8 * i + 2] * __uint_as_float(w.y << 16); s1 += q[8 * i + 3] * __uint_as_float(w.y & 0xffff0000u);
        s0 += q[8 * i + 4] * __uint_as_float(w.z << 16); s1 += q[8 * i + 5] * __uint_as_float(w.z & 0xffff0000u); s0 += q[8 * i + 6] * __uint_as_float(w.w << 16); s1 += q[8 * i + 7] * __uint_as_float(w.w & 0xffff0000u); }
    return s0 + s1;
}
__device__ __forceinline__ void axpy_row64(const bf16* p, float w_, float (&o)[64]) {
#pragma unroll
    for (int i = 0; i < 8; ++i) { const u32x4 w = *(const u32x4*)(p + 8 * i);
        o[8 * i + 0] += w_ * __uint_as_float(w.x << 16); o[8 * i + 1] += w_ * __uint_as_float(w.x & 0xffff0000u); o[8 * i + 2] += w_ * __uint_as_float(w.y << 16); o[8 * i + 3] += w_ * __uint_as_float(w.y & 0xffff0000u);
        o[8 * i + 4] += w_ * __uint_as_float(w.z << 16); o[8 * i + 5] += w_ * __uint_as_float(w.z & 0xffff0000u); o[8 * i + 6] += w_ * __uint_as_float(w.w << 16); o[8 * i + 7] += w_ * __uint_as_float(w.w & 0xffff0000u); }
}
__device__ __forceinline__ void store_o64(bf16* p, const float (&o)[64], float sc, float& ssq) {
    float s = 0.f;
#pragma unroll
    for (int i = 0; i < 8; ++i) { float v[8];
#pragma unroll
        for (int j = 0; j < 8; ++j) { v[j] = o[8 * i + j] * sc; s += v[j] * v[j]; }
        u32x4 w; w.x = pk2(v[0], v[1]); w.y = pk2(v[2], v[3]); w.z = pk2(v[4], v[5]); w.w = pk2(v[6], v[7]); *(u32x4*)(p + 8 * i) = w; }
    ssq = s;
}
__device__ __forceinline__ void phase_attn_naive(Frame& F) {
    const bf16* QD = F.QKV; const bf16* KD = F.QKV + (size_t)M * DH; const bf16* VD = F.QKV + (size_t)2 * M * DH;
    const bf16* QS = F.QKV + (size_t)3 * M * DH; const bf16* KS = F.QKV + (size_t)4 * M * DH; const bf16* VS = F.QKV + (size_t)5 * M * DH;
    const int total = 2 * M * NH;
    for (int idx = blockIdx.x * NTHREADS + F.tid; idx < total; idx += F.G * NTHREADS) {
        const int t = idx % SEQ, hh = (idx / SEQ) % NH, b = (idx / (SEQ * NH)) % NB, type = idx / (SEQ * NH * NB);
        const size_t m = (size_t)b * SEQ + t;
        float q[64], o[64];
#pragma unroll
        for (int i = 0; i < 64; ++i) o[i] = 0.f;
        float ssq = 0.f;
        if (type == 0) {
            load_row64(QD + m * DH + hh * HD, q);
            const float slope2 = exp2f(-(float)(hh + 1)) * LOG2E;
            float mx = -INFINITY, l = 0.f;
            for (int p = 0; p < 3; ++p) {
                const int d = (p == 0) ? 1 : (p == 1) ? 4 : 16;
                for (int j = 0; j <= 128; ++j) {
                    const int pos = t - j * d; if (pos < 0) break;
                    const size_t km = (size_t)b * SEQ + pos;
                    const float s = dot_row64(KD + km * DH + hh * HD, q) - slope2 * (float)(j * d);
                    const float mn = fmaxf(mx, s), f = exp2f(mx - mn), pw = exp2f(s - mn);
                    l = l * f + pw;
#pragma unroll
                    for (int i = 0; i < 64; ++i) o[i] *= f;
                    axpy_row64(VD + km * DH + hh * HD, pw, o);
                    mx = mn;
                }
            }
            store_o64(F.OB + m * D + hh * HD, o, 1.0f / l, ssq);
        } else {
            load_row64(QS + m * DH + hh * HD, q);
            float R = 1.0f;
            for (int s_ = t - 1; s_ >= 0; --s_) {
                const size_t km = (size_t)b * SEQ + s_;
                const float z2 = fminf(dot_row64(KS + km * DH + hh * HD, q), 100.0f);
                const float e = exp2f(z2), cc = 1.0f / (1.0f + e), w_ = e * cc * R;
                axpy_row64(VS + km * DH + hh * HD, w_, o);
                R *= cc;
                if (R < 1e-30f) break;
            }
            store_o64(F.OB + m * D + DH + hh * HD, o, 1.0f, ssq);
        }
        atomicAdd(F.ssq + 2 * m + type, ssq);
    }
}

__device__ __forceinline__ void phase_outproj_simple(Frame& F) {
    const int r = F.lane & 31, h = F.lane >> 5, wm = F.wave >> 1, wn = F.wave & 1;
    constexpr int NPN = D / 128;
    float* x1 = F.out;
    for (int u = F.vcu; u < (M / 256) * NPN; u += F.G) {
        const int pm = u / NPN, pn = u % NPN, m0 = pm * 256 + wm * 64, n0 = pn * 128 + wn * 64;
        const bf16* pa[2] = {F.OB + (size_t)(m0 + r) * D + 8 * h, F.OB + (size_t)(m0 + 32 + r) * D + 8 * h};
        const bf16* pb[2] = {F.WoutT + (size_t)(n0 + r) * D + 8 * h, F.WoutT + (size_t)(n0 + 32 + r) * D + 8 * h};
        float rsd[2], rss[2];
#pragma unroll
        for (int mi = 0; mi < 2; ++mi) { const int m = m0 + 32 * mi + r; rsd[mi] = 1.0f / sqrtf(F.ssq[2 * m] * (1.f / DH) + NORM_EPS); rss[mi] = 1.0f / sqrtf(F.ssq[2 * m + 1] * (1.f / DH) + NORM_EPS); }
        f32x16 acc[2][2]; sg_zero<2>(acc);
        sg_mainloop<2>(acc, pa, pb, 0, DH);
#pragma unroll
        for (int ni = 0; ni < 2; ++ni)
#pragma unroll
            for (int mi = 0; mi < 2; ++mi) acc[ni][mi] = acc[ni][mi] * (rsd[mi] / rss[mi]);
        sg_mainloop<2>(acc, pa, pb, DH, D);
        const int b = m0 / SEQ;
#pragma unroll
        for (int ni = 0; ni < 2; ++ni)
#pragma unroll
            for (int mi = 0; mi < 2; ++mi)
#pragma unroll
                for (int g = 0; g < 4; ++g) {
                    const int n = n0 + 32 * ni + 8 * g + 4 * h; const int m = m0 + 32 * mi + r;
                    const f32x4 gate = *(const f32x4*)(F.mod + b * 6144 + 2048 + n), xv = *(const f32x4*)(F.x + (size_t)m * D + n);
                    f32x4 a; a.x = acc[ni][mi][4 * g]; a.y = acc[ni][mi][4 * g + 1]; a.z = acc[ni][mi][4 * g + 2]; a.w = acc[ni][mi][4 * g + 3];
                    *(f32x4*)(x1 + (size_t)m * D + n) = xv + gate * (a * rss[mi]);
                }
    }
}

__device__ __forceinline__ void phase_router(Frame& F) {
    LAS float* WR = (LAS float*)F.lds;
    for (int i = F.tid; i < D * 36; i += NTHREADS) { const int k = i / 36, c = i % 36; const int slot = ((k >> 8) * 4 + (k & 3)) * 64 + ((k >> 2) & 63);
        WR[slot * 36 + c] = (c < 4) ? F.w_group[k * 4 + c] : F.w_expert[k * 32 + (c - 4)]; }
    __syncthreads();
    const int gw = F.vcu * NWAVES + F.wave, NGW = F.G * NWAVES;
    const float* x1 = F.out;
    for (int ch = gw; ch < M / 32; ch += NGW) {
        const int b = ch / (SEQ / 32);
        f32x4 gs[4], sh[4];
#pragma unroll
        for (int j = 0; j < 4; ++j) { const int col = 4 * F.lane + 256 * j;
            const f32x4 g = *(const f32x4*)(F.g_ffn + col), scl = *(const f32x4*)(F.mod + b * 6144 + 4096 + col); sh[j] = *(const f32x4*)(F.mod + b * 6144 + 3072 + col);
            gs[j] = g * (scl + 1.0f); }
        int my_e1 = 0, my_e2 = 0; float my_w1 = 0.f, my_w2 = 0.f;
        for (int rr = 0; rr < 32; ++rr) {
            const size_t m = (size_t)ch * 32 + rr;
            const f32x4* xr = (const f32x4*)(x1 + m * D) + F.lane;
            f32x4 v[4]; float s = 0.f;
#pragma unroll
            for (int j = 0; j < 4; ++j) { v[j] = xr[64 * j]; s += (v[j].x * v[j].x + v[j].y * v[j].y) + (v[j].z * v[j].z + v[j].w * v[j].w); }
            const float rs = 1.0f / sqrtf(wave_sum(s) * (1.f / D) + NORM_EPS);
            unsigned long long* o8 = (unsigned long long*)(F.HB + m * D) + F.lane;
            float gl[4] = {0.f, 0.f, 0.f, 0.f};
#pragma unroll
            for (int j = 0; j < 4; ++j) { v[j] = v[j] * rs * gs[j] + sh[j];
                o8[64 * j] = (unsigned long long)pk2(v[j].x, v[j].y) | ((unsigned long long)pk2(v[j].z, v[j].w) << 32);
#pragma unroll
                for (int i = 0; i < 4; ++i) { const f32x4 w = *(const LAS f32x4*)(WR + ((j * 4 + i) * 64 + F.lane) * 36); const float hv = v[j][i];
                    gl[0] += hv * w.x; gl[1] += hv * w.y; gl[2] += hv * w.z; gl[3] += hv * w.w; } }
#pragma unroll
            for (int i = 0; i < 4; ++i) gl[i] = wave_sum(gl[i]);
            int grp = 0; float gmax = gl[0];
#pragma unroll
            for (int i = 1; i < 4; ++i) if (gl[i] > gmax) { gmax = gl[i]; grp = i; }
            float gden = 0.f;
#pragma unroll
            for (int i = 0; i < 4; ++i) gden += __expf(gl[i] - gmax);
            const float ggate = 1.0f / gden;
            grp = __builtin_amdgcn_readfirstlane(grp);
            float el[8];
#pragma unroll
            for (int i = 0; i < 8; ++i) el[i] = 0.f;
#pragma unroll
            for (int j = 0; j < 4; ++j)
#pragma unroll
                for (int i = 0; i < 4; ++i) { const LAS float* wp = WR + ((j * 4 + i) * 64 + F.lane) * 36 + 4 + grp * 8; const f32x4 w0 = *(const LAS f32x4*)wp, w1 = *(const LAS f32x4*)(wp + 4); const float hv = v[j][i];
                    el[0] += hv * w0.x; el[1] += hv * w0.y; el[2] += hv * w0.z; el[3] += hv * w0.w; el[4] += hv * w1.x; el[5] += hv * w1.y; el[6] += hv * w1.z; el[7] += hv * w1.w; }
#pragma unroll
            for (int i = 0; i < 8; ++i) el[i] = wave_sum(el[i]);
            int i1 = 0; float l1 = el[0];
#pragma unroll
            for (int i = 1; i < 8; ++i) if (el[i] > l1) { l1 = el[i]; i1 = i; }
            int i2 = -1; float l2 = -INFINITY;
#pragma unroll
            for (int i = 0; i < 8; ++i) if (i != i1 && el[i] > l2) { l2 = el[i]; i2 = i; }
            const float p2 = 1.0f / (1.0f + __expf(l1 - l2)), p1 = 1.0f - p2;
            if (F.lane == rr) { my_e1 = grp * 8 + i1; my_e2 = grp * 8 + i2; my_w1 = ggate * p1; my_w2 = ggate * p2; }
        }
        if (F.lane < 32) {
            const int m = ch * 32 + F.lane;
            const int pos1 = (int)atomicAdd(F.cnt + 64 * my_e1, 1u), pos2 = (int)atomicAdd(F.cnt + 64 * my_e2, 1u);
            F.list[(size_t)my_e1 * LIST_CAP + pos1] = m; F.list[(size_t)my_e2 * LIST_CAP + pos2] = m;
            i32x4 ts; ts.x = my_e1; ts.y = pos1; ts.z = my_e2; ts.w = pos2; F.tokslot[m] = ts;
            F.tokw[2 * m] = my_w1; F.tokw[2 * m + 1] = my_w2;
        }
    }
}

__device__ __forceinline__ void build_tiles(Frame& F) {
    __syncthreads();
    if (F.tid == 0) { unsigned acc = 0; for (int e = 0; e < NE; ++e) { F.MISC[e] = acc; acc += (__hip_atomic_load(F.cnt + 64 * e, __ATOMIC_RELAXED, __HIP_MEMORY_SCOPE_AGENT) + 255u) >> 8; } F.MISC[NE] = acc; }
    __syncthreads();
}
__device__ __forceinline__ int find_expert(Frame& F, int tile) { int e = 0;
#pragma unroll 1
    for (int i = 1; i < NE; ++i) if ((int)F.MISC[i] <= tile) e = i; else break;
    return e; }

__device__ __forceinline__ void phase_moe1_simple(Frame& F) {
    build_tiles(F);
    const int r = F.lane & 31, h = F.lane >> 5, wm = F.wave >> 1, wn = F.wave & 1;
    const int T = (int)F.MISC[NE];
    for (int u = F.vcu; u < T * 8; u += F.G) {
        const int tile = u >> 3, cn = u & 7, e = find_expert(F, tile), jt = tile - (int)F.MISC[e];
        const int cnt = (int)__hip_atomic_load(F.cnt + 64 * e, __ATOMIC_RELAXED, __HIP_MEMORY_SCOPE_AGENT);
        const bf16* pa[2];
#pragma unroll
        for (int mi = 0; mi < 2; ++mi) { const int pos = jt * 256 + wm * 64 + 32 * mi + r; const int tok = (pos < cnt) ? F.list[(size_t)e * LIST_CAP + pos] : 0; pa[mi] = F.HB + (size_t)tok * D + 8 * h; }
        const int j0 = cn * 64 + wn * 32, jj = j0 + r;
        const bf16* Wb = F.WguT + (size_t)e * D * D;
        const bf16* pb[2] = {Wb + (size_t)(8 * (jj >> 2) + (jj & 3)) * D + 8 * h, Wb + (size_t)(8 * (jj >> 2) + 4 + (jj & 3)) * D + 8 * h};
        f32x16 acc[2][2]; sg_zero<2>(acc);
        sg_mainloop<2>(acc, pa, pb, 0, D);
#pragma unroll
        for (int mi = 0; mi < 2; ++mi)
#pragma unroll
            for (int g = 0; g < 4; ++g) {
                const size_t row = (size_t)tile * 256 + wm * 64 + 32 * mi + r; const int col = j0 + 8 * g + 4 * h;
                float hv[4];
#pragma unroll
                for (int i = 0; i < 4; ++i) { const float ga = acc[0][mi][4 * g + i], up = acc[1][mi][4 * g + i]; hv[i] = ga / (1.0f + __expf(-ga)) * up; }
                u32x2 w; w.x = pk2(hv[0], hv[1]); w.y = pk2(hv[2], hv[3]);
                *(u32x2*)(F.HM + row * DFF + col) = w;
            }
    }
}
__device__ __forceinline__ void phase_moe2_simple(Frame& F) {
    build_tiles(F);
    const int r = F.lane & 31, h = F.lane >> 5, wm = F.wave >> 1, wn = F.wave & 1;
    const int T = (int)F.MISC[NE];
    for (int u = F.vcu; u < T * 8; u += F.G) {
        const int tile = u >> 3, pn = u & 7, e = find_expert(F, tile);
        const size_t row0 = (size_t)tile * 256 + wm * 64; const int n0 = pn * 128 + wn * 64;
        const bf16* pa[2] = {F.HM + (row0 + r) * DFF + 8 * h, F.HM + (row0 + 32 + r) * DFF + 8 * h};
        const bf16* Wb = F.WdT + (size_t)e * D * DFF;
        const bf16* pb[2] = {Wb + (size_t)(n0 + r) * DFF + 8 * h, Wb + (size_t)(n0 + 32 + r) * DFF + 8 * h};
        f32x16 acc[2][2]; sg_zero<2>(acc);
        sg_mainloop<2>(acc, pa, pb, 0, DFF);
#pragma unroll
        for (int ni = 0; ni < 2; ++ni)
#pragma unroll
            for (int mi = 0; mi < 2; ++mi)
#pragma unroll
                for (int g = 0; g < 4; ++g) {
                    const size_t row = row0 + 32 * mi + r; const int n = n0 + 32 * ni + 8 * g + 4 * h;
                    u32x2 w; w.x = pk2(acc[ni][mi][4 * g], acc[ni][mi][4 * g + 1]); w.y = pk2(acc[ni][mi][4 * g + 2], acc[ni][mi][4 * g + 3]);
                    *(u32x2*)(F.YB + row * D + n) = w;
                }
    }
}
__device__ __forceinline__ f32x4 ld_bf4(const bf16* p) { const u32x2 w = *(const u32x2*)p; f32x4 r; r.x = __uint_as_float(w.x << 16); r.y = __uint_as_float(w.x & 0xffff0000u); r.z = __uint_as_float(w.y << 16); r.w = __uint_as_float(w.y & 0xffff0000u); return r; }
__device__ __forceinline__ void phase_final(Frame& F) {
    build_tiles(F);
    const int gw = F.vcu * NWAVES + F.wave, NGW = F.G * NWAVES;
    for (int ch = gw; ch < M / 32; ch += NGW) {
        const int b = ch / (SEQ / 32);
        f32x4 gate[4], gf[4];
#pragma unroll
        for (int j = 0; j < 4; ++j) { const int col = 4 * F.lane + 256 * j; gate[j] = *(const f32x4*)(F.mod + b * 6144 + 5120 + col); gf[j] = *(const f32x4*)(F.g_final + col); }
        for (int rr = 0; rr < 32; ++rr) {
            const size_t m = (size_t)ch * 32 + rr;
            const i32x4 ts = F.tokslot[m]; const float w1 = F.tokw[2 * m], w2 = F.tokw[2 * m + 1];
            const size_t ra = (size_t)F.MISC[ts.x] * 256 + ts.y, rb = (size_t)F.MISC[ts.z] * 256 + ts.w;
            f32x4* xr = (f32x4*)(F.out + m * D) + F.lane;
            f32x4 v[4]; float s = 0.f;
#pragma unroll
            for (int j = 0; j < 4; ++j) { const int col = 4 * F.lane + 256 * j;
                const f32x4 ya = ld_bf4(F.YB + ra * D + col), yb = ld_bf4(F.YB + rb * D + col);
                v[j] = xr[64 * j] + gate[j] * (ya * w1 + yb * w2);
                s += (v[j].x * v[j].x + v[j].y * v[j].y) + (v[j].z * v[j].z + v[j].w * v[j].w); }
            const float rs = 1.0f / sqrtf(wave_sum(s) * (1.f / D) + NORM_EPS);
#pragma unroll
            for (int j = 0; j < 4; ++j) xr[64 * j] = v[j] * rs * gf[j];
        }
    }
}

constexpr int N_PHASES = 9;
struct Args { const float* in[16]; float* out; unsigned char* ws; int ph_lo, ph_hi; };
__global__ void __launch_bounds__(NTHREADS, 2) mk_fwd(Args args) {
    extern __shared__ __attribute__((aligned(16))) unsigned char lds[];
    Frame F;
    F.lds = (LAS unsigned char*)lds; F.MISC = (volatile LAS unsigned*)(F.lds + MISC_OFF);
    F.tid = threadIdx.x; F.lane = F.tid & 63; F.wave = __builtin_amdgcn_readfirstlane(F.tid >> 6);
    F.G = gridDim.x; { const int bx = blockIdx.x; F.vcu = (F.G % 8 == 0) ? (bx % 8) * (F.G / 8) + bx / 8 : bx; }
    unsigned char* ws = args.ws; F.ws = ws; F.ctl = (unsigned*)(ws + WS_CTL);
    F.x = args.in[0]; F.c = args.in[1]; F.w_ada = args.in[2]; F.b_ada = args.in[3]; F.g_mix = args.in[4]; F.w_in = args.in[5]; F.g_dil = args.in[6]; F.g_sb = args.in[7];
    F.w_out = args.in[8]; F.g_ffn = args.in[9]; F.w_group = args.in[10]; F.w_expert = args.in[11]; F.w_gate = args.in[12]; F.w_up = args.in[13]; F.w_down = args.in[14]; F.g_final = args.in[15];
    F.out = args.out;
    F.mod = (float*)(ws + WS_MOD); F.WinT = (bf16*)(ws + WS_WIN); F.WoutT = (bf16*)(ws + WS_WOUT); F.WguT = (bf16*)(ws + WS_WGU); F.WdT = (bf16*)(ws + WS_WD);
    F.HB = (bf16*)(ws + WS_H); F.QKV = (bf16*)(ws + WS_QKV); F.OB = (bf16*)(ws + WS_O); F.HM = (bf16*)(ws + WS_PART); F.YB = (bf16*)(ws + WS_QKV);
    F.list = (int*)(ws + WS_LIST); F.tokslot = (i32x4*)(ws + WS_TOKSLOT); F.tokw = (float*)(ws + WS_TOKW); F.ssq = (float*)(F.ctl + CW_SSQ); F.cnt = F.ctl + CW_CNT;
    for (int u = F.tid; u < 64; u += NTHREADS) F.MISC[u] = 0u;
    __syncthreads();
    const int lo = args.ph_lo, hi = args.ph_hi;
    XcdBarrier bar; bar.bar = F.ctl + CW_BAR; bar.x = 0; bar.st = nullptr;
    if (hi - lo > 1) bar = xcd_barrier_post(F.ctl + CW_BAR, F.MISC + 40);
#define IN(k) (lo <= (k) && (k) < hi)
#define SEAM(k) do { if (IN(k) && IN((k) + 1)) xcd_barrier(bar); } while (0)
    if (IN(0)) { phase_mod(F); } SEAM(0);
    if (IN(1)) { phase_prep(F); } SEAM(1);
    if (IN(2)) { phase_qkv_simple(F); } SEAM(2);
    if (IN(3)) { phase_attn_naive(F); } SEAM(3);
    if (IN(4)) { phase_outproj_simple(F); } SEAM(4);
    if (IN(5)) { phase_router(F); } SEAM(5);
    if (IN(6)) { phase_moe1_simple(F); } SEAM(6);
    if (IN(7)) { phase_moe2_simple(F); } SEAM(7);
    if (IN(8)) { phase_final(F); }
#undef IN
#undef SEAM
}

extern "C" void kernel_launch(void* const* d_in, const int* in_sizes, int n_in, void* d_out, int out_size, void* d_ws, size_t ws_size, hipStream_t stream) {
    static int grid = 0;
    if (grid == 0) {
        if (n_in != 16 || in_sizes[0] != M * D || out_size != M * D || ws_size < WS_END) { fprintf(stderr, "kernel_launch: unexpected shapes / workspace (n_in %d, ws %zu)\n", n_in, ws_size); grid = -1; return; }
        int dev = 0, cus = 0;
        if (hipGetDevice(&dev) != hipSuccess || hipDeviceGetAttribute(&cus, hipDeviceAttributeMultiprocessorCount, dev) != hipSuccess) { grid = -1; return; }
        if (hipFuncSetAttribute((const void*)mk_fwd, hipFuncAttributeMaxDynamicSharedMemorySize, LDS_BYTES) != hipSuccess) { fprintf(stderr, "kernel_launch: hipFuncSetAttribute failed\n"); grid = -1; return; }
        int per_cu = 0;
        if (hipOccupancyMaxActiveBlocksPerMultiprocessor(&per_cu, (const void*)mk_fwd, NTHREADS, LDS_BYTES) != hipSuccess || per_cu < 1) fprintf(stderr, "kernel_launch: occupancy query says %d\n", per_cu);
        (void)hipGetLastError();
        grid = cus;
    }
    if (grid < 0) return;
    (void)hipMemsetAsync((char*)d_ws + WS_CTL, 0, CTL_ZERO_BYTES, stream);
    Args a{};
    for (int i = 0; i < 16; ++i) a.in[i] = (const float*)d_in[i];
    a.out = (float*)d_out; a.ws = (unsigned char*)d_ws;
    constexpr int NL = MK_N_LAUNCHES;
    for (int li = 0; li < NL; ++li) {
        a.ph_lo = (NL == N_PHASES) ? li : (li * N_PHASES) / NL; a.ph_hi = (NL == N_PHASES) ? li + 1 : ((li + 1) * N_PHASES) / NL;
        hipLaunchKernelGGL(mk_fwd, dim3(grid), dim3(NTHREADS), LDS_BYTES, stream, a);
    }
}
```

```cpp
#include <hip/hip_runtime.h>
#include <cstdio>
#include <cstdint>

#ifndef MK_N_LAUNCHES
#define MK_N_LAUNCHES 1
#endif

#define GAS __attribute__((address_space(1)))
#define LAS __attribute__((address_space(3)))
typedef unsigned short bf16;
typedef short bf16x8 __attribute__((ext_vector_type(8)));
typedef float f32x4 __attribute__((ext_vector_type(4)));
typedef float f32x16 __attribute__((ext_vector_type(16)));
typedef unsigned u32x4 __attribute__((ext_vector_type(4)));
typedef unsigned u32x2 __attribute__((ext_vector_type(2)));
typedef int i32x4 __attribute__((ext_vector_type(4)));

constexpr int NB = 8, SEQ = 8192, D = 1024, M = NB * SEQ;
constexpr int HD = 64, NH = 8, DH = 512;
constexpr int NE = 32, EPG = 8, NGRP = 4, DFF = 512;
constexpr float NORM_EPS = 1e-6f;
constexpr float LOG2E = 1.4426950408889634f;
constexpr float C2 = 0.125f * LOG2E;
constexpr int NWAVES = 8, NTHREADS = 512;
constexpr int LIST_CAP = M;
constexpr int MAX_TILES = (2 * M) / 256 + NE;

constexpr size_t MiB = 1u << 20;
constexpr size_t WS_CTL = 0, CTL_ZERO_BYTES = 2 * MiB;
constexpr size_t WS_MOD = 2 * MiB;
constexpr size_t WS_WIN = 4 * MiB;
constexpr size_t WS_WOUT = 10 * MiB;
constexpr size_t WS_WGU = 12 * MiB;
constexpr size_t WS_WD = 76 * MiB;
constexpr size_t WS_LIST = 108 * MiB;
constexpr size_t WS_TOKSLOT = 116 * MiB;
constexpr size_t WS_TOKW = 117 * MiB;
constexpr size_t WS_H = 120 * MiB;
constexpr size_t WS_QKV = 248 * MiB;
constexpr size_t WS_PART = 632 * MiB;
constexpr size_t WS_O = 768 * MiB;
constexpr size_t WS_END = 896 * MiB;
static_assert(WS_QKV + (size_t)MAX_TILES * 256 * 1024 * 2 <= WS_PART && WS_PART + (size_t)MAX_TILES * 256 * 512 * 2 <= WS_O, "overlays");
constexpr int CW_BAR = 4096;
constexpr int CW_CNT = 16384;
constexpr int CW_SSQ = 65536;
static_assert((CW_SSQ + 2 * M) * 4 <= (int)CTL_ZERO_BYTES, "ctl");

constexpr int LDS_MAIN = 147456;
constexpr int MISC_OFF = LDS_MAIN;
constexpr int LDS_BYTES = LDS_MAIN + 1024;

__device__ __forceinline__ float bf2f(bf16 v) { return __uint_as_float((unsigned)v << 16); }
__device__ __forceinline__ unsigned f2bf(float f) { unsigned u = __float_as_uint(f); return (u + 0x7fffu + ((u >> 16) & 1u)) >> 16; }
__device__ __forceinline__ unsigned pk2(float lo, float hi) { return f2bf(lo) | (f2bf(hi) << 16); }
__device__ __forceinline__ float wave_sum(float v) {
#pragma unroll
    for (int o = 1; o < 64; o <<= 1) v += __shfl_xor(v, o);
    return v;
}
__device__ __forceinline__ int crow(int r, int hi) { return (r & 3) + 8 * (r >> 2) + 4 * hi; }
#define MFMA32(a, b, c) __builtin_amdgcn_mfma_f32_32x32x16_bf16((a), (b), (c), 0, 0, 0)

#define XB_TMO      128
#define XB_XCNT(j)  (256  + 64 * (j))
#define XB_XSUB(j)  (1280 + 64 * (j))
#define XB_XGEN(j)  (2304 + 64 * (j))
#define XB_TOP      3328
#define XB_TOPGEN   3392
#define XCD_BAR_WORDS 3456
#define XB_SPIN_CAP (1u << 18)
__device__ __forceinline__ unsigned xb_ld(unsigned* p)              { return __hip_atomic_load(p, __ATOMIC_RELAXED, __HIP_MEMORY_SCOPE_AGENT); }
__device__ __forceinline__ unsigned xb_add(unsigned* p, unsigned v) { return __hip_atomic_fetch_add(p, v, __ATOMIC_RELAXED, __HIP_MEMORY_SCOPE_AGENT); }
__device__ __forceinline__ unsigned xb_xcc_id() { return (unsigned)__builtin_amdgcn_s_getreg((3 << 11) | 20) & 0xFu; }
#define XB_SPIN(cond, bar) do { unsigned _sp = 0; while (cond) { __builtin_amdgcn_s_sleep(1); \
    if ((++_sp & 255u) == 0u) { if (xb_ld(&(bar)[XB_TMO])) break; if (_sp > XB_SPIN_CAP) { atomicAdd(&(bar)[XB_TMO], 1u); break; } } } } while (0)
struct XcdBarrier { unsigned* bar; unsigned x; volatile LAS unsigned* st; };
__device__ __forceinline__ XcdBarrier xcd_barrier_post(unsigned* bar, volatile LAS unsigned* st) {
    XcdBarrier b; b.bar = bar; b.x = xb_xcc_id(); b.st = st;
    if (threadIdx.x == 0) (void)xb_add(&bar[XB_XCNT(b.x)], 1u);
    return b;
}
__device__ __forceinline__ void xcd_barrier_complete(unsigned* bar, unsigned x, unsigned& nloc, unsigned& nx) {
    const unsigned G = gridDim.x * gridDim.y * gridDim.z;
    unsigned sum, cnt, mine, sp = 0u;
    for (;;) {
        sum = 0u; cnt = 0u; mine = 0u;
#pragma unroll
        for (unsigned j = 0; j < 16; ++j) { const unsigned c = xb_ld(&bar[XB_XCNT(j)]); sum += c; cnt += (c > 0u) ? 1u : 0u; mine = (j == x) ? c : mine; }
        if (sum == G) break;
        __builtin_amdgcn_s_sleep(1);
        if ((++sp & 255u) == 0u) { if (xb_ld(&bar[XB_TMO])) break; if (sp > XB_SPIN_CAP) { atomicAdd(&bar[XB_TMO], 1u); break; } }
    }
    nloc = mine > 0u ? mine : 1u; nx = cnt > 0u ? cnt : 1u;
}
__device__ __forceinline__ void xcd_barrier(const XcdBarrier& b) {
    asm volatile("s_waitcnt vmcnt(0)" ::: "memory");
    __syncthreads();
    if (threadIdx.x == 0) {
        unsigned* bar = b.bar;
        __builtin_amdgcn_s_waitcnt(0);
        unsigned nloc = b.st[0], nx = b.st[1];
        if (nloc == 0u) { xcd_barrier_complete(bar, b.x, nloc, nx); b.st[0] = nloc; b.st[1] = nx; }
        const unsigned old = xb_add(&bar[XB_XSUB(b.x)], 1u);
        const unsigned gen = old / nloc;
        if (old + 1u == (gen + 1u) * nloc) {
            __builtin_amdgcn_fence(__ATOMIC_RELEASE, "agent");
            asm volatile("s_waitcnt vmcnt(0)" ::: "memory");
            const unsigned og = xb_add(&bar[XB_TOP], 1u);
            const unsigned tg = og / nx;
            if (og + 1u == (tg + 1u) * nx) xb_add(&bar[XB_TOPGEN], 1u);
            else XB_SPIN(xb_ld(&bar[XB_TOPGEN]) == tg, bar);
            __builtin_amdgcn_fence(__ATOMIC_ACQUIRE, "agent");
            xb_add(&bar[XB_XGEN(b.x)], 1u);
            asm volatile("s_waitcnt vmcnt(0)" ::: "memory");
        } else {
            XB_SPIN(xb_ld(&bar[XB_XGEN(b.x)]) == gen, bar);
            __builtin_amdgcn_fence(__ATOMIC_ACQUIRE, "agent");
            asm volatile("s_waitcnt vmcnt(0)" ::: "memory");
        }
    }
    __syncthreads();
}

struct Frame {
    LAS unsigned char* lds;
    volatile LAS unsigned* MISC;
    unsigned* ctl;
    int tid, lane, wave, vcu, G;
    const float *x, *c, *w_ada, *b_ada, *g_mix, *w_in, *g_dil, *g_sb, *w_out, *g_ffn, *w_group, *w_expert, *w_gate, *w_up, *w_down, *g_final;
    float* out; unsigned char* ws;
    float* mod; bf16 *WinT, *WoutT, *WguT, *WdT, *HB, *QKV, *OB, *HM, *YB;
    int* list; i32x4* tokslot; float* tokw; float* ssq; unsigned* cnt;
};

__device__ __forceinline__ void phase_mod(Frame& F) {
    LAS float* sc = (LAS float*)F.lds;
    LAS float* red = sc + 8192;
    for (int i = F.tid; i < NB * D; i += NTHREADS) { const float v = F.c[i]; sc[i] = v / (1.f + __expf(-v)); }
    __syncthreads();
    for (int unit = blockIdx.x; unit < 96; unit += F.G) {
        const int j = unit * 64 + F.lane;
        float acc[8];
#pragma unroll
        for (int b = 0; b < 8; ++b) acc[b] = 0.f;
        const float* wp = F.w_ada + (size_t)(F.wave * 128) * 6144 + j;
#pragma unroll 8
        for (int kk = 0; kk < 128; ++kk) { const float wv = wp[(size_t)kk * 6144];
#pragma unroll
            for (int b = 0; b < 8; ++b) acc[b] += sc[b * 1024 + F.wave * 128 + kk] * wv; }
#pragma unroll
        for (int b = 0; b < 8; ++b) red[(F.wave * 8 + b) * 64 + F.lane] = acc[b];
        __syncthreads();
        { const int b = F.wave; float s = 0.f;
#pragma unroll
          for (int w = 0; w < 8; ++w) s += red[(w * 8 + b) * 64 + F.lane];
          F.mod[b * 6144 + j] = s + F.b_ada[j]; }
        __syncthreads();
    }
}

template <class RowMap>
__device__ __forceinline__ void transpose_item(const float* W, int K, int N, bf16* WT, RowMap rm, const float* gk, LAS float* scr, int item, int lane) {
    const int nblk = N / 32, kb = item / nblk, nb = item % nblk, k0 = 64 * kb, n0 = 32 * nb;
#pragma unroll 8
    for (int i = 0; i < 32; ++i) { const int kk = 2 * i + (lane >> 5); float v = W[(size_t)(k0 + kk) * N + n0 + (lane & 31)]; if (gk) v *= gk[k0 + kk]; scr[kk * 33 + (lane & 31)] = v; }
    asm volatile("s_waitcnt lgkmcnt(0)" ::: "memory");
    const int c = lane & 7;
#pragma unroll
    for (int j = 0; j < 4; ++j) { const int n = (lane >> 3) + 8 * j; const LAS float* s = scr + (8 * c) * 33 + n;
        u32x4 o; o.x = pk2(s[0 * 33], s[1 * 33]); o.y = pk2(s[2 * 33], s[3 * 33]); o.z = pk2(s[4 * 33], s[5 * 33]); o.w = pk2(s[6 * 33], s[7 * 33]);
        *(u32x4*)(WT + (size_t)rm(n0 + n) * K + k0 + 8 * c) = o; }
    asm volatile("s_waitcnt lgkmcnt(0)" ::: "memory");
}
struct RmId { __device__ __forceinline__ int operator()(int n) const { return n; } };
struct RmGU { int up; __device__ __forceinline__ int operator()(int n) const { return 8 * (n >> 2) + 4 * up + (n & 3); } };

__device__ __forceinline__ void phase_prep(Frame& F) {
    LAS float* scr = (LAS float*)(F.lds + F.wave * 16384);
    const int gw = F.vcu * NWAVES + F.wave, NGW = F.G * NWAVES;
    constexpr int I_IN = 16 * 96, I_OUT = 16 * 32, I_G = 16 * 16, I_D = 8 * 32;
    constexpr int NITEMS = I_IN + I_OUT + NE * (2 * I_G + I_D);
    for (int it = gw; it < NITEMS; it += NGW) {
        int r = it;
        if (r < I_IN) { transpose_item(F.w_in, D, 3 * D, F.WinT, RmId{}, nullptr, scr, r, F.lane); continue; } r -= I_IN;
        if (r < I_OUT) {
            const int kb = r / 32; const float* gk = (kb < 8) ? F.g_dil : (F.g_sb - 512);
            transpose_item(F.w_out, D, D, F.WoutT, RmId{}, gk, scr, r, F.lane); continue; } r -= I_OUT;
        const int e = r / (2 * I_G + I_D); r -= e * (2 * I_G + I_D);
        if (r < I_G) { transpose_item(F.w_gate + (size_t)e * D * DFF, D, DFF, F.WguT + (size_t)e * D * D, RmGU{0}, nullptr, scr, r, F.lane); continue; } r -= I_G;
        if (r < I_G) { transpose_item(F.w_up + (size_t)e * D * DFF, D, DFF, F.WguT + (size_t)e * D * D, RmGU{1}, nullptr, scr, r, F.lane); continue; } r -= I_G;
        transpose_item(F.w_down + (size_t)e * DFF * D, DFF, D, F.WdT + (size_t)e * D * DFF, RmId{}, nullptr, scr, r, F.lane);
    }
    for (int ch = gw; ch < M / 32; ch += NGW) {
        const int b = ch / (SEQ / 32);
        f32x4 gs[4], sh[4];
#pragma unroll
        for (int j = 0; j < 4; ++j) { const int col = 4 * F.lane + 256 * j;
            const f32x4 g = *(const f32x4*)(F.g_mix + col), scl = *(const f32x4*)(F.mod + b * 6144 + 1024 + col); sh[j] = *(const f32x4*)(F.mod + b * 6144 + col);
            gs[j] = g * (scl + 1.0f); }
        for (int rr = 0; rr < 32; ++rr) {
            const size_t m = (size_t)ch * 32 + rr;
            const f32x4* xr = (const f32x4*)(F.x + m * D) + F.lane;
            f32x4 v[4]; float s = 0.f;
#pragma unroll
            for (int j = 0; j < 4; ++j) { v[j] = xr[64 * j]; s += (v[j].x * v[j].x + v[j].y * v[j].y) + (v[j].z * v[j].z + v[j].w * v[j].w); }
            const float rs = 1.0f / sqrtf(wave_sum(s) * (1.f / D) + NORM_EPS);
            unsigned long long* o8 = (unsigned long long*)(F.HB + m * D) + F.lane;
#pragma unroll
            for (int j = 0; j < 4; ++j) { const f32x4 y = v[j] * rs * gs[j] + sh[j];
                o8[64 * j] = (unsigned long long)pk2(y.x, y.y) | ((unsigned long long)pk2(y.z, y.w) << 32); }
        }
    }
}

template <int NI>
__device__ __forceinline__ void sg_mainloop(f32x16 (&acc)[NI][2], const bf16* const (&pa)[2], const bf16* const (&pb)[NI], int kbeg, int kend) {
#pragma unroll 2
    for (int k = kbeg; k < kend; k += 32) {
        bf16x8 a[2][2], b[NI][2];
#pragma unroll
        for (int s = 0; s < 2; ++s) {
#pragma unroll
            for (int mi = 0; mi < 2; ++mi) a[mi][s] = *(const bf16x8*)(pa[mi] + k + 16 * s);
#pragma unroll
            for (int ni = 0; ni < NI; ++ni) b[ni][s] = *(const bf16x8*)(pb[ni] + k + 16 * s);
        }
#pragma unroll
        for (int s = 0; s < 2; ++s)
#pragma unroll
            for (int ni = 0; ni < NI; ++ni)
#pragma unroll
                for (int mi = 0; mi < 2; ++mi) acc[ni][mi] = MFMA32(b[ni][s], a[mi][s], acc[ni][mi]);
    }
}
template <int NI> __device__ __forceinline__ void sg_zero(f32x16 (&acc)[NI][2]) {
#pragma unroll
    for (int ni = 0; ni < NI; ++ni)
#pragma unroll
        for (int mi = 0; mi < 2; ++mi)
#pragma unroll
            for (int i = 0; i < 16; ++i) acc[ni][mi][i] = 0.f;
}

__device__ __forceinline__ void phase_qkv_simple(Frame& F) {
    const int r = F.lane & 31, h = F.lane >> 5, wm = F.wave >> 1, wn = F.wave & 1;
    constexpr int NPN = 3 * D / 128;
    for (int u = F.vcu; u < (M / 256) * NPN; u += F.G) {
        const int pm = u / NPN, pn = u % NPN, m0 = pm * 256 + wm * 64, n0 = pn * 128 + wn * 64;
        const bf16* pa[2] = {F.HB + (size_t)(m0 + r) * D + 8 * h, F.HB + (size_t)(m0 + 32 + r) * D + 8 * h};
        const bf16* pb[2] = {F.WinT + (size_t)(n0 + r) * D + 8 * h, F.WinT + (size_t)(n0 + 32 + r) * D + 8 * h};
        f32x16 acc[2][2]; sg_zero<2>(acc);
        sg_mainloop<2>(acc, pa, pb, 0, D);
#pragma unroll
        for (int ni = 0; ni < 2; ++ni)
#pragma unroll
            for (int mi = 0; mi < 2; ++mi)
#pragma unroll
                for (int g = 0; g < 4; ++g) {
                    const int n = n0 + 32 * ni + 8 * g + 4 * h, t = n >> 9, col = n & 511; const int m = m0 + 32 * mi + r;
                    const float sc = (t == 0 || t == 3) ? C2 : 1.0f;
                    u32x2 w; w.x = pk2(acc[ni][mi][4 * g] * sc, acc[ni][mi][4 * g + 1] * sc); w.y = pk2(acc[ni][mi][4 * g + 2] * sc, acc[ni][mi][4 * g + 3] * sc);
                    *(u32x2*)(F.QKV + (size_t)t * M * DH + (size_t)m * DH + col) = w;
                }
    }
}

__device__ __forceinline__ void load_row64(const bf16* p, float (&q)[64]) {
#pragma unroll
    for (int i = 0; i < 8; ++i) { const u32x4 w = *(const u32x4*)(p + 8 * i);
        q[8 * i + 0] = __uint_as_float(w.x << 16); q[8 * i + 1] = __uint_as_float(w.x & 0xffff0000u); q[8 * i + 2] = __uint_as_float(w.y << 16); q[8 * i + 3] = __uint_as_float(w.y & 0xffff0000u);
        q[8 * i + 4] = __uint_as_float(w.z << 16); q[8 * i + 5] = __uint_as_float(w.z & 0xffff0000u); q[8 * i + 6] = __uint_as_float(w.w << 16); q[8 * i + 7] = __uint_as_float(w.w & 0xffff0000u); }
}
__device__ __forceinline__ float dot_row64(const bf16* p, const float (&q)[64]) {
    float s0 = 0.f, s1 = 0.f;
#pragma unroll
    for (int i = 0; i < 8; ++i) { const u32x4 w = *(const u32x4*)(p + 8 * i);
        s0 += q[8 * i + 0] * __uint_as_float(w.x << 16); s1 += q[8 * i + 1] * __uint_as_float(w.x & 0xffff0000u); s0 += q[8 * i + 2] * __uint_as_float(w.y << 16); s1 += q[8 * i + 3] * __uint_as_float(w.y & 0xffff0000u);
        s0 += q[8 * i + 4] * __uint_as_float(w.z << 16); s1 += q[8 * i + 5] * __uint_as_float(w.z & 0xffff0000u); s0 += q[8 * i + 6] * __uint_as_float(w.w << 16); s1 += q[8 * i + 7] * __uint_as_float(w.w & 0xffff0000u); }
    return s0 + s1;
}
__device__ __forceinline__ void axpy_row64(const bf16* p, float w_, float (&o)[64]) {
#pragma unroll
    for (int i = 0; i < 8; ++i) { const u32x4 w = *(const u32x4*)(p + 8 * i);
        o[8 * i + 0] += w_ * __uint_as_float(w.x << 16); o[8 * i + 1] += w_ * __uint_as_float(w.x & 0xffff0000u); o[8 * i + 2] += w_ * __uint_as_float(w.y << 16); o[8 * i + 3] += w_ * __uint_as_float(w.y & 0xffff0000u);
        o[8 * i + 4] += w_ * __uint_as_float(w.z << 16); o[8 * i + 5] += w_ * __uint_as_float(w.z & 0xffff0000u); o[8 * i + 6] += w_ * __uint_as_float(w.w << 16); o[8 * i + 7] += w_ * __uint_as_float(w.w & 0xffff0000u); }
}
__device__ __forceinline__ void store_o64(bf16* p, const float (&o)[64], float sc, float& ssq) {
    float s = 0.f;
#pragma unroll
    for (int i = 0; i < 8; ++i) { float v[8];
#pragma unroll
        for (int j = 0; j < 8; ++j) { v[j] = o[8 * i + j] * sc; s += v[j] * v[j]; }
        u32x4 w; w.x = pk2(v[0], v[1]); w.y = pk2(v[2], v[3]); w.z = pk2(v[4], v[5]); w.w = pk2(v[6], v[7]); *(u32x4*)(p + 8 * i) = w; }
    ssq = s;
}
__device__ __forceinline__ void phase_attn_naive(Frame& F) {
    const bf16* QD = F.QKV; const bf16* KD = F.QKV + (size_t)M * DH; const bf16* VD = F.QKV + (size_t)2 * M * DH;
    const bf16* QS = F.QKV + (size_t)3 * M * DH; const bf16* KS = F.QKV + (size_t)4 * M * DH; const bf16* VS = F.QKV + (size_t)5 * M * DH;
    const int total = 2 * M * NH;
    for (int idx = blockIdx.x * NTHREADS + F.tid; idx < total; idx += F.G * NTHREADS) {
        const int t = idx % SEQ, hh = (idx / SEQ) % NH, b = (idx / (SEQ * NH)) % NB, type = idx / (SEQ * NH * NB);
        const size_t m = (size_t)b * SEQ + t;
        float q[64], o[64];
#pragma unroll
        for (int i = 0; i < 64; ++i) o[i] = 0.f;
        float ssq = 0.f;
        if (type == 0) {
            load_row64(QD + m * DH + hh * HD, q);
            const float slope2 = exp2f(-(float)(hh + 1)) * LOG2E;
            float mx = -INFINITY, l = 0.f;
            for (int p = 0; p < 3; ++p) {
                const int d = (p == 0) ? 1 : (p == 1) ? 4 : 16;
                for (int j = 0; j <= 128; ++j) {
                    const int pos = t - j * d; if (pos < 0) break;
                    const size_t km = (size_t)b * SEQ + pos;
                    const float s = dot_row64(KD + km * DH + hh * HD, q) - slope2 * (float)(j * d);
                    const float mn = fmaxf(mx, s), f = exp2f(mx - mn), pw = exp2f(s - mn);
                    l = l * f + pw;
#pragma unroll
                    for (int i = 0; i < 64; ++i) o[i] *= f;
                    axpy_row64(VD + km * DH + hh * HD, pw, o);
                    mx = mn;
                }
            }
            store_o64(F.OB + m * D + hh * HD, o, 1.0f / l, ssq);
        } else {
            load_row64(QS + m * DH + hh * HD, q);
            float R = 1.0f;
            for (int s_ = t - 1; s_ >= 0; --s_) {
                const size_t km = (size_t)b * SEQ + s_;
                const float z2 = fminf(dot_row64(KS + km * DH + hh * HD, q), 100.0f);
                const float e = exp2f(z2), cc = 1.0f / (1.0f + e), w_ = e * cc * R;
                axpy_row64(VS + km * DH + hh * HD, w_, o);
                R *= cc;
                if (R < 1e-30f) break;
            }
            store_o64(F.OB + m * D + DH + hh * HD, o, 1.0f, ssq);
        }
        atomicAdd(F.ssq + 2 * m + type, ssq);
    }
}

__device__ __forceinline__ void phase_outproj_simple(Frame& F) {
    const int r = F.lane & 31, h = F.lane >> 5, wm = F.wave >> 1, wn = F.wave & 1;
    constexpr int NPN = D / 128;
    float* x1 = F.out;
    for (int u = F.vcu; u < (M / 256) * NPN; u += F.G) {
        const int pm = u / NPN, pn = u % NPN, m0 = pm * 256 + wm * 64, n0 = pn * 128 + wn * 64;
        const bf16* pa[2] = {F.OB + (size_t)(m0 + r) * D + 8 * h, F.OB + (size_t)(m0 + 32 + r) * D + 8 * h};
        const bf16* pb[2] = {F.WoutT + (size_t)(n0 + r) * D + 8 * h, F.WoutT + (size_t)(n0 + 32 + r) * D + 8 * h};
        float rsd[2], rss[2];
#pragma unroll
        for (int mi = 0; mi < 2; ++mi) { const int m = m0 + 32 * mi + r; rsd[mi] = 1.0f / sqrtf(F.ssq[2 * m] * (1.f / DH) + NORM_EPS); rss[mi] = 1.0f / sqrtf(F.ssq[2 * m + 1] * (1.f / DH) + NORM_EPS); }
        f32x16 acc[2][2]; sg_zero<2>(acc);
        sg_mainloop<2>(acc, pa, pb, 0, DH);
#pragma unroll
        for (int ni = 0; ni < 2; ++ni)
#pragma unroll
            for (int mi = 0; mi < 2; ++mi) acc[ni][mi] = acc[ni][mi] * (rsd[mi] / rss[mi]);
        sg_mainloop<2>(acc, pa, pb, DH, D);
        const int b = m0 / SEQ;
#pragma unroll
        for (int ni = 0; ni < 2; ++ni)
#pragma unroll
            for (int mi = 0; mi < 2; ++mi)
#pragma unroll
                for (int g = 0; g < 4; ++g) {
                    const int n = n0 + 32 * ni + 8 * g + 4 * h; const int m = m0 + 32 * mi + r;
                    const f32x4 gate = *(const f32x4*)(F.mod + b * 6144 + 2048 + n), xv = *(const f32x4*)(F.x + (size_t)m * D + n);
                    f32x4 a; a.x = acc[ni][mi][4 * g]; a.y = acc[ni][mi][4 * g + 1]; a.z = acc[ni][mi][4 * g + 2]; a.w = acc[ni][mi][4 * g + 3];
                    *(f32x4*)(x1 + (size_t)m * D + n) = xv + gate * (a * rss[mi]);
                }
    }
}

__device__ __forceinline__ void phase_router(Frame& F) {
    LAS float* WR = (LAS float*)F.lds;
    for (int i = F.tid; i < D * 36; i += NTHREADS) { const int k = i / 36, c = i % 36; const int slot = ((k >> 8) * 4 + (k & 3)) * 64 + ((k >> 2) & 63);
        WR[slot * 36 + c] = (c < 4) ? F.w_group[k * 4 + c] : F.w_expert[k * 32 + (c - 4)]; }
    __syncthreads();
    const int gw = F.vcu * NWAVES + F.wave, NGW = F.G * NWAVES;
    const float* x1 = F.out;
    for (int ch = gw; ch < M / 32; ch += NGW) {
        const int b = ch / (SEQ / 32);
        f32x4 gs[4], sh[4];
#pragma unroll
        for (int j = 0; j < 4; ++j) { const int col = 4 * F.lane + 256 * j;
            const f32x4 g = *(const f32x4*)(F.g_ffn + col), scl = *(const f32x4*)(F.mod + b * 6144 + 4096 + col); sh[j] = *(const f32x4*)(F.mod + b * 6144 + 3072 + col);
            gs[j] = g * (scl + 1.0f); }
        int my_e1 = 0, my_e2 = 0; float my_w1 = 0.f, my_w2 = 0.f;
        for (int rr = 0; rr < 32; ++rr) {
            const size_t m = (size_t)ch * 32 + rr;
            const f32x4* xr = (const f32x4*)(x1 + m * D) + F.lane;
            f32x4 v[4]; float s = 0.f;
#pragma unroll
            for (int j = 0; j < 4; ++j) { v[j] = xr[64 * j]; s += (v[j].x * v[j].x + v[j].y * v[j].y) + (v[j].z * v[j].z + v[j].w * v[j].w); }
            const float rs = 1.0f / sqrtf(wave_sum(s) * (1.f / D) + NORM_EPS);
            unsigned long long* o8 = (unsigned long long*)(F.HB + m * D) + F.lane;
            float gl[4] = {0.f, 0.f, 0.f, 0.f};
#pragma unroll
            for (int j = 0; j < 4; ++j) { v[j] = v[j] * rs * gs[j] + sh[j];
                o8[64 * j] = (unsigned long long)pk2(v[j].x, v[j].y) | ((unsigned long long)pk2(v[j].z, v[j].w) << 32);
#pragma unroll
                for (int i = 0; i < 4; ++i) { const f32x4 w = *(const LAS f32x4*)(WR + ((j * 4 + i) * 64 + F.lane) * 36); const float hv = v[j][i];
                    gl[0] += hv * w.x; gl[1] += hv * w.y; gl[2] += hv * w.z; gl[3] += hv * w.w; } }
#pragma unroll
            for (int i = 0; i < 4; ++i) gl[i] = wave_sum(gl[i]);
            int grp = 0; float gmax = gl[0];
#pragma unroll
            for (int i = 1; i < 4; ++i) if (gl[i] > gmax) { gmax = gl[i]; grp = i; }
            float gden = 0.f;
#pragma unroll
            for (int i = 0; i < 4; ++i) gden += __expf(gl[i] - gmax);
            const float ggate = 1.0f / gden;
            grp = __builtin_amdgcn_readfirstlane(grp);
            float el[8];
#pragma unroll
            for (int i = 0; i < 8; ++i) el[i] = 0.f;
#pragma unroll
            for (int j = 0; j < 4; ++j)
#pragma unroll
                for (int i = 0; i < 4; ++i) { const LAS float* wp = WR + ((j * 4 + i) * 64 + F.lane) * 36 + 4 + grp * 8; const f32x4 w0 = *(const LAS f32x4*)wp, w1 = *(const LAS f32x4*)(wp + 4); const float hv = v[j][i];
                    el[0] += hv * w0.x; el[1] += hv * w0.y; el[2] += hv * w0.z; el[3] += hv * w0.w; el[4] += hv * w1.x; el[5] += hv * w1.y; el[6] += hv * w1.z; el[7] += hv * w1.w; }
#pragma unroll
            for (int i = 0; i < 8; ++i) el[i] = wave_sum(el[i]);
            int i1 = 0; float l1 = el[0];
#pragma unroll
            for (int i = 1; i < 8; ++i) if (el[i] > l1) { l1 = el[i]; i1 = i; }
            int i2 = -1; float l2 = -INFINITY;
#pragma unroll
            for (int i = 0; i < 8; ++i) if (i != i1 && el[i] > l2) { l2 = el[i]; i2 = i; }
            const float p2 = 1.0f / (1.0f + __expf(l1 - l2)), p1 = 1.0f - p2;
            if (F.lane == rr) { my_e1 = grp * 8 + i1; my_e2 = grp * 8 + i2; my_w1 = ggate * p1; my_w2 = ggate * p2; }
        }
        if (F.lane < 32) {
            const int m = ch * 32 + F.lane;
            const int pos1 = (int)atomicAdd(F.cnt + 64 * my_e1, 1u), pos2 = (int)atomicAdd(F.cnt + 64 * my_e2, 1u);
            F.list[(size_t)my_e1 * LIST_CAP + pos1] = m; F.list[(size_t)my_e2 * LIST_CAP + pos2] = m;
            i32x4 ts; ts.x = my_e1; ts.y = pos1; ts.z = my_e2; ts.w = pos2; F.tokslot[m] = ts;
            F.tokw[2 * m] = my_w1; F.tokw[2 * m + 1] = my_w2;
        }
    }
}

__device__ __forceinline__ void build_tiles(Frame& F) {
    __syncthreads();
    if (F.tid == 0) { unsigned acc = 0; for (int e = 0; e < NE; ++e) { F.MISC[e] = acc; acc += (__hip_atomic_load(F.cnt + 64 * e, __ATOMIC_RELAXED, __HIP_MEMORY_SCOPE_AGENT) + 255u) >> 8; } F.MISC[NE] = acc; }
    __syncthreads();
}
__device__ __forceinline__ int find_expert(Frame& F, int tile) { int e = 0;
#pragma unroll 1
    for (int i = 1; i < NE; ++i) if ((int)F.MISC[i] <= tile) e = i; else break;
    return e; }

__device__ __forceinline__ void phase_moe1_simple(Frame& F) {
    build_tiles(F);
    const int r = F.lane & 31, h = F.lane >> 5, wm = F.wave >> 1, wn = F.wave & 1;
    const int T = (int)F.MISC[NE];
    for (int u = F.vcu; u < T * 8; u += F.G) {
        const int tile = u >> 3, cn = u & 7, e = find_expert(F, tile), jt = tile - (int)F.MISC[e];
        const int cnt = (int)__hip_atomic_load(F.cnt + 64 * e, __ATOMIC_RELAXED, __HIP_MEMORY_SCOPE_AGENT);
        const bf16* pa[2];
#pragma unroll
        for (int mi = 0; mi < 2; ++mi) { const int pos = jt * 256 + wm * 64 + 32 * mi + r; const int tok = (pos < cnt) ? F.list[(size_t)e * LIST_CAP + pos] : 0; pa[mi] = F.HB + (size_t)tok * D + 8 * h; }
        const int j0 = cn * 64 + wn * 32, jj = j0 + r;
        const bf16* Wb = F.WguT + (size_t)e * D * D;
        const bf16* pb[2] = {Wb + (size_t)(8 * (jj >> 2) + (jj & 3)) * D + 8 * h, Wb + (size_t)(8 * (jj >> 2) + 4 + (jj & 3)) * D + 8 * h};
        f32x16 acc[2][2]; sg_zero<2>(acc);
        sg_mainloop<2>(acc, pa, pb, 0, D);
#pragma unroll
        for (int mi = 0; mi < 2; ++mi)
#pragma unroll
            for (int g = 0; g < 4; ++g) {
                const size_t row = (size_t)tile * 256 + wm * 64 + 32 * mi + r; const int col = j0 + 8 * g + 4 * h;
                float hv[4];
#pragma unroll
                for (int i = 0; i < 4; ++i) { const float ga = acc[0][mi][4 * g + i], up = acc[1][mi][4 * g + i]; hv[i] = ga / (1.0f + __expf(-ga)) * up; }
                u32x2 w; w.x = pk2(hv[0], hv[1]); w.y = pk2(hv[2], hv[3]);
                *(u32x2*)(F.HM + row * DFF + col) = w;
            }
    }
}
__device__ __forceinline__ void phase_moe2_simple(Frame& F) {
    build_tiles(F);
    const int r = F.lane & 31, h = F.lane >> 5, wm = F.wave >> 1, wn = F.wave & 1;
    const int T = (int)F.MISC[NE];
    for (int u = F.vcu; u < T * 8; u += F.G) {
        const int tile = u >> 3, pn = u & 7, e = find_expert(F, tile);
        const size_t row0 = (size_t)tile * 256 + wm * 64; const int n0 = pn * 128 + wn * 64;
        const bf16* pa[2] = {F.HM + (row0 + r) * DFF + 8 * h, F.HM + (row0 + 32 + r) * DFF + 8 * h};
        const bf16* Wb = F.WdT + (size_t)e * D * DFF;
        const bf16* pb[2] = {Wb + (size_t)(n0 + r) * DFF + 8 * h, Wb + (size_t)(n0 + 32 + r) * DFF + 8 * h};
        f32x16 acc[2][2]; sg_zero<2>(acc);
        sg_mainloop<2>(acc, pa, pb, 0, DFF);
#pragma unroll
        for (int ni = 0; ni < 2; ++ni)
#pragma unroll
            for (int mi = 0; mi < 2; ++mi)
#pragma unroll
                for (int g = 0; g < 4; ++g) {
                    const size_t row = row0 + 32 * mi + r; const int n = n0 + 32 * ni + 8 * g + 4 * h;
                    u32x2 w; w.x = pk2(acc[ni][mi][4 * g], acc[ni][mi][4 * g + 1]); w.y = pk2(acc[ni][mi][4 * g + 2], acc[ni][mi][4 * g + 3]);
                    *(u32x2*)(F.YB + row * D + n) = w;
                }
    }
}
__device__ __forceinline__ f32x4 ld_bf4(const bf16* p) { const u32x2 w = *(const u32x2*)p; f32x4 r; r.x = __uint_as_float(w.x << 16); r.y = __uint_as_float(w.x & 0xffff0000u); r.z = __uint_as_float(w.y << 16); r.w = __uint_as_float(w.y & 0xffff0000u); return r; }
__device__ __forceinline__ void phase_final(Frame& F) {
    build_tiles(F);
    const int gw = F.vcu * NWAVES + F.wave, NGW = F.G * NWAVES;
    for (int ch = gw; ch < M / 32; ch += NGW) {
        const int b = ch / (SEQ / 32);
        f32x4 gate[4], gf[4];
#pragma unroll
        for (int j = 0; j < 4; ++j) { const int col = 4 * F.lane + 256 * j; gate[j] = *(const f32x4*)(F.mod + b * 6144 + 5120 + col); gf[j] = *(const f32x4*)(F.g_final + col); }
        for (int rr = 0; rr < 32; ++rr) {
            const size_t m = (size_t)ch * 32 + rr;
            const i32x4 ts = F.tokslot[m]; const float w1 = F.tokw[2 * m], w2 = F.tokw[2 * m + 1];
            const size_t ra = (size_t)F.MISC[ts.x] * 256 + ts.y, rb = (size_t)F.MISC[ts.z] * 256 + ts.w;
            f32x4* xr = (f32x4*)(F.out + m * D) + F.lane;
            f32x4 v[4]; float s = 0.f;
#pragma unroll
            for (int j = 0; j < 4; ++j) { const int col = 4 * F.lane + 256 * j;
                const f32x4 ya = ld_bf4(F.YB + ra * D + col), yb = ld_bf4(F.YB + rb * D + col);
                v[j] = xr[64 * j] + gate[j] * (ya * w1 + yb * w2);
                s += (v[j].x * v[j].x + v[j].y * v[j].y) + (v[j].z * v[j].z + v[j].w * v[j].w); }
            const float rs = 1.0f / sqrtf(wave_sum(s) * (1.f / D) + NORM_EPS);
#pragma unroll
            for (int j = 0; j < 4; ++j) xr[64 * j] = v[j] * rs * gf[j];
        }
    }
}

constexpr int N_PHASES = 9;
struct Args { const float* in[16]; float* out; unsigned char* ws; int ph_lo, ph_hi; };
__global__ void __launch_bounds__(NTHREADS, 2) mk_fwd(Args args) {
    extern __shared__ __attribute__((aligned(16))) unsigned char lds[];
    Frame F;
    F.lds = (LAS unsigned char*)lds; F.MISC = (volatile LAS unsigned*)(F.lds + MISC_OFF);
    F.tid = threadIdx.x; F.lane = F.tid & 63; F.wave = __builtin_amdgcn_readfirstlane(F.tid >> 6);
    F.G = gridDim.x; { const int bx = blockIdx.x; F.vcu = (F.G % 8 == 0) ? (bx % 8) * (F.G / 8) + bx / 8 : bx; }
    unsigned char* ws = args.ws; F.ws = ws; F.ctl = (unsigned*)(ws + WS_CTL);
    F.x = args.in[0]; F.c = args.in[1]; F.w_ada = args.in[2]; F.b_ada = args.in[3]; F.g_mix = args.in[4]; F.w_in = args.in[5]; F.g_dil = args.in[6]; F.g_sb = args.in[7];
    F.w_out = args.in[8]; F.g_ffn = args.in[9]; F.w_group = args.in[10]; F.w_expert = args.in[11]; F.w_gate = args.in[12]; F.w_up = args.in[13]; F.w_down = args.in[14]; F.g_final = args.in[15];
    F.out = args.out;
    F.mod = (float*)(ws + WS_MOD); F.WinT = (bf16*)(ws + WS_WIN); F.WoutT = (bf16*)(ws + WS_WOUT); F.WguT = (bf16*)(ws + WS_WGU); F.WdT = (bf16*)(ws + WS_WD);
    F.HB = (bf16*)(ws + WS_H); F.QKV = (bf16*)(ws + WS_QKV); F.OB = (bf16*)(ws + WS_O); F.HM = (bf16*)(ws + WS_PART); F.YB = (bf16*)(ws + WS_QKV);
    F.list = (int*)(ws + WS_LIST); F.tokslot = (i32x4*)(ws + WS_TOKSLOT); F.tokw = (float*)(ws + WS_TOKW); F.ssq = (float*)(F.ctl + CW_SSQ); F.cnt = F.ctl + CW_CNT;
    for (int u = F.tid; u < 64; u += NTHREADS) F.MISC[u] = 0u;
    __syncthreads();
    const int lo = args.ph_lo, hi = args.ph_hi;
    XcdBarrier bar; bar.bar = F.ctl + CW_BAR; bar.x = 0; bar.st = nullptr;
    if (hi - lo > 1) bar = xcd_barrier_post(F.ctl + CW_BAR, F.MISC + 40);
#define IN(k) (lo <= (k) && (k) < hi)
#define SEAM(k) do { if (IN(k) && IN((k) + 1)) xcd_barrier(bar); } while (0)
    if (IN(0)) { phase_mod(F); } SEAM(0);
    if (IN(1)) { phase_prep(F); } SEAM(1);
    if (IN(2)) { phase_qkv_simple(F); } SEAM(2);
    if (IN(3)) { phase_attn_naive(F); } SEAM(3);
    if (IN(4)) { phase_outproj_simple(F); } SEAM(4);
    if (IN(5)) { phase_router(F); } SEAM(5);
    if (IN(6)) { phase_moe1_simple(F); } SEAM(6);
    if (IN(7)) { phase_moe2_simple(F); } SEAM(7);
    if (IN(8)) { phase_final(F); }
#undef IN
#undef SEAM
}

extern "C" void kernel_launch(void* const* d_in, const int* in_sizes, int n_in, void* d_out, int out_size, void* d_ws, size_t ws_size, hipStream_t stream) {
    static int grid = 0;
    if (grid == 0) {
        if (n_in != 16 || in_sizes[0] != M * D || out_size != M * D || ws_size < WS_END) { fprintf(stderr, "kernel_launch: unexpected shapes / workspace (n_in %d, ws %zu)\n", n_in, ws_size); grid = -1; return; }
        int dev = 0, cus = 0;
        if (hipGetDevice(&dev) != hipSuccess || hipDeviceGetAttribute(&cus, hipDeviceAttributeMultiprocessorCount, dev) != hipSuccess) { grid = -1; return; }
        if (hipFuncSetAttribute((const void*)mk_fwd, hipFuncAttributeMaxDynamicSharedMemorySize, LDS_BYTES) != hipSuccess) { fprintf(stderr, "kernel_launch: hipFuncSetAttribute failed\n"); grid = -1; return; }
        int per_cu = 0;
        if (hipOccupancyMaxActiveBlocksPerMultiprocessor(&per_cu, (const void*)mk_fwd, NTHREADS, LDS_BYTES) != hipSuccess || per_cu < 1) fprintf(stderr, "kernel_launch: occupancy query says %d\n", per_cu);
        (void)hipGetLastError();
        grid = cus;
    }
    if (grid < 0) return;
    (void)hipMemsetAsync((char*)d_ws + WS_CTL, 0, CTL_ZERO_BYTES, stream);
    Args a{};
    for (int i = 0; i < 16; ++i) a.in[i] = (const float*)d_in[i];
    a.out = (float*)d_out; a.ws = (unsigned char*)d_ws;
    constexpr int NL = MK_N_LAUNCHES;
    for (int li = 0; li < NL; ++li) {
        a.ph_lo = (NL == N_PHASES) ? li : (li * N_PHASES) / NL; a.ph_hi = (NL == N_PHASES) ? li + 1 : ((li + 1) * N_PHASES) / NL;
        hipLaunchKernelGGL(mk_fwd, dim3(grid), dim3(NTHREADS), LDS_BYTES, stream, a);
    }
}
```

```cpp
#include <hip/hip_runtime.h>
#include <cstdio>
#include <cstdint>

#ifndef FAST_QKV
#define FAST_QKV 1
#endif
#ifndef FAST_OUT
#define FAST_OUT 1
#endif
#ifndef FAST_MOE1
#define FAST_MOE1 1
#endif
#ifndef FAST_MOE2
#define FAST_MOE2 1
#endif
#ifndef MK_N_LAUNCHES
#define MK_N_LAUNCHES 1
#endif

#define GAS __attribute__((address_space(1)))
#define LAS __attribute__((address_space(3)))
typedef unsigned short bf16;
typedef short bf16x8 __attribute__((ext_vector_type(8)));
typedef float f32x4 __attribute__((ext_vector_type(4)));
typedef float f32x16 __attribute__((ext_vector_type(16)));
typedef unsigned u32x4 __attribute__((ext_vector_type(4)));
typedef unsigned u32x2 __attribute__((ext_vector_type(2)));
typedef int i32x4 __attribute__((ext_vector_type(4)));

constexpr int NB = 8, SEQ = 8192, D = 1024, M = NB * SEQ;
constexpr int HD = 64, NH = 8, DH = 512;
constexpr int NE = 32, EPG = 8, NGRP = 4, DFF = 512;
constexpr float NORM_EPS = 1e-6f;
constexpr float LOG2E = 1.4426950408889634f;
constexpr float C2 = 0.125f * LOG2E;
constexpr int NWAVES = 8, NTHREADS = 512;
constexpr int LIST_CAP = M;
constexpr int MAX_TILES = (2 * M) / 256 + NE;

constexpr size_t MiB = 1u << 20;
constexpr size_t WS_CTL = 0, CTL_ZERO_BYTES = 2 * MiB;
constexpr size_t WS_MOD = 2 * MiB;
constexpr size_t WS_WIN = 4 * MiB;
constexpr size_t WS_WOUT = 10 * MiB;
constexpr size_t WS_WGU = 12 * MiB;
constexpr size_t WS_WD = 76 * MiB;
constexpr size_t WS_LIST = 108 * MiB;
constexpr size_t WS_TOKSLOT = 116 * MiB;
constexpr size_t WS_TOKW = 117 * MiB;
constexpr size_t WS_H = 120 * MiB;
constexpr size_t WS_QKV = 248 * MiB;
constexpr size_t WS_PART = 632 * MiB;
constexpr size_t WS_O = 768 * MiB;
constexpr size_t WS_END = 896 * MiB;
static_assert(WS_QKV + (size_t)MAX_TILES * 256 * 1024 * 2 <= WS_PART && WS_PART + (size_t)MAX_TILES * 256 * 512 * 2 <= WS_O, "overlays");
constexpr int CW_BAR = 4096;
constexpr int CW_CNT = 16384;
constexpr int CW_SSQ = 65536;
static_assert((CW_SSQ + 2 * M) * 4 <= (int)CTL_ZERO_BYTES, "ctl");

constexpr int LDS_MAIN = 147456;
constexpr int MISC_OFF = LDS_MAIN;
constexpr int LDS_BYTES = LDS_MAIN + 1024;

__device__ __forceinline__ float bf2f(bf16 v) { return __uint_as_float((unsigned)v << 16); }
__device__ __forceinline__ unsigned f2bf(float f) { unsigned u = __float_as_uint(f); return (u + 0x7fffu + ((u >> 16) & 1u)) >> 16; }
__device__ __forceinline__ unsigned pk2(float lo, float hi) { return f2bf(lo) | (f2bf(hi) << 16); }
__device__ __forceinline__ float wave_sum(float v) {
#pragma unroll
    for (int o = 1; o < 64; o <<= 1) v += __shfl_xor(v, o);
    return v;
}
__device__ __forceinline__ int crow(int r, int hi) { return (r & 3) + 8 * (r >> 2) + 4 * hi; }
#define MFMA32(a, b, c) __builtin_amdgcn_mfma_f32_32x32x16_bf16((a), (b), (c), 0, 0, 0)

#define XB_TMO      128
#define XB_XCNT(j)  (256  + 64 * (j))
#define XB_XSUB(j)  (1280 + 64 * (j))
#define XB_XGEN(j)  (2304 + 64 * (j))
#define XB_TOP      3328
#define XB_TOPGEN   3392
#define XCD_BAR_WORDS 3456
#define XB_SPIN_CAP (1u << 18)
__device__ __forceinline__ unsigned xb_ld(unsigned* p)              { return __hip_atomic_load(p, __ATOMIC_RELAXED, __HIP_MEMORY_SCOPE_AGENT); }
__device__ __forceinline__ unsigned xb_add(unsigned* p, unsigned v) { return __hip_atomic_fetch_add(p, v, __ATOMIC_RELAXED, __HIP_MEMORY_SCOPE_AGENT); }
__device__ __forceinline__ unsigned xb_xcc_id() { return (unsigned)__builtin_amdgcn_s_getreg((3 << 11) | 20) & 0xFu; }
#define XB_SPIN(cond, bar) do { unsigned _sp = 0; while (cond) { __builtin_amdgcn_s_sleep(1); \
    if ((++_sp & 255u) == 0u) { if (xb_ld(&(bar)[XB_TMO])) break; if (_sp > XB_SPIN_CAP) { atomicAdd(&(bar)[XB_TMO], 1u); break; } } } } while (0)
struct XcdBarrier { unsigned* bar; unsigned x; volatile LAS unsigned* st; };
__device__ __forceinline__ XcdBarrier xcd_barrier_post(unsigned* bar, volatile LAS unsigned* st) {
    XcdBarrier b; b.bar = bar; b.x = xb_xcc_id(); b.st = st;
    if (threadIdx.x == 0) (void)xb_add(&bar[XB_XCNT(b.x)], 1u);
    return b;
}
__device__ __forceinline__ void xcd_barrier_complete(unsigned* bar, unsigned x, unsigned& nloc, unsigned& nx) {
    const unsigned G = gridDim.x * gridDim.y * gridDim.z;
    unsigned sum, cnt, mine, sp = 0u;
    for (;;) {
        sum = 0u; cnt = 0u; mine = 0u;
#pragma unroll
        for (unsigned j = 0; j < 16; ++j) { const unsigned c = xb_ld(&bar[XB_XCNT(j)]); sum += c; cnt += (c > 0u) ? 1u : 0u; mine = (j == x) ? c : mine; }
        if (sum == G) break;
        __builtin_amdgcn_s_sleep(1);
        if ((++sp & 255u) == 0u) { if (xb_ld(&bar[XB_TMO])) break; if (sp > XB_SPIN_CAP) { atomicAdd(&bar[XB_TMO], 1u); break; } }
    }
    nloc = mine > 0u ? mine : 1u; nx = cnt > 0u ? cnt : 1u;
}
__device__ __forceinline__ void xcd_barrier(const XcdBarrier& b) {
    asm volatile("s_waitcnt vmcnt(0)" ::: "memory");
    __syncthreads();
    if (threadIdx.x == 0) {
        unsigned* bar = b.bar;
        __builtin_amdgcn_s_waitcnt(0);
        unsigned nloc = b.st[0], nx = b.st[1];
        if (nloc == 0u) { xcd_barrier_complete(bar, b.x, nloc, nx); b.st[0] = nloc; b.st[1] = nx; }
        const unsigned old = xb_add(&bar[XB_XSUB(b.x)], 1u);
        const unsigned gen = old / nloc;
        if (old + 1u == (gen + 1u) * nloc) {
            __builtin_amdgcn_fence(__ATOMIC_RELEASE, "agent");
            asm volatile("s_waitcnt vmcnt(0)" ::: "memory");
            const unsigned og = xb_add(&bar[XB_TOP], 1u);
            const unsigned tg = og / nx;
            if (og + 1u == (tg + 1u) * nx) xb_add(&bar[XB_TOPGEN], 1u);
            else XB_SPIN(xb_ld(&bar[XB_TOPGEN]) == tg, bar);
            __builtin_amdgcn_fence(__ATOMIC_ACQUIRE, "agent");
            xb_add(&bar[XB_XGEN(b.x)], 1u);
            asm volatile("s_waitcnt vmcnt(0)" ::: "memory");
        } else {
            XB_SPIN(xb_ld(&bar[XB_XGEN(b.x)]) == gen, bar);
            __builtin_amdgcn_fence(__ATOMIC_ACQUIRE, "agent");
            asm volatile("s_waitcnt vmcnt(0)" ::: "memory");
        }
    }
    __syncthreads();
}

struct Frame {
    LAS unsigned char* lds;
    volatile LAS unsigned* MISC;
    unsigned* ctl;
    int tid, lane, wave, vcu, G;
    const float *x, *c, *w_ada, *b_ada, *g_mix, *w_in, *g_dil, *g_sb, *w_out, *g_ffn, *w_group, *w_expert, *w_gate, *w_up, *w_down, *g_final;
    float* out; unsigned char* ws;
    float* mod; bf16 *WinT, *WoutT, *WguT, *WdT, *HB, *QKV, *OB, *HM, *YB;
    int* list; i32x4* tokslot; float* tokw; float* ssq; unsigned* cnt;
};

__device__ __forceinline__ void phase_mod(Frame& F) {
    LAS float* sc = (LAS float*)F.lds;
    LAS float* red = sc + 8192;
    for (int i = F.tid; i < NB * D; i += NTHREADS) { const float v = F.c[i]; sc[i] = v / (1.f + __expf(-v)); }
    __syncthreads();
    for (int unit = blockIdx.x; unit < 96; unit += F.G) {
        const int j = unit * 64 + F.lane;
        float acc[8];
#pragma unroll
        for (int b = 0; b < 8; ++b) acc[b] = 0.f;
        const float* wp = F.w_ada + (size_t)(F.wave * 128) * 6144 + j;
#pragma unroll 8
        for (int kk = 0; kk < 128; ++kk) { const float wv = wp[(size_t)kk * 6144];
#pragma unroll
            for (int b = 0; b < 8; ++b) acc[b] += sc[b * 1024 + F.wave * 128 + kk] * wv; }
#pragma unroll
        for (int b = 0; b < 8; ++b) red[(F.wave * 8 + b) * 64 + F.lane] = acc[b];
        __syncthreads();
        { const int b = F.wave; float s = 0.f;
#pragma unroll
          for (int w = 0; w < 8; ++w) s += red[(w * 8 + b) * 64 + F.lane];
          F.mod[b * 6144 + j] = s + F.b_ada[j]; }
        __syncthreads();
    }
}

template <class RowMap>
__device__ __forceinline__ void transpose_item(const float* W, int K, int N, bf16* WT, RowMap rm, const float* gk, LAS float* scr, int item, int lane) {
    const int nblk = N / 32, kb = item / nblk, nb = item % nblk, k0 = 64 * kb, n0 = 32 * nb;
#pragma unroll 8
    for (int i = 0; i < 32; ++i) { const int kk = 2 * i + (lane >> 5); float v = W[(size_t)(k0 + kk) * N + n0 + (lane & 31)]; if (gk) v *= gk[k0 + kk]; scr[kk * 33 + (lane & 31)] = v; }
    asm volatile("s_waitcnt lgkmcnt(0)" ::: "memory");
    const int c = lane & 7;
#pragma unroll
    for (int j = 0; j < 4; ++j) { const int n = (lane >> 3) + 8 * j; const LAS float* s = scr + (8 * c) * 33 + n;
        u32x4 o; o.x = pk2(s[0 * 33], s[1 * 33]); o.y = pk2(s[2 * 33], s[3 * 33]); o.z = pk2(s[4 * 33], s[5 * 33]); o.w = pk2(s[6 * 33], s[7 * 33]);
        *(u32x4*)(WT + (size_t)rm(n0 + n) * K + k0 + 8 * c) = o; }
    asm volatile("s_waitcnt lgkmcnt(0)" ::: "memory");
}
struct RmId { __device__ __forceinline__ int operator()(int n) const { return n; } };
struct RmGU { int up; __device__ __forceinline__ int operator()(int n) const { return 8 * (n >> 2) + 4 * up + (n & 3); } };

__device__ __forceinline__ void phase_prep(Frame& F) {
    LAS float* scr = (LAS float*)(F.lds + F.wave * 16384);
    const int gw = F.vcu * NWAVES + F.wave, NGW = F.G * NWAVES;
    constexpr int I_IN = 16 * 96, I_OUT = 16 * 32, I_G = 16 * 16, I_D = 8 * 32;
    constexpr int NITEMS = I_IN + I_OUT + NE * (2 * I_G + I_D);
    for (int it = gw; it < NITEMS; it += NGW) {
        int r = it;
        if (r < I_IN) { transpose_item(F.w_in, D, 3 * D, F.WinT, RmId{}, nullptr, scr, r, F.lane); continue; } r -= I_IN;
        if (r < I_OUT) {
            const int kb = r / 32; const float* gk = (kb < 8) ? F.g_dil : (F.g_sb - 512);
            transpose_item(F.w_out, D, D, F.WoutT, RmId{}, gk, scr, r, F.lane); continue; } r -= I_OUT;
        const int e = r / (2 * I_G + I_D); r -= e * (2 * I_G + I_D);
        if (r < I_G) { transpose_item(F.w_gate + (size_t)e * D * DFF, D, DFF, F.WguT + (size_t)e * D * D, RmGU{0}, nullptr, scr, r, F.lane); continue; } r -= I_G;
        if (r < I_G) { transpose_item(F.w_up + (size_t)e * D * DFF, D, DFF, F.WguT + (size_t)e * D * D, RmGU{1}, nullptr, scr, r, F.lane); continue; } r -= I_G;
        transpose_item(F.w_down + (size_t)e * DFF * D, DFF, D, F.WdT + (size_t)e * D * DFF, RmId{}, nullptr, scr, r, F.lane);
    }
    for (int ch = gw; ch < M / 32; ch += NGW) {
        const int b = ch / (SEQ / 32);
        f32x4 gs[4], sh[4];
#pragma unroll
        for (int j = 0; j < 4; ++j) { const int col = 4 * F.lane + 256 * j;
            const f32x4 g = *(const f32x4*)(F.g_mix + col), scl = *(const f32x4*)(F.mod + b * 6144 + 1024 + col); sh[j] = *(const f32x4*)(F.mod + b * 6144 + col);
            gs[j] = g * (scl + 1.0f); }
        for (int rr = 0; rr < 32; ++rr) {
            const size_t m = (size_t)ch * 32 + rr;
            const f32x4* xr = (const f32x4*)(F.x + m * D) + F.lane;
            f32x4 v[4]; float s = 0.f;
#pragma unroll
            for (int j = 0; j < 4; ++j) { v[j] = xr[64 * j]; s += (v[j].x * v[j].x + v[j].y * v[j].y) + (v[j].z * v[j].z + v[j].w * v[j].w); }
            const float rs = 1.0f / sqrtf(wave_sum(s) * (1.f / D) + NORM_EPS);
            unsigned long long* o8 = (unsigned long long*)(F.HB + m * D) + F.lane;
#pragma unroll
            for (int j = 0; j < 4; ++j) { const f32x4 y = v[j] * rs * gs[j] + sh[j];
                o8[64 * j] = (unsigned long long)pk2(y.x, y.y) | ((unsigned long long)pk2(y.z, y.w) << 32); }
        }
    }
}

template <int NI>
__device__ __forceinline__ void sg_mainloop(f32x16 (&acc)[NI][2], const bf16* const (&pa)[2], const bf16* const (&pb)[NI], int kbeg, int kend) {
#pragma unroll 2
    for (int k = kbeg; k < kend; k += 32) {
        bf16x8 a[2][2], b[NI][2];
#pragma unroll
        for (int s = 0; s < 2; ++s) {
#pragma unroll
            for (int mi = 0; mi < 2; ++mi) a[mi][s] = *(const bf16x8*)(pa[mi] + k + 16 * s);
#pragma unroll
            for (int ni = 0; ni < NI; ++ni) b[ni][s] = *(const bf16x8*)(pb[ni] + k + 16 * s);
        }
#pragma unroll
        for (int s = 0; s < 2; ++s)
#pragma unroll
            for (int ni = 0; ni < NI; ++ni)
#pragma unroll
                for (int mi = 0; mi < 2; ++mi) acc[ni][mi] = MFMA32(b[ni][s], a[mi][s], acc[ni][mi]);
    }
}
template <int NI> __device__ __forceinline__ void sg_zero(f32x16 (&acc)[NI][2]) {
#pragma unroll
    for (int ni = 0; ni < NI; ++ni)
#pragma unroll
        for (int mi = 0; mi < 2; ++mi)
#pragma unroll
            for (int i = 0; i < 16; ++i) acc[ni][mi][i] = 0.f;
}

namespace pg8 {
typedef unsigned short bf16_t;
constexpr int BM = 256, BK = 64, HALF = 128, HTB = HALF * BK * 2, STAGE_BYTES = 8 * HTB, NXCD = 8, WGM = 8;
constexpr int SIDE_OFF = STAGE_BYTES;
__host__ __device__ __forceinline__ int lds_byte(int r, int c) { const int st = (r >> 4) * 2 + (c >> 5), rr = r & 15, cc = c & 31, ob = rr * 64 + cc * 2; return st * 1024 + (ob ^ (((ob >> 9) & 1) << 5)); }
__host__ __device__ __forceinline__ void stage_rc(int b, int& R, int& C) { const int st = b / 1024, sb = b % 1024, swz = sb ^ (((sb >> 9) & 1) << 5); R = (st >> 1) * 16 + swz / 64; C = (st & 1) * 32 + (swz % 64) / 2; }
__host__ __device__ __forceinline__ int perm32(int rho) { const int n = rho >> 4, i = rho & 15; return 8 * (i >> 2) + 4 * n + (i & 3); }
struct Unit { int pm, pn, pb, li; };
struct Gemm { const bf16_t* A; const bf16_t* Bt; int K; };
struct StaticOrder {
    int nM, nN, nwg, G, c;
    __device__ void init(int M_, int N_, int G_, int c_) { nM = M_ / BM; nN = N_ / BM; nwg = nM * nN; G = G_; c = c_; }
    __device__ bool next(int i, Unit& u) const {
        const long L = (long)i * G + c; if (L >= nwg) return false;
        int wgid = (int)L; { const int q = nwg / NXCD, r = nwg % NXCD, xcd = wgid % NXCD, off = wgid / NXCD; wgid = (xcd < r ? xcd * (q + 1) : r * (q + 1) + (xcd - r) * q) + off; }
        const int nig = WGM * nN, gid = wgid / nig, fm = gid * WGM, gsz = (nM - fm) < WGM ? (nM - fm) : WGM;
        u.pm = fm + ((wgid % nig) % gsz); u.pn = (wgid % nig) / gsz; u.pb = u.pn; u.li = i; return true;
    }
};
__device__ __forceinline__ unsigned cvt_pk_bf16(float lo, float hi) { unsigned r; asm volatile("v_cvt_pk_bf16_f32 %0, %1, %2" : "=v"(r) : "v"(lo), "v"(hi)); return r; }

template <class Epi, class Sched, int MODE>
__device__ __forceinline__ void gemm_phase(LAS unsigned char* lds, const Gemm g, const Sched& S, const Epi& E) {
    constexpr bool GATHER = (MODE == 1), RESCALE = (MODE == 2);
    const int tid = threadIdx.x, wid = __builtin_amdgcn_readfirstlane(tid >> 6), lane = tid & 63, wr = wid >> 2, wc = wid & 3, fr = lane & 15, fq = lane >> 4;
    const int K = g.K, nt = K / BK;
    unsigned voffA[2], voffB[2]; int RA[2], CA2[2];
#pragma unroll
    for (int i = 0; i < 2; ++i) { int R, C; stage_rc(tid * 16 + i * 8192, R, C); const int Rb = Epi::PERM ? ((R & ~31) + perm32(R & 31)) : R;
        voffA[i] = (unsigned)(R * K + C) * 2u; voffB[i] = (unsigned)(Rb * K + C) * 2u; RA[i] = R; CA2[i] = C * 2; }
    const size_t kstep = (size_t)(BK * 2);
    const size_t hstep = (size_t)HALF * K * 2;
    const size_t tstep = 2 * hstep;
    const unsigned ldsw = (unsigned)wid * 1024u;
    const int aoff = lds_byte(wr * 64 + fr, fq * 8), boff = lds_byte(wc * 32 + fr, fq * 8);
    const LAS int* idxtab = (const LAS int*)(lds + SIDE_OFF);
#define PG8_SA(b, h) (((b) * 2 + (h)) * HTB)
#define PG8_SB(b, h) ((4 + (b) * 2 + (h)) * HTB)
#define PG8_STAGE2(bufoff, gbase, o0, o1) do { \
        __builtin_amdgcn_global_load_lds((const unsigned*)((const char*)(gbase) + (o0)), (LAS unsigned*)(lds + (bufoff) + ldsw), 16, 0, 0); \
        __builtin_amdgcn_global_load_lds((const unsigned*)((const char*)(gbase) + (o1)), (LAS unsigned*)(lds + (bufoff) + ldsw + 8192), 16, 0, 0); } while (0)
#define PG8_STAGE(bufoff, gbase, voff) PG8_STAGE2(bufoff, gbase, (voff)[0], (voff)[1])
#define PG8_STAGE_A(bufoff, hf, aptr, NXT) do { if constexpr (GATHER) { const unsigned o0_ = (NXT) ? goffN[hf][0] : goffC[hf][0], o1_ = (NXT) ? goffN[hf][1] : goffC[hf][1]; PG8_STAGE2(bufoff, aptr, o0_, o1_); } \
        else { PG8_STAGE(bufoff, (aptr) + (hf) * hstep, voffA); } } while (0)
#define PG8_LDA(dst, b, h) do { _Pragma("unroll") for (int m = 0; m < 4; ++m) _Pragma("unroll") for (int k = 0; k < 2; ++k) dst[m][k] = *(const LAS bf16x8*)(lds + PG8_SA(b, h) + aoff + m * 2048 + k * 1024); } while (0)
#define PG8_LDB(dst, b, h) do { _Pragma("unroll") for (int n = 0; n < 2; ++n) _Pragma("unroll") for (int k = 0; k < 2; ++k) dst[n][k] = *(const LAS bf16x8*)(lds + PG8_SB(b, h) + boff + n * 2048 + k * 1024); } while (0)
#define PG8_MMA(ai, bj, At, Bt) do { __builtin_amdgcn_s_setprio(1); _Pragma("unroll") for (int m = 0; m < 4; ++m) _Pragma("unroll") for (int n = 0; n < 2; ++n) _Pragma("unroll") for (int k = 0; k < 2; ++k) \
        acc[ai][bj][m][n] = __builtin_amdgcn_mfma_f32_16x16x32_bf16(Bt[n][k], At[m][k], acc[ai][bj][m][n], 0, 0, 0); __builtin_amdgcn_s_setprio(0); } while (0)
#define PG8_WAIT_V(n) asm volatile("s_waitcnt vmcnt(" #n ")" ::: "memory")
#define PG8_WAIT_L(n) asm volatile("s_waitcnt lgkmcnt(" #n ")" ::: "memory")
#define PG8_BAR __builtin_amdgcn_s_barrier()
#define PG8_SCHED __builtin_amdgcn_sched_barrier(0)
#define PG8_GOFF(dst, u) do { _Pragma("unroll") for (int hf_ = 0; hf_ < 2; ++hf_) _Pragma("unroll") for (int i_ = 0; i_ < 2; ++i_) \
        dst[hf_][i_] = (unsigned)idxtab[(u).li * 256 + hf_ * 128 + RA[i_]] * (unsigned)(K * 2) + (unsigned)CA2[i_]; } while (0)
    Unit cur, nxt; int ui = 0;
    if (!S.next(0, cur)) return;
    f32x4 acc[2][2][4][2];
#pragma unroll
    for (int a = 0; a < 2; ++a)
#pragma unroll
        for (int b = 0; b < 2; ++b)
#pragma unroll
            for (int m = 0; m < 4; ++m)
#pragma unroll
                for (int n = 0; n < 2; ++n) acc[a][b][m][n] = (f32x4){0.f, 0.f, 0.f, 0.f};
    bf16x8 At[4][2], B0[2][2], B1[2][2];
    unsigned goffC[2][2] = {{0u, 0u}, {0u, 0u}}, goffN[2][2] = {{0u, 0u}, {0u, 0u}};
    if constexpr (GATHER) { PG8_GOFF(goffC, cur); }
    const char* cA = GATHER ? (const char*)g.A : (const char*)g.A + (size_t)cur.pm * tstep; const char* cB = (const char*)g.Bt + (size_t)cur.pb * tstep;
    PG8_STAGE(PG8_SB(0, 0), cB, voffB); PG8_STAGE(PG8_SB(0, 1), cB + hstep, voffB); PG8_STAGE_A(PG8_SA(0, 0), 0, cA, false); PG8_STAGE_A(PG8_SA(0, 1), 1, cA, false);
    if (wr == 1) PG8_BAR;
    PG8_WAIT_V(2); PG8_BAR;
    PG8_STAGE(PG8_SB(1, 0), cB + kstep, voffB); PG8_STAGE_A(PG8_SA(1, 0), 0, cA + kstep, false); PG8_STAGE(PG8_SB(1, 1), cB + hstep + kstep, voffB);
    PG8_WAIT_V(6); PG8_BAR;
    for (;;) {
        const bool has_next = S.next(ui + 1, nxt);
        const char* nA = GATHER ? cA : (has_next ? (const char*)g.A + (size_t)nxt.pm * tstep : cA); const char* nB = has_next ? (const char*)g.Bt + (size_t)nxt.pb * tstep : cB;
        if constexpr (GATHER) { if (has_next) { PG8_GOFF(goffN, nxt); } else {
#pragma unroll
            for (int hf = 0; hf < 2; ++hf) { goffN[hf][0] = goffC[hf][0]; goffN[hf][1] = goffC[hf][1]; } } }
        for (int t = 0; t < nt; t += 2) {
            const bool last = (t == nt - 2);
            const char* a1 = cA + (size_t)(t + 1) * kstep;
            const char* a2 = last ? nA : cA + (size_t)(t + 2) * kstep; const char* b2 = last ? nB : cB + (size_t)(t + 2) * kstep;
            const char* a3 = a2 + kstep; const char* b3 = b2 + kstep;
            if constexpr (RESCALE) { if (t == nt / 2) { const LAS float* sd = (const LAS float*)(lds + SIDE_OFF) + (size_t)cur.li * 512;
#pragma unroll
                for (int ai = 0; ai < 2; ++ai)
#pragma unroll
                    for (int m = 0; m < 4; ++m) { const float f = sd[2 * (ai * HALF + wr * 64 + m * 16 + fr)];
#pragma unroll
                        for (int bj = 0; bj < 2; ++bj)
#pragma unroll
                            for (int n = 0; n < 2; ++n) acc[ai][bj][m][n] = acc[ai][bj][m][n] * f; } } }
            PG8_LDB(B0, 0, 0); PG8_LDB(B1, 0, 1); PG8_SCHED; PG8_LDA(At, 0, 0); PG8_STAGE_A(PG8_SA(1, 1), 1, a1, false);
            PG8_WAIT_V(8); PG8_WAIT_L(0); PG8_BAR; PG8_MMA(0, 0, At, B0); PG8_MMA(0, 1, At, B1); PG8_BAR; PG8_SCHED;
            PG8_LDA(At, 0, 1); PG8_STAGE(PG8_SB(0, 0), b2, voffB); PG8_STAGE(PG8_SB(0, 1), b2 + hstep, voffB); PG8_STAGE_A(PG8_SA(0, 0), 0, a2, last);
            PG8_WAIT_V(8); PG8_WAIT_L(0); PG8_BAR; PG8_MMA(1, 0, At, B0); PG8_MMA(1, 1, At, B1); PG8_BAR; PG8_SCHED;
            PG8_LDB(B0, 1, 0); PG8_LDB(B1, 1, 1); PG8_SCHED; PG8_LDA(At, 1, 0); PG8_STAGE_A(PG8_SA(0, 1), 1, a2, last);
            PG8_WAIT_V(8); PG8_WAIT_L(0); PG8_BAR; PG8_MMA(0, 0, At, B0); PG8_MMA(0, 1, At, B1); PG8_BAR; PG8_SCHED;
            PG8_LDA(At, 1, 1); PG8_STAGE(PG8_SB(1, 0), b3, voffB); PG8_STAGE(PG8_SB(1, 1), b3 + hstep, voffB); PG8_STAGE_A(PG8_SA(1, 0), 0, a3, last);
            PG8_WAIT_V(8); PG8_WAIT_L(0); PG8_BAR; PG8_MMA(1, 0, At, B0); PG8_MMA(1, 1, At, B1); PG8_BAR; PG8_SCHED;
        }
        if (wr == 0) PG8_BAR;
        E(acc, cur, wr, wc, fr, fq);
        if (!has_next) break;
#pragma unroll
        for (int a = 0; a < 2; ++a)
#pragma unroll
            for (int b = 0; b < 2; ++b)
#pragma unroll
                for (int m = 0; m < 4; ++m)
#pragma unroll
                    for (int n = 0; n < 2; ++n) acc[a][b][m][n] = (f32x4){0.f, 0.f, 0.f, 0.f};
        cur = nxt; cA = nA; cB = nB; ++ui;
        if constexpr (GATHER) {
#pragma unroll
            for (int hf = 0; hf < 2; ++hf) { goffC[hf][0] = goffN[hf][0]; goffC[hf][1] = goffN[hf][1]; } }
        if (wr == 1) PG8_BAR;
    }
    PG8_WAIT_V(0);
    PG8_BAR;
#undef PG8_SA
#undef PG8_SB
#undef PG8_STAGE
#undef PG8_STAGE2
#undef PG8_STAGE_A
#undef PG8_LDA
#undef PG8_LDB
#undef PG8_MMA
#undef PG8_WAIT_V
#undef PG8_WAIT_L
#undef PG8_BAR
#undef PG8_SCHED
#undef PG8_GOFF
}

struct EpiQKV {
    static constexpr bool PERM = true;
    bf16_t* O;
    __device__ __forceinline__ void operator()(const f32x4 (&acc)[2][2][4][2], const Unit& u, int wr, int wc, int fr, int fq) const {
        const int row0 = u.pm * BM + wr * 64 + fr; const int colt = u.pn * BM; const int t = colt >> 9;
        bf16_t* base = O + (size_t)t * M * DH; const float sc = (t == 0 || t == 3) ? C2 : 1.0f;
        const int col0 = (colt & 511) + wc * 32 + 8 * fq;
#pragma unroll
        for (int ai = 0; ai < 2; ++ai)
#pragma unroll
            for (int m = 0; m < 4; ++m) { bf16_t* rowp = base + (size_t)(row0 + ai * HALF + m * 16) * DH + col0;
#pragma unroll
                for (int bj = 0; bj < 2; ++bj) { const f32x4 v0 = acc[ai][bj][m][0] * sc, v1 = acc[ai][bj][m][1] * sc;
                    u32x4 w; w.x = cvt_pk_bf16(v0[0], v0[1]); w.y = cvt_pk_bf16(v0[2], v0[3]); w.z = cvt_pk_bf16(v1[0], v1[1]); w.w = cvt_pk_bf16(v1[2], v1[3]);
                    *(u32x4*)(rowp + bj * HALF) = w; } }
    }
};
struct EpiY {
    static constexpr bool PERM = true;
    bf16_t* O; int ldc;
    __device__ __forceinline__ void operator()(const f32x4 (&acc)[2][2][4][2], const Unit& u, int wr, int wc, int fr, int fq) const {
        const int row0 = u.pm * BM + wr * 64 + fr; const int col0 = u.pn * BM + wc * 32 + 8 * fq;
#pragma unroll
        for (int ai = 0; ai < 2; ++ai)
#pragma unroll
            for (int m = 0; m < 4; ++m) { bf16_t* rowp = O + (size_t)(row0 + ai * HALF + m * 16) * ldc + col0;
#pragma unroll
                for (int bj = 0; bj < 2; ++bj) { const f32x4 v0 = acc[ai][bj][m][0], v1 = acc[ai][bj][m][1];
                    u32x4 w; w.x = cvt_pk_bf16(v0[0], v0[1]); w.y = cvt_pk_bf16(v0[2], v0[3]); w.z = cvt_pk_bf16(v1[0], v1[1]); w.w = cvt_pk_bf16(v1[2], v1[3]);
                    *(u32x4*)(rowp + bj * HALF) = w; } }
    }
};
struct EpiSwiGLU {
    static constexpr bool PERM = true;
    bf16_t* O;
    __device__ __forceinline__ void operator()(const f32x4 (&acc)[2][2][4][2], const Unit& u, int wr, int wc, int fr, int fq) const {
        const int row0 = u.pm * BM + wr * 64 + fr; const int col0 = u.pn * 128 + wc * 16 + 4 * fq;
#pragma unroll
        for (int ai = 0; ai < 2; ++ai)
#pragma unroll
            for (int m = 0; m < 4; ++m) { bf16_t* rowp = O + (size_t)(row0 + ai * HALF + m * 16) * DFF + col0;
#pragma unroll
                for (int bj = 0; bj < 2; ++bj) { const f32x4 ga = acc[ai][bj][m][0], up = acc[ai][bj][m][1]; float hv[4];
#pragma unroll
                    for (int i = 0; i < 4; ++i) hv[i] = ga[i] * __builtin_amdgcn_rcpf(1.0f + __builtin_amdgcn_exp2f(-LOG2E * ga[i])) * up[i];
                    u32x2 w; w.x = cvt_pk_bf16(hv[0], hv[1]); w.y = cvt_pk_bf16(hv[2], hv[3]);
                    *(u32x2*)(rowp + bj * 64) = w; } }
    }
};
struct EpiOutProj {
    static constexpr bool PERM = false;
    const float* x; float* x1; const float* mod; const LAS float* side;
    __device__ __forceinline__ void operator()(const f32x4 (&acc)[2][2][4][2], const Unit& u, int wr, int wc, int fr, int fq) const {
        const int b = (u.pm * BM) / SEQ; const int col0 = u.pn * BM + wc * 32 + 4 * fq;
        f32x4 gate[2][2];
#pragma unroll
        for (int bj = 0; bj < 2; ++bj)
#pragma unroll
            for (int n = 0; n < 2; ++n) gate[bj][n] = *(const f32x4*)(mod + b * 6144 + 2048 + col0 + bj * HALF + n * 16);
#pragma unroll
        for (int ai = 0; ai < 2; ++ai)
#pragma unroll
            for (int m = 0; m < 4; ++m) { const int rl = ai * HALF + wr * 64 + m * 16 + fr; const float rss = side[(size_t)u.li * 512 + 2 * rl + 1];
                const size_t off = (size_t)(u.pm * BM + rl) * D + col0;
#pragma unroll
                for (int bj = 0; bj < 2; ++bj)
#pragma unroll
                    for (int n = 0; n < 2; ++n) { const f32x4 xv = *(const f32x4*)(x + off + bj * HALF + n * 16);
                        *(f32x4*)(x1 + off + bj * HALF + n * 16) = xv + gate[bj][n] * (acc[ai][bj][m][n] * rss); }
                if (m & 1) asm volatile("" ::: "memory"); }
    }
};
}

__device__ __forceinline__ void phase_qkv_simple(Frame& F) {
    const int r = F.lane & 31, h = F.lane >> 5, wm = F.wave >> 1, wn = F.wave & 1;
    constexpr int NPN = 3 * D / 128;
    for (int u = F.vcu; u < (M / 256) * NPN; u += F.G) {
        const int pm = u / NPN, pn = u % NPN, m0 = pm * 256 + wm * 64, n0 = pn * 128 + wn * 64;
        const bf16* pa[2] = {F.HB + (size_t)(m0 + r) * D + 8 * h, F.HB + (size_t)(m0 + 32 + r) * D + 8 * h};
        const bf16* pb[2] = {F.WinT + (size_t)(n0 + r) * D + 8 * h, F.WinT + (size_t)(n0 + 32 + r) * D + 8 * h};
        f32x16 acc[2][2]; sg_zero<2>(acc);
        sg_mainloop<2>(acc, pa, pb, 0, D);
#pragma unroll
        for (int ni = 0; ni < 2; ++ni)
#pragma unroll
            for (int mi = 0; mi < 2; ++mi)
#pragma unroll
                for (int g = 0; g < 4; ++g) {
                    const int n = n0 + 32 * ni + 8 * g + 4 * h, t = n >> 9, col = n & 511; const int m = m0 + 32 * mi + r;
                    const float sc = (t == 0 || t == 3) ? C2 : 1.0f;
                    u32x2 w; w.x = pk2(acc[ni][mi][4 * g] * sc, acc[ni][mi][4 * g + 1] * sc); w.y = pk2(acc[ni][mi][4 * g + 2] * sc, acc[ni][mi][4 * g + 3] * sc);
                    *(u32x2*)(F.QKV + (size_t)t * M * DH + (size_t)m * DH + col) = w;
                }
    }
}

__device__ __forceinline__ void load_row64(const bf16* p, float (&q)[64]) {
#pragma unroll
    for (int i = 0; i < 8; ++i) { const u32x4 w = *(const u32x4*)(p + 8 * i);
        q[8 * i + 0] = __uint_as_float(w.x << 16); q[8 * i + 1] = __uint_as_float(w.x & 0xffff0000u); q[8 * i + 2] = __uint_as_float(w.y << 16); q[8 * i + 3] = __uint_as_float(w.y & 0xffff0000u);
        q[8 * i + 4] = __uint_as_float(w.z << 16); q[8 * i + 5] = __uint_as_float(w.z & 0xffff0000u); q[8 * i + 6] = __uint_as_float(w.w << 16); q[8 * i + 7] = __uint_as_float(w.w & 0xffff0000u); }
}
__device__ __forceinline__ float dot_row64(const bf16* p, const float (&q)[64]) {
    float s0 = 0.f, s1 = 0.f;
#pragma unroll
    for (int i = 0; i < 8; ++i) { const u32x4 w = *(const u32x4*)(p + 8 * i);
        s0 += q[8 * i + 0] * __uint_as_float(w.x << 16); s1 += q[8 * i + 1] * __uint_as_float(w.x & 0xffff0000u); s0 += q[8 * i + 2] * __uint_as_float(w.y << 16); s1 += q[8 * i + 3] * __uint_as_float(w.y & 0xffff0000u);
        s0 += q[8 * i + 4] * __uint_as_float(w.z << 16); s1 += q[8 * i + 5] * __uint_as_float(w.z & 0xffff0000u); s0 += q[8 * i + 6] * __uint_as_float(w.w << 16); s1 += q[8 * i + 7] * __uint_as_float(w.w & 0xffff0000u); }
    return s0 + s1;
}
__device__ __forceinline__ void axpy_row64(const bf16* p, float w_, float (&o)[64]) {
#pragma unroll
    for (int i = 0; i < 8; ++i) { const u32x4 w = *(const u32x4*)(p + 8 * i);
        o[8 * i + 0] += w_ * __uint_as_float(w.x << 16); o[8 * i + 1] += w_ * __uint_as_float(w.x & 0xffff0000u); o[8 * i + 2] += w_ * __uint_as_float(w.y << 16); o[8 * i + 3] += w_ * __uint_as_float(w.y & 0xffff0000u);
        o[8 * i + 4] += w_ * __uint_as_float(w.z << 16); o[8 * i + 5] += w_ * __uint_as_float(w.z & 0xffff0000u); o[8 * i + 6] += w_ * __uint_as_float(w.w << 16); o[8 * i + 7] += w_ * __uint_as_float(w.w & 0xffff0000u); }
}
__device__ __forceinline__ void store_o64(bf16* p, const float (&o)[64], float sc, float& ssq) {
    float s = 0.f;
#pragma unroll
    for (int i = 0; i < 8; ++i) { float v[8];
#pragma unroll
        for (int j = 0; j < 8; ++j) { v[j] = o[8 * i + j] * sc; s += v[j] * v[j]; }
        u32x4 w; w.x = pk2(v[0], v[1]); w.y = pk2(v[2], v[3]); w.z = pk2(v[4], v[5]); w.w = pk2(v[6], v[7]); *(u32x4*)(p + 8 * i) = w; }
    ssq = s;
}
__device__ __forceinline__ void phase_attn_naive(Frame& F) {
    const bf16* QD = F.QKV; const bf16* KD = F.QKV + (size_t)M * DH; const bf16* VD = F.QKV + (size_t)2 * M * DH;
    const bf16* QS = F.QKV + (size_t)3 * M * DH; const bf16* KS = F.QKV + (size_t)4 * M * DH; const bf16* VS = F.QKV + (size_t)5 * M * DH;
    const int total = 2 * M * NH;
    for (int idx = blockIdx.x * NTHREADS + F.tid; idx < total; idx += F.G * NTHREADS) {
        const int t = idx % SEQ, hh = (idx / SEQ) % NH, b = (idx / (SEQ * NH)) % NB, type = idx / (SEQ * NH * NB);
        const size_t m = (size_t)b * SEQ + t;
        float q[64], o[64];
#pragma unroll
        for (int i = 0; i < 64; ++i) o[i] = 0.f;
        float ssq = 0.f;
        if (type == 0) {
            load_row64(QD + m * DH + hh * HD, q);
            const float slope2 = exp2f(-(float)(hh + 1)) * LOG2E;
            float mx = -INFINITY, l = 0.f;
            for (int p = 0; p < 3; ++p) {
                const int d = (p == 0) ? 1 : (p == 1) ? 4 : 16;
                for (int j = 0; j <= 128; ++j) {
                    const int pos = t - j * d; if (pos < 0) break;
                    const size_t km = (size_t)b * SEQ + pos;
                    const float s = dot_row64(KD + km * DH + hh * HD, q) - slope2 * (float)(j * d);
                    const float mn = fmaxf(mx, s), f = exp2f(mx - mn), pw = exp2f(s - mn);
                    l = l * f + pw;
#pragma unroll
                    for (int i = 0; i < 64; ++i) o[i] *= f;
                    axpy_row64(VD + km * DH + hh * HD, pw, o);
                    mx = mn;
                }
            }
            store_o64(F.OB + m * D + hh * HD, o, 1.0f / l, ssq);
        } else {
            load_row64(QS + m * DH + hh * HD, q);
            float R = 1.0f;
            for (int s_ = t - 1; s_ >= 0; --s_) {
                const size_t km = (size_t)b * SEQ + s_;
                const float z2 = fminf(dot_row64(KS + km * DH + hh * HD, q), 100.0f);
                const float e = exp2f(z2), cc = 1.0f / (1.0f + e), w_ = e * cc * R;
                axpy_row64(VS + km * DH + hh * HD, w_, o);
                R *= cc;
                if (R < 1e-30f) break;
            }
            store_o64(F.OB + m * D + DH + hh * HD, o, 1.0f, ssq);
        }
        atomicAdd(F.ssq + 2 * m + type, ssq);
    }
}

__device__ __forceinline__ void phase_outproj_simple(Frame& F) {
    const int r = F.lane & 31, h = F.lane >> 5, wm = F.wave >> 1, wn = F.wave & 1;
    constexpr int NPN = D / 128;
    float* x1 = F.out;
    for (int u = F.vcu; u < (M / 256) * NPN; u += F.G) {
        const int pm = u / NPN, pn = u % NPN, m0 = pm * 256 + wm * 64, n0 = pn * 128 + wn * 64;
        const bf16* pa[2] = {F.OB + (size_t)(m0 + r) * D + 8 * h, F.OB + (size_t)(m0 + 32 + r) * D + 8 * h};
        const bf16* pb[2] = {F.WoutT + (size_t)(n0 + r) * D + 8 * h, F.WoutT + (size_t)(n0 + 32 + r) * D + 8 * h};
        float rsd[2], rss[2];
#pragma unroll
        for (int mi = 0; mi < 2; ++mi) { const int m = m0 + 32 * mi + r; rsd[mi] = 1.0f / sqrtf(F.ssq[2 * m] * (1.f / DH) + NORM_EPS); rss[mi] = 1.0f / sqrtf(F.ssq[2 * m + 1] * (1.f / DH) + NORM_EPS); }
        f32x16 acc[2][2]; sg_zero<2>(acc);
        sg_mainloop<2>(acc, pa, pb, 0, DH);
#pragma unroll
        for (int ni = 0; ni < 2; ++ni)
#pragma unroll
            for (int mi = 0; mi < 2; ++mi) acc[ni][mi] = acc[ni][mi] * (rsd[mi] / rss[mi]);
        sg_mainloop<2>(acc, pa, pb, DH, D);
        const int b = m0 / SEQ;
#pragma unroll
        for (int ni = 0; ni < 2; ++ni)
#pragma unroll
            for (int mi = 0; mi < 2; ++mi)
#pragma unroll
                for (int g = 0; g < 4; ++g) {
                    const int n = n0 + 32 * ni + 8 * g + 4 * h; const int m = m0 + 32 * mi + r;
                    const f32x4 gate = *(const f32x4*)(F.mod + b * 6144 + 2048 + n), xv = *(const f32x4*)(F.x + (size_t)m * D + n);
                    f32x4 a; a.x = acc[ni][mi][4 * g]; a.y = acc[ni][mi][4 * g + 1]; a.z = acc[ni][mi][4 * g + 2]; a.w = acc[ni][mi][4 * g + 3];
                    *(f32x4*)(x1 + (size_t)m * D + n) = xv + gate * (a * rss[mi]);
                }
    }
}

__device__ __forceinline__ void phase_router(Frame& F) {
    LAS float* WR = (LAS float*)F.lds;
    for (int i = F.tid; i < D * 36; i += NTHREADS) { const int k = i / 36, c = i % 36; const int slot = ((k >> 8) * 4 + (k & 3)) * 64 + ((k >> 2) & 63);
        WR[slot * 36 + c] = (c < 4) ? F.w_group[k * 4 + c] : F.w_expert[k * 32 + (c - 4)]; }
    __syncthreads();
    const int gw = F.vcu * NWAVES + F.wave, NGW = F.G * NWAVES;
    const float* x1 = F.out;
    for (int ch = gw; ch < M / 32; ch += NGW) {
        const int b = ch / (SEQ / 32);
        f32x4 gs[4], sh[4];
#pragma unroll
        for (int j = 0; j < 4; ++j) { const int col = 4 * F.lane + 256 * j;
            const f32x4 g = *(const f32x4*)(F.g_ffn + col), scl = *(const f32x4*)(F.mod + b * 6144 + 4096 + col); sh[j] = *(const f32x4*)(F.mod + b * 6144 + 3072 + col);
            gs[j] = g * (scl + 1.0f); }
        int my_e1 = 0, my_e2 = 0; float my_w1 = 0.f, my_w2 = 0.f;
        for (int rr = 0; rr < 32; ++rr) {
            const size_t m = (size_t)ch * 32 + rr;
            const f32x4* xr = (const f32x4*)(x1 + m * D) + F.lane;
            f32x4 v[4]; float s = 0.f;
#pragma unroll
            for (int j = 0; j < 4; ++j) { v[j] = xr[64 * j]; s += (v[j].x * v[j].x + v[j].y * v[j].y) + (v[j].z * v[j].z + v[j].w * v[j].w); }
            const float rs = 1.0f / sqrtf(wave_sum(s) * (1.f / D) + NORM_EPS);
            unsigned long long* o8 = (unsigned long long*)(F.HB + m * D) + F.lane;
            float gl[4] = {0.f, 0.f, 0.f, 0.f};
#pragma unroll
            for (int j = 0; j < 4; ++j) { v[j] = v[j] * rs * gs[j] + sh[j];
                o8[64 * j] = (unsigned long long)pk2(v[j].x, v[j].y) | ((unsigned long long)pk2(v[j].z, v[j].w) << 32);
#pragma unroll
                for (int i = 0; i < 4; ++i) { const f32x4 w = *(const LAS f32x4*)(WR + ((j * 4 + i) * 64 + F.lane) * 36); const float hv = v[j][i];
                    gl[0] += hv * w.x; gl[1] += hv * w.y; gl[2] += hv * w.z; gl[3] += hv * w.w; } }
#pragma unroll
            for (int i = 0; i < 4; ++i) gl[i] = wave_sum(gl[i]);
            int grp = 0; float gmax = gl[0];
#pragma unroll
            for (int i = 1; i < 4; ++i) if (gl[i] > gmax) { gmax = gl[i]; grp = i; }
            float gden = 0.f;
#pragma unroll
            for (int i = 0; i < 4; ++i) gden += __expf(gl[i] - gmax);
            const float ggate = 1.0f / gden;
            grp = __builtin_amdgcn_readfirstlane(grp);
            float el[8];
#pragma unroll
            for (int i = 0; i < 8; ++i) el[i] = 0.f;
#pragma unroll
            for (int j = 0; j < 4; ++j)
#pragma unroll
                for (int i = 0; i < 4; ++i) { const LAS float* wp = WR + ((j * 4 + i) * 64 + F.lane) * 36 + 4 + grp * 8; const f32x4 w0 = *(const LAS f32x4*)wp, w1 = *(const LAS f32x4*)(wp + 4); const float hv = v[j][i];
                    el[0] += hv * w0.x; el[1] += hv * w0.y; el[2] += hv * w0.z; el[3] += hv * w0.w; el[4] += hv * w1.x; el[5] += hv * w1.y; el[6] += hv * w1.z; el[7] += hv * w1.w; }
#pragma unroll
            for (int i = 0; i < 8; ++i) el[i] = wave_sum(el[i]);
            int i1 = 0; float l1 = el[0];
#pragma unroll
            for (int i = 1; i < 8; ++i) if (el[i] > l1) { l1 = el[i]; i1 = i; }
            int i2 = -1; float l2 = -INFINITY;
#pragma unroll
            for (int i = 0; i < 8; ++i) if (i != i1 && el[i] > l2) { l2 = el[i]; i2 = i; }
            const float p2 = 1.0f / (1.0f + __expf(l1 - l2)), p1 = 1.0f - p2;
            if (F.lane == rr) { my_e1 = grp * 8 + i1; my_e2 = grp * 8 + i2; my_w1 = ggate * p1; my_w2 = ggate * p2; }
        }
        if (F.lane < 32) {
            const int m = ch * 32 + F.lane;
            const int pos1 = (int)atomicAdd(F.cnt + 64 * my_e1, 1u), pos2 = (int)atomicAdd(F.cnt + 64 * my_e2, 1u);
            F.list[(size_t)my_e1 * LIST_CAP + pos1] = m; F.list[(size_t)my_e2 * LIST_CAP + pos2] = m;
            i32x4 ts; ts.x = my_e1; ts.y = pos1; ts.z = my_e2; ts.w = pos2; F.tokslot[m] = ts;
            F.tokw[2 * m] = my_w1; F.tokw[2 * m + 1] = my_w2;
        }
    }
}

__device__ __forceinline__ void build_tiles(Frame& F) {
    __syncthreads();
    if (F.tid == 0) { unsigned acc = 0; for (int e = 0; e < NE; ++e) { F.MISC[e] = acc; acc += (__hip_atomic_load(F.cnt + 64 * e, __ATOMIC_RELAXED, __HIP_MEMORY_SCOPE_AGENT) + 255u) >> 8; } F.MISC[NE] = acc; }
    __syncthreads();
}
__device__ __forceinline__ int find_expert(Frame& F, int tile) { int e = 0;
#pragma unroll 1
    for (int i = 1; i < NE; ++i) if ((int)F.MISC[i] <= tile) e = i; else break;
    return e; }

__device__ __forceinline__ void phase_moe1_simple(Frame& F) {
    build_tiles(F);
    const int r = F.lane & 31, h = F.lane >> 5, wm = F.wave >> 1, wn = F.wave & 1;
    const int T = (int)F.MISC[NE];
    for (int u = F.vcu; u < T * 8; u += F.G) {
        const int tile = u >> 3, cn = u & 7, e = find_expert(F, tile), jt = tile - (int)F.MISC[e];
        const int cnt = (int)__hip_atomic_load(F.cnt + 64 * e, __ATOMIC_RELAXED, __HIP_MEMORY_SCOPE_AGENT);
        const bf16* pa[2];
#pragma unroll
        for (int mi = 0; mi < 2; ++mi) { const int pos = jt * 256 + wm * 64 + 32 * mi + r; const int tok = (pos < cnt) ? F.list[(size_t)e * LIST_CAP + pos] : 0; pa[mi] = F.HB + (size_t)tok * D + 8 * h; }
        const int j0 = cn * 64 + wn * 32, jj = j0 + r;
        const bf16* Wb = F.WguT + (size_t)e * D * D;
        const bf16* pb[2] = {Wb + (size_t)(8 * (jj >> 2) + (jj & 3)) * D + 8 * h, Wb + (size_t)(8 * (jj >> 2) + 4 + (jj & 3)) * D + 8 * h};
        f32x16 acc[2][2]; sg_zero<2>(acc);
        sg_mainloop<2>(acc, pa, pb, 0, D);
#pragma unroll
        for (int mi = 0; mi < 2; ++mi)
#pragma unroll
            for (int g = 0; g < 4; ++g) {
                const size_t row = (size_t)tile * 256 + wm * 64 + 32 * mi + r; const int col = j0 + 8 * g + 4 * h;
                float hv[4];
#pragma unroll
                for (int i = 0; i < 4; ++i) { const float ga = acc[0][mi][4 * g + i], up = acc[1][mi][4 * g + i]; hv[i] = ga / (1.0f + __expf(-ga)) * up; }
                u32x2 w; w.x = pk2(hv[0], hv[1]); w.y = pk2(hv[2], hv[3]);
                *(u32x2*)(F.HM + row * DFF + col) = w;
            }
    }
}
__device__ __forceinline__ void phase_moe2_simple(Frame& F) {
    build_tiles(F);
    const int r = F.lane & 31, h = F.lane >> 5, wm = F.wave >> 1, wn = F.wave & 1;
    const int T = (int)F.MISC[NE];
    for (int u = F.vcu; u < T * 8; u += F.G) {
        const int tile = u >> 3, pn = u & 7, e = find_expert(F, tile);
        const size_t row0 = (size_t)tile * 256 + wm * 64; const int n0 = pn * 128 + wn * 64;
        const bf16* pa[2] = {F.HM + (row0 + r) * DFF + 8 * h, F.HM + (row0 + 32 + r) * DFF + 8 * h};
        const bf16* Wb = F.WdT + (size_t)e * D * DFF;
        const bf16* pb[2] = {Wb + (size_t)(n0 + r) * DFF + 8 * h, Wb + (size_t)(n0 + 32 + r) * DFF + 8 * h};
        f32x16 acc[2][2]; sg_zero<2>(acc);
        sg_mainloop<2>(acc, pa, pb, 0, DFF);
#pragma unroll
        for (int ni = 0; ni < 2; ++ni)
#pragma unroll
            for (int mi = 0; mi < 2; ++mi)
#pragma unroll
                for (int g = 0; g < 4; ++g) {
                    const size_t row = row0 + 32 * mi + r; const int n = n0 + 32 * ni + 8 * g + 4 * h;
                    u32x2 w; w.x = pk2(acc[ni][mi][4 * g], acc[ni][mi][4 * g + 1]); w.y = pk2(acc[ni][mi][4 * g + 2], acc[ni][mi][4 * g + 3]);
                    *(u32x2*)(F.YB + row * D + n) = w;
                }
    }
}
__device__ __forceinline__ f32x4 ld_bf4(const bf16* p) { const u32x2 w = *(const u32x2*)p; f32x4 r; r.x = __uint_as_float(w.x << 16); r.y = __uint_as_float(w.x & 0xffff0000u); r.z = __uint_as_float(w.y << 16); r.w = __uint_as_float(w.y & 0xffff0000u); return r; }
__device__ __forceinline__ void phase_final(Frame& F) {
    build_tiles(F);
    const int gw = F.vcu * NWAVES + F.wave, NGW = F.G * NWAVES;
    for (int ch = gw; ch < M / 32; ch += NGW) {
        const int b = ch / (SEQ / 32);
        f32x4 gate[4], gf[4];
#pragma unroll
        for (int j = 0; j < 4; ++j) { const int col = 4 * F.lane + 256 * j; gate[j] = *(const f32x4*)(F.mod + b * 6144 + 5120 + col); gf[j] = *(const f32x4*)(F.g_final + col); }
        for (int rr = 0; rr < 32; ++rr) {
            const size_t m = (size_t)ch * 32 + rr;
            const i32x4 ts = F.tokslot[m]; const float w1 = F.tokw[2 * m], w2 = F.tokw[2 * m + 1];
            const size_t ra = (size_t)F.MISC[ts.x] * 256 + ts.y, rb = (size_t)F.MISC[ts.z] * 256 + ts.w;
            f32x4* xr = (f32x4*)(F.out + m * D) + F.lane;
            f32x4 v[4]; float s = 0.f;
#pragma unroll
            for (int j = 0; j < 4; ++j) { const int col = 4 * F.lane + 256 * j;
                const f32x4 ya = ld_bf4(F.YB + ra * D + col), yb = ld_bf4(F.YB + rb * D + col);
                v[j] = xr[64 * j] + gate[j] * (ya * w1 + yb * w2);
                s += (v[j].x * v[j].x + v[j].y * v[j].y) + (v[j].z * v[j].z + v[j].w * v[j].w); }
            const float rs = 1.0f / sqrtf(wave_sum(s) * (1.f / D) + NORM_EPS);
#pragma unroll
            for (int j = 0; j < 4; ++j) xr[64 * j] = v[j] * rs * gf[j];
        }
    }
}

__device__ __forceinline__ void phase_qkv_fast(Frame& F) {
    pg8::Gemm g{F.HB, F.WinT, D}; pg8::StaticOrder S; S.init(M, 3 * D, F.G, (int)blockIdx.x);
    pg8::EpiQKV E{F.QKV};
    pg8::gemm_phase<pg8::EpiQKV, pg8::StaticOrder, 0>(F.lds, g, S, E);
}
__device__ __forceinline__ void phase_outproj_fast(Frame& F) {
    pg8::StaticOrder S; S.init(M, D, F.G, (int)blockIdx.x);
    LAS float* side = (LAS float*)(F.lds + pg8::SIDE_OFF);
    pg8::Unit u;
    for (int i = 0; i < 8 && S.next(i, u); ++i) {
        if (F.tid < 256) { const int m = u.pm * 256 + F.tid; const float rsd = 1.0f / sqrtf(F.ssq[2 * m] * (1.f / DH) + NORM_EPS), rss = 1.0f / sqrtf(F.ssq[2 * m + 1] * (1.f / DH) + NORM_EPS);
            side[(i * 256 + F.tid) * 2] = rsd / rss; side[(i * 256 + F.tid) * 2 + 1] = rss; }
    }
    __syncthreads();
    pg8::Gemm g{F.OB, F.WoutT, D};
    pg8::EpiOutProj E{F.x, F.out, F.mod, (const LAS float*)side};
    pg8::gemm_phase<pg8::EpiOutProj, pg8::StaticOrder, 2>(F.lds, g, S, E);
}
struct MoeOrder {
    const volatile LAS unsigned* ts; int T4, G, c;
    __device__ __forceinline__ bool next(int i, pg8::Unit& u) const {
        const int L = i * G + c; if (L >= T4) return false;
        const int tile = L >> 2, pn = L & 3; int e = 0;
#pragma unroll 1
        for (int k = 1; k < NE; ++k) { if ((int)ts[k] <= tile) e = k; else break; }
        u.pm = tile; u.pn = pn; u.pb = e * 4 + pn; u.li = i; return true;
    }
};
__device__ __forceinline__ void phase_moe1_fast(Frame& F) {
    build_tiles(F);
    MoeOrder S{F.MISC, 4 * (int)F.MISC[NE], F.G, F.vcu};
    LAS int* idxtab = (LAS int*)(F.lds + pg8::SIDE_OFF);
    pg8::Unit u;
    for (int i = 0; i < 16 && S.next(i, u); ++i) {
        if (F.tid < 256) { const int e = u.pb >> 2, jt = u.pm - (int)F.MISC[e]; const int cnt = (int)__hip_atomic_load(F.cnt + 64 * e, __ATOMIC_RELAXED, __HIP_MEMORY_SCOPE_AGENT);
            const int pos = jt * 256 + F.tid; idxtab[i * 256 + F.tid] = (pos < cnt) ? F.list[(size_t)e * LIST_CAP + pos] : 0; }
    }
    __syncthreads();
    pg8::Gemm g{F.HB, F.WguT, D};
    pg8::EpiSwiGLU E{F.HM};
    pg8::gemm_phase<pg8::EpiSwiGLU, MoeOrder, 1>(F.lds, g, S, E);
}
__device__ __forceinline__ void phase_moe2_fast(Frame& F) {
    build_tiles(F);
    MoeOrder S{F.MISC, 4 * (int)F.MISC[NE], F.G, F.vcu};
    pg8::Gemm g{F.HM, F.WdT, DFF};
    pg8::EpiY E{F.YB, D};
    pg8::gemm_phase<pg8::EpiY, MoeOrder, 0>(F.lds, g, S, E);
}

constexpr int N_PHASES = 9;
struct Args { const float* in[16]; float* out; unsigned char* ws; int ph_lo, ph_hi; };
__global__ void __launch_bounds__(NTHREADS, 2) mk_fwd(Args args) {
    extern __shared__ __attribute__((aligned(16))) unsigned char lds[];
    Frame F;
    F.lds = (LAS unsigned char*)lds; F.MISC = (volatile LAS unsigned*)(F.lds + MISC_OFF);
    F.tid = threadIdx.x; F.lane = F.tid & 63; F.wave = __builtin_amdgcn_readfirstlane(F.tid >> 6);
    F.G = gridDim.x; { const int bx = blockIdx.x; F.vcu = (F.G % 8 == 0) ? (bx % 8) * (F.G / 8) + bx / 8 : bx; }
    unsigned char* ws = args.ws; F.ws = ws; F.ctl = (unsigned*)(ws + WS_CTL);
    F.x = args.in[0]; F.c = args.in[1]; F.w_ada = args.in[2]; F.b_ada = args.in[3]; F.g_mix = args.in[4]; F.w_in = args.in[5]; F.g_dil = args.in[6]; F.g_sb = args.in[7];
    F.w_out = args.in[8]; F.g_ffn = args.in[9]; F.w_group = args.in[10]; F.w_expert = args.in[11]; F.w_gate = args.in[12]; F.w_up = args.in[13]; F.w_down = args.in[14]; F.g_final = args.in[15];
    F.out = args.out;
    F.mod = (float*)(ws + WS_MOD); F.WinT = (bf16*)(ws + WS_WIN); F.WoutT = (bf16*)(ws + WS_WOUT); F.WguT = (bf16*)(ws + WS_WGU); F.WdT = (bf16*)(ws + WS_WD);
    F.HB = (bf16*)(ws + WS_H); F.QKV = (bf16*)(ws + WS_QKV); F.OB = (bf16*)(ws + WS_O); F.HM = (bf16*)(ws + WS_PART); F.YB = (bf16*)(ws + WS_QKV);
    F.list = (int*)(ws + WS_LIST); F.tokslot = (i32x4*)(ws + WS_TOKSLOT); F.tokw = (float*)(ws + WS_TOKW); F.ssq = (float*)(F.ctl + CW_SSQ); F.cnt = F.ctl + CW_CNT;
    for (int u = F.tid; u < 64; u += NTHREADS) F.MISC[u] = 0u;
    __syncthreads();
    const int lo = args.ph_lo, hi = args.ph_hi;
    XcdBarrier bar; bar.bar = F.ctl + CW_BAR; bar.x = 0; bar.st = nullptr;
    if (hi - lo > 1) bar = xcd_barrier_post(F.ctl + CW_BAR, F.MISC + 40);
#define IN(k) (lo <= (k) && (k) < hi)
#define SEAM(k) do { if (IN(k) && IN((k) + 1)) xcd_barrier(bar); } while (0)
    if (IN(0)) { phase_mod(F); } SEAM(0);
    if (IN(1)) { phase_prep(F); } SEAM(1);
    if (IN(2)) { if (FAST_QKV) phase_qkv_fast(F); else phase_qkv_simple(F); } SEAM(2);
    if (IN(3)) { phase_attn_naive(F); } SEAM(3);
    if (IN(4)) { if (FAST_OUT) phase_outproj_fast(F); else phase_outproj_simple(F); } SEAM(4);
    if (IN(5)) { phase_router(F); } SEAM(5);
    if (IN(6)) { if (FAST_MOE1) phase_moe1_fast(F); else phase_moe1_simple(F); } SEAM(6);
    if (IN(7)) { if (FAST_MOE2) phase_moe2_fast(F); else phase_moe2_simple(F); } SEAM(7);
    if (IN(8)) { phase_final(F); }
#undef IN
#undef SEAM
}

extern "C" void kernel_launch(void* const* d_in, const int* in_sizes, int n_in, void* d_out, int out_size, void* d_ws, size_t ws_size, hipStream_t stream) {
    static int grid = 0;
    if (grid == 0) {
        if (n_in != 16 || in_sizes[0] != M * D || out_size != M * D || ws_size < WS_END) { fprintf(stderr, "kernel_launch: unexpected shapes / workspace (n_in %d, ws %zu)\n", n_in, ws_size); grid = -1; return; }
        int dev = 0, cus = 0;
        if (hipGetDevice(&dev) != hipSuccess || hipDeviceGetAttribute(&cus, hipDeviceAttributeMultiprocessorCount, dev) != hipSuccess) { grid = -1; return; }
        if (hipFuncSetAttribute((const void*)mk_fwd, hipFuncAttributeMaxDynamicSharedMemorySize, LDS_BYTES) != hipSuccess) { fprintf(stderr, "kernel_launch: hipFuncSetAttribute failed\n"); grid = -1; return; }
        int per_cu = 0;
        if (hipOccupancyMaxActiveBlocksPerMultiprocessor(&per_cu, (const void*)mk_fwd, NTHREADS, LDS_BYTES) != hipSuccess || per_cu < 1) fprintf(stderr, "kernel_launch: occupancy query says %d\n", per_cu);
        (void)hipGetLastError();
        grid = cus;
    }
    if (grid < 0) return;
    (void)hipMemsetAsync((char*)d_ws + WS_CTL, 0, CTL_ZERO_BYTES, stream);
    Args a{};
    for (int i = 0; i < 16; ++i) a.in[i] = (const float*)d_in[i];
    a.out = (float*)d_out; a.ws = (unsigned char*)d_ws;
    constexpr int NL = MK_N_LAUNCHES;
    for (int li = 0; li < NL; ++li) {
        a.ph_lo = (NL == N_PHASES) ? li : (li * N_PHASES) / NL; a.ph_hi = (NL == N_PHASES) ? li + 1 : ((li + 1) * N_PHASES) / NL;
        hipLaunchKernelGGL(mk_fwd, dim3(grid), dim3(NTHREADS), LDS_BYTES, stream, a);
    }
}
```

```cpp
#include <hip/hip_runtime.h>
#include <cstdio>
#include <cstdint>

#ifndef FAST_ATTN
#define FAST_ATTN 1
#endif
#ifndef FAST_QKV
#define FAST_QKV 1
#endif
#ifndef FAST_OUT
#define FAST_OUT 1
#endif
#ifndef FAST_MOE1
#define FAST_MOE1 1
#endif
#ifndef FAST_MOE2
#define FAST_MOE2 1
#endif
#ifndef MK_N_LAUNCHES
#define MK_N_LAUNCHES 1
#endif

#define GAS __attribute__((address_space(1)))
#define LAS __attribute__((address_space(3)))
typedef unsigned short bf16;
typedef short bf16x8 __attribute__((ext_vector_type(8)));
typedef float f32x4 __attribute__((ext_vector_type(4)));
typedef float f32x16 __attribute__((ext_vector_type(16)));
typedef unsigned u32x4 __attribute__((ext_vector_type(4)));
typedef unsigned u32x2 __attribute__((ext_vector_type(2)));
typedef int i32x4 __attribute__((ext_vector_type(4)));

constexpr int NB = 8, SEQ = 8192, D = 1024, M = NB * SEQ;
constexpr int HD = 64, NH = 8, DH = 512;
constexpr int NE = 32, EPG = 8, NGRP = 4, DFF = 512;
constexpr float NORM_EPS = 1e-6f;
constexpr float LOG2E = 1.4426950408889634f;
constexpr float C2 = 0.125f * LOG2E;
constexpr int NWAVES = 8, NTHREADS = 512;
constexpr int LIST_CAP = M;
constexpr int MAX_TILES = (2 * M) / 256 + NE;

constexpr size_t MiB = 1u << 20;
constexpr size_t WS_CTL = 0, CTL_ZERO_BYTES = 2 * MiB;
constexpr size_t WS_MOD = 2 * MiB;
constexpr size_t WS_WIN = 4 * MiB;
constexpr size_t WS_WOUT = 10 * MiB;
constexpr size_t WS_WGU = 12 * MiB;
constexpr size_t WS_WD = 76 * MiB;
constexpr size_t WS_LIST = 108 * MiB;
constexpr size_t WS_TOKSLOT = 116 * MiB;
constexpr size_t WS_TOKW = 117 * MiB;
constexpr size_t WS_H = 120 * MiB;
constexpr size_t WS_QKV = 248 * MiB;
constexpr size_t WS_PART = 632 * MiB;
constexpr size_t WS_O = 768 * MiB;
constexpr size_t WS_END = 896 * MiB;
static_assert(WS_QKV + (size_t)MAX_TILES * 256 * 1024 * 2 <= WS_PART && WS_PART + (size_t)MAX_TILES * 256 * 512 * 2 <= WS_O, "overlays");
constexpr int CW_BAR = 4096;
constexpr int CW_CNT = 16384;
constexpr int CW_SSQ = 65536;
static_assert((CW_SSQ + 2 * M) * 4 <= (int)CTL_ZERO_BYTES, "ctl");

constexpr int LDS_MAIN = 147456;
constexpr int MISC_OFF = LDS_MAIN;
constexpr int LDS_BYTES = LDS_MAIN + 1024;

__device__ __forceinline__ float bf2f(bf16 v) { return __uint_as_float((unsigned)v << 16); }
__device__ __forceinline__ unsigned f2bf(float f) { unsigned u = __float_as_uint(f); return (u + 0x7fffu + ((u >> 16) & 1u)) >> 16; }
__device__ __forceinline__ unsigned pk2(float lo, float hi) { return f2bf(lo) | (f2bf(hi) << 16); }
__device__ __forceinline__ float wave_sum(float v) {
#pragma unroll
    for (int o = 1; o < 64; o <<= 1) v += __shfl_xor(v, o);
    return v;
}
__device__ __forceinline__ int crow(int r, int hi) { return (r & 3) + 8 * (r >> 2) + 4 * hi; }
#define MFMA32(a, b, c) __builtin_amdgcn_mfma_f32_32x32x16_bf16((a), (b), (c), 0, 0, 0)

#define XB_TMO      128
#define XB_XCNT(j)  (256  + 64 * (j))
#define XB_XSUB(j)  (1280 + 64 * (j))
#define XB_XGEN(j)  (2304 + 64 * (j))
#define XB_TOP      3328
#define XB_TOPGEN   3392
#define XCD_BAR_WORDS 3456
#define XB_SPIN_CAP (1u << 18)
__device__ __forceinline__ unsigned xb_ld(unsigned* p)              { return __hip_atomic_load(p, __ATOMIC_RELAXED, __HIP_MEMORY_SCOPE_AGENT); }
__device__ __forceinline__ unsigned xb_add(unsigned* p, unsigned v) { return __hip_atomic_fetch_add(p, v, __ATOMIC_RELAXED, __HIP_MEMORY_SCOPE_AGENT); }
__device__ __forceinline__ unsigned xb_xcc_id() { return (unsigned)__builtin_amdgcn_s_getreg((3 << 11) | 20) & 0xFu; }
#define XB_SPIN(cond, bar) do { unsigned _sp = 0; while (cond) { __builtin_amdgcn_s_sleep(1); \
    if ((++_sp & 255u) == 0u) { if (xb_ld(&(bar)[XB_TMO])) break; if (_sp > XB_SPIN_CAP) { atomicAdd(&(bar)[XB_TMO], 1u); break; } } } } while (0)
struct XcdBarrier { unsigned* bar; unsigned x; volatile LAS unsigned* st; };
__device__ __forceinline__ XcdBarrier xcd_barrier_post(unsigned* bar, volatile LAS unsigned* st) {
    XcdBarrier b; b.bar = bar; b.x = xb_xcc_id(); b.st = st;
    if (threadIdx.x == 0) (void)xb_add(&bar[XB_XCNT(b.x)], 1u);
    return b;
}
__device__ __forceinline__ void xcd_barrier_complete(unsigned* bar, unsigned x, unsigned& nloc, unsigned& nx) {
    const unsigned G = gridDim.x * gridDim.y * gridDim.z;
    unsigned sum, cnt, mine, sp = 0u;
    for (;;) {
        sum = 0u; cnt = 0u; mine = 0u;
#pragma unroll
        for (unsigned j = 0; j < 16; ++j) { const unsigned c = xb_ld(&bar[XB_XCNT(j)]); sum += c; cnt += (c > 0u) ? 1u : 0u; mine = (j == x) ? c : mine; }
        if (sum == G) break;
        __builtin_amdgcn_s_sleep(1);
        if ((++sp & 255u) == 0u) { if (xb_ld(&bar[XB_TMO])) break; if (sp > XB_SPIN_CAP) { atomicAdd(&bar[XB_TMO], 1u); break; } }
    }
    nloc = mine > 0u ? mine : 1u; nx = cnt > 0u ? cnt : 1u;
}
__device__ __forceinline__ void xcd_barrier(const XcdBarrier& b) {
    asm volatile("s_waitcnt vmcnt(0)" ::: "memory");
    __syncthreads();
    if (threadIdx.x == 0) {
        unsigned* bar = b.bar;
        __builtin_amdgcn_s_waitcnt(0);
        unsigned nloc = b.st[0], nx = b.st[1];
        if (nloc == 0u) { xcd_barrier_complete(bar, b.x, nloc, nx); b.st[0] = nloc; b.st[1] = nx; }
        const unsigned old = xb_add(&bar[XB_XSUB(b.x)], 1u);
        const unsigned gen = old / nloc;
        if (old + 1u == (gen + 1u) * nloc) {
            __builtin_amdgcn_fence(__ATOMIC_RELEASE, "agent");
            asm volatile("s_waitcnt vmcnt(0)" ::: "memory");
            const unsigned og = xb_add(&bar[XB_TOP], 1u);
            const unsigned tg = og / nx;
            if (og + 1u == (tg + 1u) * nx) xb_add(&bar[XB_TOPGEN], 1u);
            else XB_SPIN(xb_ld(&bar[XB_TOPGEN]) == tg, bar);
            __builtin_amdgcn_fence(__ATOMIC_ACQUIRE, "agent");
            xb_add(&bar[XB_XGEN(b.x)], 1u);
            asm volatile("s_waitcnt vmcnt(0)" ::: "memory");
        } else {
            XB_SPIN(xb_ld(&bar[XB_XGEN(b.x)]) == gen, bar);
            __builtin_amdgcn_fence(__ATOMIC_ACQUIRE, "agent");
            asm volatile("s_waitcnt vmcnt(0)" ::: "memory");
        }
    }
    __syncthreads();
}

struct Frame {
    LAS unsigned char* lds;
    volatile LAS unsigned* MISC;
    unsigned* ctl;
    int tid, lane, wave, vcu, G;
    const float *x, *c, *w_ada, *b_ada, *g_mix, *w_in, *g_dil, *g_sb, *w_out, *g_ffn, *w_group, *w_expert, *w_gate, *w_up, *w_down, *g_final;
    float* out; unsigned char* ws;
    float* mod; bf16 *WinT, *WoutT, *WguT, *WdT, *HB, *QKV, *OB, *HM, *YB;
    int* list; i32x4* tokslot; float* tokw; float* ssq; unsigned* cnt;
};

__device__ __forceinline__ void phase_mod(Frame& F) {
    LAS float* sc = (LAS float*)F.lds;
    LAS float* red = sc + 8192;
    for (int i = F.tid; i < NB * D; i += NTHREADS) { const float v = F.c[i]; sc[i] = v / (1.f + __expf(-v)); }
    __syncthreads();
    for (int unit = blockIdx.x; unit < 96; unit += F.G) {
        const int j = unit * 64 + F.lane;
        float acc[8];
#pragma unroll
        for (int b = 0; b < 8; ++b) acc[b] = 0.f;
        const float* wp = F.w_ada + (size_t)(F.wave * 128) * 6144 + j;
#pragma unroll 8
        for (int kk = 0; kk < 128; ++kk) { const float wv = wp[(size_t)kk * 6144];
#pragma unroll
            for (int b = 0; b < 8; ++b) acc[b] += sc[b * 1024 + F.wave * 128 + kk] * wv; }
#pragma unroll
        for (int b = 0; b < 8; ++b) red[(F.wave * 8 + b) * 64 + F.lane] = acc[b];
        __syncthreads();
        { const int b = F.wave; float s = 0.f;
#pragma unroll
          for (int w = 0; w < 8; ++w) s += red[(w * 8 + b) * 64 + F.lane];
          F.mod[b * 6144 + j] = s + F.b_ada[j]; }
        __syncthreads();
    }
}

template <class RowMap>
__device__ __forceinline__ void transpose_item(const float* W, int K, int N, bf16* WT, RowMap rm, const float* gk, LAS float* scr, int item, int lane) {
    const int nblk = N / 32, kb = item / nblk, nb = item % nblk, k0 = 64 * kb, n0 = 32 * nb;
#pragma unroll 8
    for (int i = 0; i < 32; ++i) { const int kk = 2 * i + (lane >> 5); float v = W[(size_t)(k0 + kk) * N + n0 + (lane & 31)]; if (gk) v *= gk[k0 + kk]; scr[kk * 33 + (lane & 31)] = v; }
    asm volatile("s_waitcnt lgkmcnt(0)" ::: "memory");
    const int c = lane & 7;
#pragma unroll
    for (int j = 0; j < 4; ++j) { const int n = (lane >> 3) + 8 * j; const LAS float* s = scr + (8 * c) * 33 + n;
        u32x4 o; o.x = pk2(s[0 * 33], s[1 * 33]); o.y = pk2(s[2 * 33], s[3 * 33]); o.z = pk2(s[4 * 33], s[5 * 33]); o.w = pk2(s[6 * 33], s[7 * 33]);
        *(u32x4*)(WT + (size_t)rm(n0 + n) * K + k0 + 8 * c) = o; }
    asm volatile("s_waitcnt lgkmcnt(0)" ::: "memory");
}
struct RmId { __device__ __forceinline__ int operator()(int n) const { return n; } };
struct RmGU { int up; __device__ __forceinline__ int operator()(int n) const { return 8 * (n >> 2) + 4 * up + (n & 3); } };

__device__ __forceinline__ void phase_prep(Frame& F) {
    LAS float* scr = (LAS float*)(F.lds + F.wave * 16384);
    const int gw = F.vcu * NWAVES + F.wave, NGW = F.G * NWAVES;
    constexpr int I_IN = 16 * 96, I_OUT = 16 * 32, I_G = 16 * 16, I_D = 8 * 32;
    constexpr int NITEMS = I_IN + I_OUT + NE * (2 * I_G + I_D);
    for (int it = gw; it < NITEMS; it += NGW) {
        int r = it;
        if (r < I_IN) { transpose_item(F.w_in, D, 3 * D, F.WinT, RmId{}, nullptr, scr, r, F.lane); continue; } r -= I_IN;
        if (r < I_OUT) {
            const int kb = r / 32; const float* gk = (kb < 8) ? F.g_dil : (F.g_sb - 512);
            transpose_item(F.w_out, D, D, F.WoutT, RmId{}, gk, scr, r, F.lane); continue; } r -= I_OUT;
        const int e = r / (2 * I_G + I_D); r -= e * (2 * I_G + I_D);
        if (r < I_G) { transpose_item(F.w_gate + (size_t)e * D * DFF, D, DFF, F.WguT + (size_t)e * D * D, RmGU{0}, nullptr, scr, r, F.lane); continue; } r -= I_G;
        if (r < I_G) { transpose_item(F.w_up + (size_t)e * D * DFF, D, DFF, F.WguT + (size_t)e * D * D, RmGU{1}, nullptr, scr, r, F.lane); continue; } r -= I_G;
        transpose_item(F.w_down + (size_t)e * DFF * D, DFF, D, F.WdT + (size_t)e * D * DFF, RmId{}, nullptr, scr, r, F.lane);
    }
    for (int ch = gw; ch < M / 32; ch += NGW) {
        const int b = ch / (SEQ / 32);
        f32x4 gs[4], sh[4];
#pragma unroll
        for (int j = 0; j < 4; ++j) { const int col = 4 * F.lane + 256 * j;
            const f32x4 g = *(const f32x4*)(F.g_mix + col), scl = *(const f32x4*)(F.mod + b * 6144 + 1024 + col); sh[j] = *(const f32x4*)(F.mod + b * 6144 + col);
            gs[j] = g * (scl + 1.0f); }
        for (int rr = 0; rr < 32; ++rr) {
            const size_t m = (size_t)ch * 32 + rr;
            const f32x4* xr = (const f32x4*)(F.x + m * D) + F.lane;
            f32x4 v[4]; float s = 0.f;
#pragma unroll
            for (int j = 0; j < 4; ++j) { v[j] = xr[64 * j]; s += (v[j].x * v[j].x + v[j].y * v[j].y) + (v[j].z * v[j].z + v[j].w * v[j].w); }
            const float rs = 1.0f / sqrtf(wave_sum(s) * (1.f / D) + NORM_EPS);
            unsigned long long* o8 = (unsigned long long*)(F.HB + m * D) + F.lane;
#pragma unroll
            for (int j = 0; j < 4; ++j) { const f32x4 y = v[j] * rs * gs[j] + sh[j];
                o8[64 * j] = (unsigned long long)pk2(y.x, y.y) | ((unsigned long long)pk2(y.z, y.w) << 32); }
        }
    }
}

template <int NI>
__device__ __forceinline__ void sg_mainloop(f32x16 (&acc)[NI][2], const bf16* const (&pa)[2], const bf16* const (&pb)[NI], int kbeg, int kend) {
#pragma unroll 2
    for (int k = kbeg; k < kend; k += 32) {
        bf16x8 a[2][2], b[NI][2];
#pragma unroll
        for (int s = 0; s < 2; ++s) {
#pragma unroll
            for (int mi = 0; mi < 2; ++mi) a[mi][s] = *(const bf16x8*)(pa[mi] + k + 16 * s);
#pragma unroll
            for (int ni = 0; ni < NI; ++ni) b[ni][s] = *(const bf16x8*)(pb[ni] + k + 16 * s);
        }
#pragma unroll
        for (int s = 0; s < 2; ++s)
#pragma unroll
            for (int ni = 0; ni < NI; ++ni)
#pragma unroll
                for (int mi = 0; mi < 2; ++mi) acc[ni][mi] = MFMA32(b[ni][s], a[mi][s], acc[ni][mi]);
    }
}
template <int NI> __device__ __forceinline__ void sg_zero(f32x16 (&acc)[NI][2]) {
#pragma unroll
    for (int ni = 0; ni < NI; ++ni)
#pragma unroll
        for (int mi = 0; mi < 2; ++mi)
#pragma unroll
            for (int i = 0; i < 16; ++i) acc[ni][mi][i] = 0.f;
}

namespace pg8 {
typedef unsigned short bf16_t;
constexpr int BM = 256, BK = 64, HALF = 128, HTB = HALF * BK * 2, STAGE_BYTES = 8 * HTB, NXCD = 8, WGM = 8;
constexpr int SIDE_OFF = STAGE_BYTES;
__host__ __device__ __forceinline__ int lds_byte(int r, int c) { const int st = (r >> 4) * 2 + (c >> 5), rr = r & 15, cc = c & 31, ob = rr * 64 + cc * 2; return st * 1024 + (ob ^ (((ob >> 9) & 1) << 5)); }
__host__ __device__ __forceinline__ void stage_rc(int b, int& R, int& C) { const int st = b / 1024, sb = b % 1024, swz = sb ^ (((sb >> 9) & 1) << 5); R = (st >> 1) * 16 + swz / 64; C = (st & 1) * 32 + (swz % 64) / 2; }
__host__ __device__ __forceinline__ int perm32(int rho) { const int n = rho >> 4, i = rho & 15; return 8 * (i >> 2) + 4 * n + (i & 3); }
struct Unit { int pm, pn, pb, li; };
struct Gemm { const bf16_t* A; const bf16_t* Bt; int K; };
struct StaticOrder {
    int nM, nN, nwg, G, c;
    __device__ void init(int M_, int N_, int G_, int c_) { nM = M_ / BM; nN = N_ / BM; nwg = nM * nN; G = G_; c = c_; }
    __device__ bool next(int i, Unit& u) const {
        const long L = (long)i * G + c; if (L >= nwg) return false;
        int wgid = (int)L; { const int q = nwg / NXCD, r = nwg % NXCD, xcd = wgid % NXCD, off = wgid / NXCD; wgid = (xcd < r ? xcd * (q + 1) : r * (q + 1) + (xcd - r) * q) + off; }
        const int nig = WGM * nN, gid = wgid / nig, fm = gid * WGM, gsz = (nM - fm) < WGM ? (nM - fm) : WGM;
        u.pm = fm + ((wgid % nig) % gsz); u.pn = (wgid % nig) / gsz; u.pb = u.pn; u.li = i; return true;
    }
};
__device__ __forceinline__ unsigned cvt_pk_bf16(float lo, float hi) { unsigned r; asm volatile("v_cvt_pk_bf16_f32 %0, %1, %2" : "=v"(r) : "v"(lo), "v"(hi)); return r; }

template <class Epi, class Sched, int MODE>
__device__ __forceinline__ void gemm_phase(LAS unsigned char* lds, const Gemm g, const Sched& S, const Epi& E) {
    constexpr bool GATHER = (MODE == 1), RESCALE = (MODE == 2);
    const int tid = threadIdx.x, wid = __builtin_amdgcn_readfirstlane(tid >> 6), lane = tid & 63, wr = wid >> 2, wc = wid & 3, fr = lane & 15, fq = lane >> 4;
    const int K = g.K, nt = K / BK;
    unsigned voffA[2], voffB[2]; int RA[2], CA2[2];
#pragma unroll
    for (int i = 0; i < 2; ++i) { int R, C; stage_rc(tid * 16 + i * 8192, R, C); const int Rb = Epi::PERM ? ((R & ~31) + perm32(R & 31)) : R;
        voffA[i] = (unsigned)(R * K + C) * 2u; voffB[i] = (unsigned)(Rb * K + C) * 2u; RA[i] = R; CA2[i] = C * 2; }
    const size_t kstep = (size_t)(BK * 2);
    const size_t hstep = (size_t)HALF * K * 2;
    const size_t tstep = 2 * hstep;
    const unsigned ldsw = (unsigned)wid * 1024u;
    const int aoff = lds_byte(wr * 64 + fr, fq * 8), boff = lds_byte(wc * 32 + fr, fq * 8);
    const LAS int* idxtab = (const LAS int*)(lds + SIDE_OFF);
#define PG8_SA(b, h) (((b) * 2 + (h)) * HTB)
#define PG8_SB(b, h) ((4 + (b) * 2 + (h)) * HTB)
#define PG8_STAGE2(bufoff, gbase, o0, o1) do { \
        __builtin_amdgcn_global_load_lds((const unsigned*)((const char*)(gbase) + (o0)), (LAS unsigned*)(lds + (bufoff) + ldsw), 16, 0, 0); \
        __builtin_amdgcn_global_load_lds((const unsigned*)((const char*)(gbase) + (o1)), (LAS unsigned*)(lds + (bufoff) + ldsw + 8192), 16, 0, 0); } while (0)
#define PG8_STAGE(bufoff, gbase, voff) PG8_STAGE2(bufoff, gbase, (voff)[0], (voff)[1])
#define PG8_STAGE_A(bufoff, hf, aptr, NXT) do { if constexpr (GATHER) { const unsigned o0_ = (NXT) ? goffN[hf][0] : goffC[hf][0], o1_ = (NXT) ? goffN[hf][1] : goffC[hf][1]; PG8_STAGE2(bufoff, aptr, o0_, o1_); } \
        else { PG8_STAGE(bufoff, (aptr) + (hf) * hstep, voffA); } } while (0)
#define PG8_LDA(dst, b, h) do { _Pragma("unroll") for (int m = 0; m < 4; ++m) _Pragma("unroll") for (int k = 0; k < 2; ++k) dst[m][k] = *(const LAS bf16x8*)(lds + PG8_SA(b, h) + aoff + m * 2048 + k * 1024); } while (0)
#define PG8_LDB(dst, b, h) do { _Pragma("unroll") for (int n = 0; n < 2; ++n) _Pragma("unroll") for (int k = 0; k < 2; ++k) dst[n][k] = *(const LAS bf16x8*)(lds + PG8_SB(b, h) + boff + n * 2048 + k * 1024); } while (0)
#define PG8_MMA(ai, bj, At, Bt) do { __builtin_amdgcn_s_setprio(1); _Pragma("unroll") for (int m = 0; m < 4; ++m) _Pragma("unroll") for (int n = 0; n < 2; ++n) _Pragma("unroll") for (int k = 0; k < 2; ++k) \
        acc[ai][bj][m][n] = __builtin_amdgcn_mfma_f32_16x16x32_bf16(Bt[n][k], At[m][k], acc[ai][bj][m][n], 0, 0, 0); __builtin_amdgcn_s_setprio(0); } while (0)
#define PG8_WAIT_V(n) asm volatile("s_waitcnt vmcnt(" #n ")" ::: "memory")
#define PG8_WAIT_L(n) asm volatile("s_waitcnt lgkmcnt(" #n ")" ::: "memory")
#define PG8_BAR __builtin_amdgcn_s_barrier()
#define PG8_SCHED __builtin_amdgcn_sched_barrier(0)
#define PG8_GOFF(dst, u) do { _Pragma("unroll") for (int hf_ = 0; hf_ < 2; ++hf_) _Pragma("unroll") for (int i_ = 0; i_ < 2; ++i_) \
        dst[hf_][i_] = (unsigned)idxtab[(u).li * 256 + hf_ * 128 + RA[i_]] * (unsigned)(K * 2) + (unsigned)CA2[i_]; } while (0)
    Unit cur, nxt; int ui = 0;
    if (!S.next(0, cur)) return;
    f32x4 acc[2][2][4][2];
#pragma unroll
    for (int a = 0; a < 2; ++a)
#pragma unroll
        for (int b = 0; b < 2; ++b)
#pragma unroll
            for (int m = 0; m < 4; ++m)
#pragma unroll
                for (int n = 0; n < 2; ++n) acc[a][b][m][n] = (f32x4){0.f, 0.f, 0.f, 0.f};
    bf16x8 At[4][2], B0[2][2], B1[2][2];
    unsigned goffC[2][2] = {{0u, 0u}, {0u, 0u}}, goffN[2][2] = {{0u, 0u}, {0u, 0u}};
    if constexpr (GATHER) { PG8_GOFF(goffC, cur); }
    const char* cA = GATHER ? (const char*)g.A : (const char*)g.A + (size_t)cur.pm * tstep; const char* cB = (const char*)g.Bt + (size_t)cur.pb * tstep;
    PG8_STAGE(PG8_SB(0, 0), cB, voffB); PG8_STAGE(PG8_SB(0, 1), cB + hstep, voffB); PG8_STAGE_A(PG8_SA(0, 0), 0, cA, false); PG8_STAGE_A(PG8_SA(0, 1), 1, cA, false);
    if (wr == 1) PG8_BAR;
    PG8_WAIT_V(2); PG8_BAR;
    PG8_STAGE(PG8_SB(1, 0), cB + kstep, voffB); PG8_STAGE_A(PG8_SA(1, 0), 0, cA + kstep, false); PG8_STAGE(PG8_SB(1, 1), cB + hstep + kstep, voffB);
    PG8_WAIT_V(6); PG8_BAR;
    for (;;) {
        const bool has_next = S.next(ui + 1, nxt);
        const char* nA = GATHER ? cA : (has_next ? (const char*)g.A + (size_t)nxt.pm * tstep : cA); const char* nB = has_next ? (const char*)g.Bt + (size_t)nxt.pb * tstep : cB;
        if constexpr (GATHER) { if (has_next) { PG8_GOFF(goffN, nxt); } else {
#pragma unroll
            for (int hf = 0; hf < 2; ++hf) { goffN[hf][0] = goffC[hf][0]; goffN[hf][1] = goffC[hf][1]; } } }
        for (int t = 0; t < nt; t += 2) {
            const bool last = (t == nt - 2);
            const char* a1 = cA + (size_t)(t + 1) * kstep;
            const char* a2 = last ? nA : cA + (size_t)(t + 2) * kstep; const char* b2 = last ? nB : cB + (size_t)(t + 2) * kstep;
            const char* a3 = a2 + kstep; const char* b3 = b2 + kstep;
            if constexpr (RESCALE) { if (t == nt / 2) { const LAS float* sd = (const LAS float*)(lds + SIDE_OFF) + (size_t)cur.li * 512;
#pragma unroll
                for (int ai = 0; ai < 2; ++ai)
#pragma unroll
                    for (int m = 0; m < 4; ++m) { const float f = sd[2 * (ai * HALF + wr * 64 + m * 16 + fr)];
#pragma unroll
                        for (int bj = 0; bj < 2; ++bj)
#pragma unroll
                            for (int n = 0; n < 2; ++n) acc[ai][bj][m][n] = acc[ai][bj][m][n] * f; } } }
            PG8_LDB(B0, 0, 0); PG8_LDB(B1, 0, 1); PG8_SCHED; PG8_LDA(At, 0, 0); PG8_STAGE_A(PG8_SA(1, 1), 1, a1, false);
            PG8_WAIT_V(8); PG8_WAIT_L(0); PG8_BAR; PG8_MMA(0, 0, At, B0); PG8_MMA(0, 1, At, B1); PG8_BAR; PG8_SCHED;
            PG8_LDA(At, 0, 1); PG8_STAGE(PG8_SB(0, 0), b2, voffB); PG8_STAGE(PG8_SB(0, 1), b2 + hstep, voffB); PG8_STAGE_A(PG8_SA(0, 0), 0, a2, last);
            PG8_WAIT_V(8); PG8_WAIT_L(0); PG8_BAR; PG8_MMA(1, 0, At, B0); PG8_MMA(1, 1, At, B1); PG8_BAR; PG8_SCHED;
            PG8_LDB(B0, 1, 0); PG8_LDB(B1, 1, 1); PG8_SCHED; PG8_LDA(At, 1, 0); PG8_STAGE_A(PG8_SA(0, 1), 1, a2, last);
            PG8_WAIT_V(8); PG8_WAIT_L(0); PG8_BAR; PG8_MMA(0, 0, At, B0); PG8_MMA(0, 1, At, B1); PG8_BAR; PG8_SCHED;
            PG8_LDA(At, 1, 1); PG8_STAGE(PG8_SB(1, 0), b3, voffB); PG8_STAGE(PG8_SB(1, 1), b3 + hstep, voffB); PG8_STAGE_A(PG8_SA(1, 0), 0, a3, last);
            PG8_WAIT_V(8); PG8_WAIT_L(0); PG8_BAR; PG8_MMA(1, 0, At, B0); PG8_MMA(1, 1, At, B1); PG8_BAR; PG8_SCHED;
        }
        if (wr == 0) PG8_BAR;
        E(acc, cur, wr, wc, fr, fq);
        if (!has_next) break;
#pragma unroll
        for (int a = 0; a < 2; ++a)
#pragma unroll
            for (int b = 0; b < 2; ++b)
#pragma unroll
                for (int m = 0; m < 4; ++m)
#pragma unroll
                    for (int n = 0; n < 2; ++n) acc[a][b][m][n] = (f32x4){0.f, 0.f, 0.f, 0.f};
        cur = nxt; cA = nA; cB = nB; ++ui;
        if constexpr (GATHER) {
#pragma unroll
            for (int hf = 0; hf < 2; ++hf) { goffC[hf][0] = goffN[hf][0]; goffC[hf][1] = goffN[hf][1]; } }
        if (wr == 1) PG8_BAR;
    }
    PG8_WAIT_V(0);
    PG8_BAR;
#undef PG8_SA
#undef PG8_SB
#undef PG8_STAGE
#undef PG8_STAGE2
#undef PG8_STAGE_A
#undef PG8_LDA
#undef PG8_LDB
#undef PG8_MMA
#undef PG8_WAIT_V
#undef PG8_WAIT_L
#undef PG8_BAR
#undef PG8_SCHED
#undef PG8_GOFF
}

struct EpiQKV {
    static constexpr bool PERM = true;
    bf16_t* O;
    __device__ __forceinline__ void operator()(const f32x4 (&acc)[2][2][4][2], const Unit& u, int wr, int wc, int fr, int fq) const {
        const int row0 = u.pm * BM + wr * 64 + fr; const int colt = u.pn * BM; const int t = colt >> 9;
        bf16_t* base = O + (size_t)t * M * DH; const float sc = (t == 0 || t == 3) ? C2 : 1.0f;
        const int col0 = (colt & 511) + wc * 32 + 8 * fq;
#pragma unroll
        for (int ai = 0; ai < 2; ++ai)
#pragma unroll
            for (int m = 0; m < 4; ++m) { bf16_t* rowp = base + (size_t)(row0 + ai * HALF + m * 16) * DH + col0;
#pragma unroll
                for (int bj = 0; bj < 2; ++bj) { const f32x4 v0 = acc[ai][bj][m][0] * sc, v1 = acc[ai][bj][m][1] * sc;
                    u32x4 w; w.x = cvt_pk_bf16(v0[0], v0[1]); w.y = cvt_pk_bf16(v0[2], v0[3]); w.z = cvt_pk_bf16(v1[0], v1[1]); w.w = cvt_pk_bf16(v1[2], v1[3]);
                    *(u32x4*)(rowp + bj * HALF) = w; } }
    }
};
struct EpiY {
    static constexpr bool PERM = true;
    bf16_t* O; int ldc;
    __device__ __forceinline__ void operator()(const f32x4 (&acc)[2][2][4][2], const Unit& u, int wr, int wc, int fr, int fq) const {
        const int row0 = u.pm * BM + wr * 64 + fr; const int col0 = u.pn * BM + wc * 32 + 8 * fq;
#pragma unroll
        for (int ai = 0; ai < 2; ++ai)
#pragma unroll
            for (int m = 0; m < 4; ++m) { bf16_t* rowp = O + (size_t)(row0 + ai * HALF + m * 16) * ldc + col0;
#pragma unroll
                for (int bj = 0; bj < 2; ++bj) { const f32x4 v0 = acc[ai][bj][m][0], v1 = acc[ai][bj][m][1];
                    u32x4 w; w.x = cvt_pk_bf16(v0[0], v0[1]); w.y = cvt_pk_bf16(v0[2], v0[3]); w.z = cvt_pk_bf16(v1[0], v1[1]); w.w = cvt_pk_bf16(v1[2], v1[3]);
                    *(u32x4*)(rowp + bj * HALF) = w; } }
    }
};
struct EpiSwiGLU {
    static constexpr bool PERM = true;
    bf16_t* O;
    __device__ __forceinline__ void operator()(const f32x4 (&acc)[2][2][4][2], const Unit& u, int wr, int wc, int fr, int fq) const {
        const int row0 = u.pm * BM + wr * 64 + fr; const int col0 = u.pn * 128 + wc * 16 + 4 * fq;
#pragma unroll
        for (int ai = 0; ai < 2; ++ai)
#pragma unroll
            for (int m = 0; m < 4; ++m) { bf16_t* rowp = O + (size_t)(row0 + ai * HALF + m * 16) * DFF + col0;
#pragma unroll
                for (int bj = 0; bj < 2; ++bj) { const f32x4 ga = acc[ai][bj][m][0], up = acc[ai][bj][m][1]; float hv[4];
#pragma unroll
                    for (int i = 0; i < 4; ++i) hv[i] = ga[i] * __builtin_amdgcn_rcpf(1.0f + __builtin_amdgcn_exp2f(-LOG2E * ga[i])) * up[i];
                    u32x2 w; w.x = cvt_pk_bf16(hv[0], hv[1]); w.y = cvt_pk_bf16(hv[2], hv[3]);
                    *(u32x2*)(rowp + bj * 64) = w; } }
    }
};
struct EpiOutProj {
    static constexpr bool PERM = false;
    const float* x; float* x1; const float* mod; const LAS float* side;
    __device__ __forceinline__ void operator()(const f32x4 (&acc)[2][2][4][2], const Unit& u, int wr, int wc, int fr, int fq) const {
        const int b = (u.pm * BM) / SEQ; const int col0 = u.pn * BM + wc * 32 + 4 * fq;
        f32x4 gate[2][2];
#pragma unroll
        for (int bj = 0; bj < 2; ++bj)
#pragma unroll
            for (int n = 0; n < 2; ++n) gate[bj][n] = *(const f32x4*)(mod + b * 6144 + 2048 + col0 + bj * HALF + n * 16);
#pragma unroll
        for (int ai = 0; ai < 2; ++ai)
#pragma unroll
            for (int m = 0; m < 4; ++m) { const int rl = ai * HALF + wr * 64 + m * 16 + fr; const float rss = side[(size_t)u.li * 512 + 2 * rl + 1];
                const size_t off = (size_t)(u.pm * BM + rl) * D + col0;
#pragma unroll
                for (int bj = 0; bj < 2; ++bj)
#pragma unroll
                    for (int n = 0; n < 2; ++n) { const f32x4 xv = *(const f32x4*)(x + off + bj * HALF + n * 16);
                        *(f32x4*)(x1 + off + bj * HALF + n * 16) = xv + gate[bj][n] * (acc[ai][bj][m][n] * rss); }
                if (m & 1) asm volatile("" ::: "memory"); }
    }
};
}

__device__ __forceinline__ void phase_qkv_simple(Frame& F) {
    const int r = F.lane & 31, h = F.lane >> 5, wm = F.wave >> 1, wn = F.wave & 1;
    constexpr int NPN = 3 * D / 128;
    for (int u = F.vcu; u < (M / 256) * NPN; u += F.G) {
        const int pm = u / NPN, pn = u % NPN, m0 = pm * 256 + wm * 64, n0 = pn * 128 + wn * 64;
        const bf16* pa[2] = {F.HB + (size_t)(m0 + r) * D + 8 * h, F.HB + (size_t)(m0 + 32 + r) * D + 8 * h};
        const bf16* pb[2] = {F.WinT + (size_t)(n0 + r) * D + 8 * h, F.WinT + (size_t)(n0 + 32 + r) * D + 8 * h};
        f32x16 acc[2][2]; sg_zero<2>(acc);
        sg_mainloop<2>(acc, pa, pb, 0, D);
#pragma unroll
        for (int ni = 0; ni < 2; ++ni)
#pragma unroll
            for (int mi = 0; mi < 2; ++mi)
#pragma unroll
                for (int g = 0; g < 4; ++g) {
                    const int n = n0 + 32 * ni + 8 * g + 4 * h, t = n >> 9, col = n & 511; const int m = m0 + 32 * mi + r;
                    const float sc = (t == 0 || t == 3) ? C2 : 1.0f;
                    u32x2 w; w.x = pk2(acc[ni][mi][4 * g] * sc, acc[ni][mi][4 * g + 1] * sc); w.y = pk2(acc[ni][mi][4 * g + 2] * sc, acc[ni][mi][4 * g + 3] * sc);
                    *(u32x2*)(F.QKV + (size_t)t * M * DH + (size_t)m * DH + col) = w;
                }
    }
}

__device__ __forceinline__ void load_row64(const bf16* p, float (&q)[64]) {
#pragma unroll
    for (int i = 0; i < 8; ++i) { const u32x4 w = *(const u32x4*)(p + 8 * i);
        q[8 * i + 0] = __uint_as_float(w.x << 16); q[8 * i + 1] = __uint_as_float(w.x & 0xffff0000u); q[8 * i + 2] = __uint_as_float(w.y << 16); q[8 * i + 3] = __uint_as_float(w.y & 0xffff0000u);
        q[8 * i + 4] = __uint_as_float(w.z << 16); q[8 * i + 5] = __uint_as_float(w.z & 0xffff0000u); q[8 * i + 6] = __uint_as_float(w.w << 16); q[8 * i + 7] = __uint_as_float(w.w & 0xffff0000u); }
}
__device__ __forceinline__ float dot_row64(const bf16* p, const float (&q)[64]) {
    float s0 = 0.f, s1 = 0.f;
#pragma unroll
    for (int i = 0; i < 8; ++i) { const u32x4 w = *(const u32x4*)(p + 8 * i);
        s0 += q[8 * i + 0] * __uint_as_float(w.x << 16); s1 += q[8 * i + 1] * __uint_as_float(w.x & 0xffff0000u); s0 += q[8 * i + 2] * __uint_as_float(w.y << 16); s1 += q[8 * i + 3] * __uint_as_float(w.y & 0xffff0000u);
        s0 += q[8 * i + 4] * __uint_as_float(w.z << 16); s1 += q[8 * i + 5] * __uint_as_float(w.z & 0xffff0000u); s0 += q[8 * i + 6] * __uint_as_float(w.w << 16); s1 += q[8 * i + 7] * __uint_as_float(w.w & 0xffff0000u); }
    return s0 + s1;
}
__device__ __forceinline__ void axpy_row64(const bf16* p, float w_, float (&o)[64]) {
#pragma unroll
    for (int i = 0; i < 8; ++i) { const u32x4 w = *(const u32x4*)(p + 8 * i);
        o[8 * i + 0] += w_ * __uint_as_float(w.x << 16); o[8 * i + 1] += w_ * __uint_as_float(w.x & 0xffff0000u); o[8 * i + 2] += w_ * __uint_as_float(w.y << 16); o[8 * i + 3] += w_ * __uint_as_float(w.y & 0xffff0000u);
        o[8 * i + 4] += w_ * __uint_as_float(w.z << 16); o[8 * i + 5] += w_ * __uint_as_float(w.z & 0xffff0000u); o[8 * i + 6] += w_ * __uint_as_float(w.w << 16); o[8 * i + 7] += w_ * __uint_as_float(w.w & 0xffff0000u); }
}
__device__ __forceinline__ void store_o64(bf16* p, const float (&o)[64], float sc, float& ssq) {
    float s = 0.f;
#pragma unroll
    for (int i = 0; i < 8; ++i) { float v[8];
#pragma unroll
        for (int j = 0; j < 8; ++j) { v[j] = o[8 * i + j] * sc; s += v[j] * v[j]; }
        u32x4 w; w.x = pk2(v[0], v[1]); w.y = pk2(v[2], v[3]); w.z = pk2(v[4], v[5]); w.w = pk2(v[6], v[7]); *(u32x4*)(p + 8 * i) = w; }
    ssq = s;
}
__device__ __forceinline__ void phase_attn_naive(Frame& F) {
    const bf16* QD = F.QKV; const bf16* KD = F.QKV + (size_t)M * DH; const bf16* VD = F.QKV + (size_t)2 * M * DH;
    const bf16* QS = F.QKV + (size_t)3 * M * DH; const bf16* KS = F.QKV + (size_t)4 * M * DH; const bf16* VS = F.QKV + (size_t)5 * M * DH;
    const int total = 2 * M * NH;
    for (int idx = blockIdx.x * NTHREADS + F.tid; idx < total; idx += F.G * NTHREADS) {
        const int t = idx % SEQ, hh = (idx / SEQ) % NH, b = (idx / (SEQ * NH)) % NB, type = idx / (SEQ * NH * NB);
        const size_t m = (size_t)b * SEQ + t;
        float q[64], o[64];
#pragma unroll
        for (int i = 0; i < 64; ++i) o[i] = 0.f;
        float ssq = 0.f;
        if (type == 0) {
            load_row64(QD + m * DH + hh * HD, q);
            const float slope2 = exp2f(-(float)(hh + 1)) * LOG2E;
            float mx = -INFINITY, l = 0.f;
            for (int p = 0; p < 3; ++p) {
                const int d = (p == 0) ? 1 : (p == 1) ? 4 : 16;
                for (int j = 0; j <= 128; ++j) {
                    const int pos = t - j * d; if (pos < 0) break;
                    const size_t km = (size_t)b * SEQ + pos;
                    const float s = dot_row64(KD + km * DH + hh * HD, q) - slope2 * (float)(j * d);
                    const float mn = fmaxf(mx, s), f = exp2f(mx - mn), pw = exp2f(s - mn);
                    l = l * f + pw;
#pragma unroll
                    for (int i = 0; i < 64; ++i) o[i] *= f;
                    axpy_row64(VD + km * DH + hh * HD, pw, o);
                    mx = mn;
                }
            }
            store_o64(F.OB + m * D + hh * HD, o, 1.0f / l, ssq);
        } else {
            load_row64(QS + m * DH + hh * HD, q);
            float R = 1.0f;
            for (int s_ = t - 1; s_ >= 0; --s_) {
                const size_t km = (size_t)b * SEQ + s_;
                const float z2 = fminf(dot_row64(KS + km * DH + hh * HD, q), 100.0f);
                const float e = exp2f(z2), cc = 1.0f / (1.0f + e), w_ = e * cc * R;
                axpy_row64(VS + km * DH + hh * HD, w_, o);
                R *= cc;
                if (R < 1e-30f) break;
            }
            store_o64(F.OB + m * D + DH + hh * HD, o, 1.0f, ssq);
        }
        atomicAdd(F.ssq + 2 * m + type, ssq);
    }
}

__device__ __forceinline__ f32x4 ld_bf4(const bf16* p) { const u32x2 w = *(const u32x2*)p; f32x4 r; r.x = __uint_as_float(w.x << 16); r.y = __uint_as_float(w.x & 0xffff0000u); r.z = __uint_as_float(w.y << 16); r.w = __uint_as_float(w.y & 0xffff0000u); return r; }
typedef short v4i16_t __attribute__((ext_vector_type(4)));
constexpr int VIMG_PITCH = 144, VIMG_BYTES = 8192;
__device__ __forceinline__ int pik(int rho) { return 16 * ((rho >> 2) & 1) + (rho & 3) + 4 * (rho >> 3); }
__device__ __forceinline__ unsigned cvtpk(float lo, float hi) { typedef float f2 __attribute__((ext_vector_type(2))); typedef __bf16 b2 __attribute__((ext_vector_type(2))); f2 v = {lo, hi}; b2 b = __builtin_convertvector(v, b2); return __builtin_bit_cast(unsigned, b); }
__device__ __forceinline__ bf16x8 pack8(const f32x16& p, int s) {
    u32x4 w; w.x = cvtpk(p[8 * s + 0], p[8 * s + 1]); w.y = cvtpk(p[8 * s + 2], p[8 * s + 3]); w.z = cvtpk(p[8 * s + 4], p[8 * s + 5]); w.w = cvtpk(p[8 * s + 6], p[8 * s + 7]);
    return __builtin_bit_cast(bf16x8, w);
}
__device__ __forceinline__ void load_kf(bf16x8 (&kf)[4], const bf16* rowp) {
#pragma unroll
    for (int d0 = 0; d0 < 4; ++d0) kf[d0] = *(const bf16x8*)(rowp + 16 * d0);
}
__device__ __forceinline__ void pv_block(f32x16 (&o)[2], const u32x4 (&vr)[4], const f32x16& p, LAS unsigned char* img, int lane) {
    const int h = lane >> 5;
#pragma unroll
    for (int i = 0; i < 4; ++i) *(LAS u32x4*)(img + ((lane >> 3) + 8 * i) * VIMG_PITCH + (lane & 7) * 16) = vr[i];
    const LAS unsigned char* vb = img + (16 * h + ((lane & 15) >> 2)) * VIMG_PITCH + (16 * ((lane >> 4) & 1) + 4 * (lane & 3)) * 2;
#pragma unroll
    for (int s = 0; s < 2; ++s) { const bf16x8 pf = pack8(p, s);
#pragma unroll
        for (int db = 0; db < 2; ++db) {
            const v4i16_t lo = __builtin_amdgcn_ds_read_tr16_b64_v4i16((LAS v4i16_t*)(vb + s * 8 * VIMG_PITCH + db * 64));
            const v4i16_t hi = __builtin_amdgcn_ds_read_tr16_b64_v4i16((LAS v4i16_t*)(vb + s * 8 * VIMG_PITCH + 4 * VIMG_PITCH + db * 64));
            const bf16x8 vf = (bf16x8){lo[0], lo[1], lo[2], lo[3], hi[0], hi[1], hi[2], hi[3]};
            o[db] = MFMA32(vf, pf, o[db]);
        } }
}
__device__ __forceinline__ float xhalf_max(float v) { return fmaxf(v, __shfl_xor(v, 32)); }
__device__ __forceinline__ float xhalf_sum(float v) { return v + __shfl_xor(v, 32); }

template <int DIL>
__device__ __forceinline__ void dil_unit(const bf16* QD, const bf16* KD, const bf16* VD, LAS unsigned char* img, int lane, int b, int head, int cls, int i0, f32x16 (&o)[2], float& m_out, float& l_out) {
    const int r = lane & 31, h = lane >> 5;
    const size_t ubase = ((size_t)b * SEQ + (size_t)i0 * DIL + cls) * DH + head * HD;
    constexpr int BLK = 32 * DIL * DH;
    const unsigned koff = (unsigned)(pik(r) * DIL * DH + 8 * h) * 2u, qoff = (unsigned)(r * DIL * DH + 8 * h) * 2u;
    const unsigned voff = (unsigned)((lane >> 3) * DIL * DH + 8 * (lane & 7)) * 2u;
    bf16x8 qf[4];
#pragma unroll
    for (int d0 = 0; d0 < 4; ++d0) qf[d0] = *(const bf16x8*)((const char*)(QD + ubase) + qoff + 32 * d0);
    const float slope2d = exp2f(-(float)(head + 1)) * LOG2E * (float)DIL;
    const int nblk = (i0 >= 128) ? 5 : (1 + (i0 >> 5));
#pragma unroll
    for (int db = 0; db < 2; ++db)
#pragma unroll
        for (int ii = 0; ii < 16; ++ii) o[db][ii] = 0.f;
    float m = -INFINITY, l = 0.f;
    bf16x8 kfn[4]; u32x4 vrn[4];
    { const char* kp = (const char*)(KD + ubase) + koff; const char* vp = (const char*)(VD + ubase) + voff;
#pragma unroll
      for (int d0 = 0; d0 < 4; ++d0) kfn[d0] = *(const bf16x8*)(kp + 32 * d0);
#pragma unroll
      for (int i = 0; i < 4; ++i) vrn[i] = *(const u32x4*)(vp + (size_t)i * (8 * DIL * DH * 2)); }
    for (int it = 0; it < nblk; ++it) {
        bf16x8 kf[4]; u32x4 vr[4];
#pragma unroll
        for (int i = 0; i < 4; ++i) { kf[i] = kfn[i]; vr[i] = vrn[i]; }
        if (it + 1 < nblk) { const char* kp = (const char*)(KD + ubase - (size_t)(it + 1) * BLK) + koff; const char* vp = (const char*)(VD + ubase - (size_t)(it + 1) * BLK) + voff;
#pragma unroll
            for (int d0 = 0; d0 < 4; ++d0) kfn[d0] = *(const bf16x8*)(kp + 32 * d0);
#pragma unroll
            for (int i = 0; i < 4; ++i) vrn[i] = *(const u32x4*)(vp + (size_t)i * (8 * DIL * DH * 2)); }
        f32x16 acc;
#pragma unroll
        for (int ii = 0; ii < 16; ++ii) acc[ii] = 0.f;
#pragma unroll
        for (int d0 = 0; d0 < 4; ++d0) acc = MFMA32(kf[d0], qf[d0], acc);
        const int dbase = 32 * it + r - 16 * h;
        float bm = -INFINITY;
#pragma unroll
        for (int ii = 0; ii < 16; ++ii) { const int dist = dbase - ii; const bool valid = (dist >= 0) && (dist <= 128);
            acc[ii] = valid ? (acc[ii] - slope2d * (float)dist) : -INFINITY; bm = fmaxf(bm, acc[ii]); }
        if (__any(bm > m + 8.0f)) {
            const float mn = xhalf_max(fmaxf(bm, m)); const float f = __builtin_amdgcn_exp2f(m - mn);
            l *= f;
#pragma unroll
            for (int db = 0; db < 2; ++db)
#pragma unroll
                for (int ii = 0; ii < 16; ++ii) o[db][ii] *= f;
            m = mn;
        }
#pragma unroll
        for (int ii = 0; ii < 16; ++ii) { acc[ii] = __builtin_amdgcn_exp2f(acc[ii] - m); l += acc[ii]; }
        pv_block(o, vr, acc, img, lane);
    }
    m_out = m; l_out = xhalf_sum(l);
}
__device__ __forceinline__ float store_ot(bf16* dst, const f32x16 (&o)[2], float sc, int h) {
    float s = 0.f;
#pragma unroll
    for (int db = 0; db < 2; ++db)
#pragma unroll
        for (int g = 0; g < 4; ++g) { const float a = o[db][4 * g] * sc, b_ = o[db][4 * g + 1] * sc, c_ = o[db][4 * g + 2] * sc, d_ = o[db][4 * g + 3] * sc;
            s += (a * a + b_ * b_) + (c_ * c_ + d_ * d_);
            u32x2 w; w.x = cvtpk(a, b_); w.y = cvtpk(c_, d_); *(u32x2*)(dst + 32 * db + 8 * g + 4 * h) = w; }
    return s;
}
__device__ __forceinline__ void sb_unit(const bf16* QS, const bf16* KS, const bf16* VS, bf16* OB, float* ssq, LAS unsigned char* img, int lane, int b, int head, int qb) {
    const int r = lane & 31, h = lane >> 5, t0 = 32 * qb;
    const size_t rowbase = (size_t)b * SEQ;
    bf16x8 qf[4];
    { const bf16* qp = QS + (rowbase + t0 + r) * DH + head * HD + 8 * h;
#pragma unroll
      for (int d0 = 0; d0 < 4; ++d0) qf[d0] = *(const bf16x8*)(qp + 16 * d0); }
    const bf16* Kl = KS + (rowbase + pik(r)) * DH + head * HD + 8 * h;
    const bf16* Vl = VS + (rowbase + (lane >> 3)) * DH + head * HD + 8 * (lane & 7);
    f32x16 o[2];
#pragma unroll
    for (int db = 0; db < 2; ++db)
#pragma unroll
        for (int ii = 0; ii < 16; ++ii) o[db][ii] = 0.f;
    float R = 1.0f;
    bf16x8 kfn[4]; u32x4 vrn[4];
    load_kf(kfn, Kl + (size_t)t0 * DH);
#pragma unroll
    for (int i = 0; i < 4; ++i) vrn[i] = *(const u32x4*)(Vl + (size_t)(t0 + 8 * i) * DH);
    for (int kb = t0; kb >= 0; kb -= 32) {
        bf16x8 kf[4]; u32x4 vr[4];
#pragma unroll
        for (int i = 0; i < 4; ++i) { kf[i] = kfn[i]; vr[i] = vrn[i]; }
        if (kb >= 32) {
            load_kf(kfn, Kl + (size_t)(kb - 32) * DH);
#pragma unroll
            for (int i = 0; i < 4; ++i) vrn[i] = *(const u32x4*)(Vl + (size_t)(kb - 32 + 8 * i) * DH);
        }
        f32x16 acc;
#pragma unroll
        for (int ii = 0; ii < 16; ++ii) acc[ii] = 0.f;
#pragma unroll
        for (int d0 = 0; d0 < 4; ++d0) acc = MFMA32(kf[d0], qf[d0], acc);
        const bool diag = (kb == t0);
        float cc[16]; float T = 1.0f;
#pragma unroll
        for (int ii = 0; ii < 16; ++ii) { float x = fminf(acc[ii], 100.0f); if (diag && (16 * h + ii >= r)) x = -INFINITY;
            const float e = __builtin_amdgcn_exp2f(x); const float c_ = __builtin_amdgcn_rcpf(1.0f + e); cc[ii] = c_; acc[ii] = e * c_; T *= c_; }
        const float Tp = __shfl_xor(T, 32);
        float E = h ? R : R * Tp;
#pragma unroll
        for (int ii = 15; ii >= 0; --ii) { acc[ii] = acc[ii] * E; E *= cc[ii]; }
        R = R * T * Tp;
        pv_block(o, vr, acc, img, lane);
        if (__all(R < 7.8e-31f)) break;
    }
    const size_t m = rowbase + t0 + r;
    float s = store_ot(OB + m * D + DH + head * HD, o, 1.0f, h);
    s = xhalf_sum(s);
    if (h == 0) atomicAdd(ssq + 2 * m + 1, s);
}
__device__ __forceinline__ void phase_attn_fast(Frame& F) {
    const bf16* QD = F.QKV; const bf16* KD = F.QKV + (size_t)M * DH; const bf16* VD = F.QKV + (size_t)2 * M * DH;
    const bf16* QS = F.QKV + (size_t)3 * M * DH; const bf16* KS = F.QKV + (size_t)4 * M * DH; const bf16* VS = F.QKV + (size_t)5 * M * DH;
    bf16* P1 = (bf16*)(F.ws + WS_PART); bf16* P2 = P1 + (size_t)M * DH;
    float* ML1 = (float*)(F.ws + WS_PART + (size_t)2 * M * DH * 2); float* ML2 = ML1 + (size_t)2 * M * NH;
    LAS unsigned char* img = F.lds + F.wave * VIMG_BYTES;
    const int lane = F.lane, r = lane & 31, h = lane >> 5;
    for (int sg = F.vcu; sg < 256; sg += F.G) {
        for (int wu = F.wave; wu < 128; wu += NWAVES) {
            const int su = sg * 4 + (wu >> 5), idx = wu & 31; const int b = su >> 7, head = (su >> 4) & 7, span = su & 15;
            f32x16 o[2]; float m_, l_;
            if (idx < 16) {
                const int i0 = span * 512 + 32 * idx;
                dil_unit<1>(QD, KD, VD, img, lane, b, head, 0, i0, o, m_, l_);
                const size_t tok = (size_t)b * SEQ + i0 + r;
                (void)store_ot(P1 + tok * DH + head * HD, o, 1.0f / l_, h);
                if (h == 0) { ML1[(tok * NH + head) * 2] = m_; ML1[(tok * NH + head) * 2 + 1] = l_; }
            } else {
                const int cls = (idx - 16) >> 2, i0 = span * 128 + 32 * ((idx - 16) & 3);
                dil_unit<4>(QD, KD, VD, img, lane, b, head, cls, i0, o, m_, l_);
                const size_t tok = (size_t)b * SEQ + (size_t)(i0 + r) * 4 + cls;
                (void)store_ot(P2 + tok * DH + head * HD, o, 1.0f / l_, h);
                if (h == 0) { ML2[(tok * NH + head) * 2] = m_; ML2[(tok * NH + head) * 2 + 1] = l_; }
            }
        }
        asm volatile("s_waitcnt vmcnt(0)" ::: "memory");
        __syncthreads();
        for (int wu = F.wave; wu < 64; wu += NWAVES) {
            const int su = sg * 4 + (wu >> 4), cls = wu & 15; const int b = su >> 7, head = (su >> 4) & 7, span = su & 15;
            const int i0 = span * 32;
            f32x16 o[2]; float m3, l3;
            dil_unit<16>(QD, KD, VD, img, lane, b, head, cls, i0, o, m3, l3);
            const size_t tok = (size_t)b * SEQ + (size_t)(i0 + r) * 16 + cls;
            const float m1 = ML1[(tok * NH + head) * 2], l1 = ML1[(tok * NH + head) * 2 + 1], m2 = ML2[(tok * NH + head) * 2], l2 = ML2[(tok * NH + head) * 2 + 1];
            const float mm = fmaxf(fmaxf(m1, m2), m3);
            const float w1 = l1 * exp2f(m1 - mm), w2 = l2 * exp2f(m2 - mm), e3 = exp2f(m3 - mm);
            const float inv = 1.0f / (w1 + w2 + l3 * e3);
            const float a1 = w1 * inv, a2 = w2 * inv, a3 = e3 * inv;
            const bf16* p1 = P1 + tok * DH + head * HD; const bf16* p2 = P2 + tok * DH + head * HD;
#pragma unroll
            for (int db = 0; db < 2; ++db)
#pragma unroll
                for (int g = 0; g < 4; ++g) { const f32x4 x1 = ld_bf4(p1 + 32 * db + 8 * g + 4 * h), x2 = ld_bf4(p2 + 32 * db + 8 * g + 4 * h);
#pragma unroll
                    for (int e = 0; e < 4; ++e) o[db][4 * g + e] = a3 * o[db][4 * g + e] + a1 * x1[e] + a2 * x2[e]; }
            float s = store_ot(F.OB + tok * D + head * HD, o, 1.0f, h);
            s = xhalf_sum(s);
            if (h == 0) atomicAdd(F.ssq + 2 * tok, s);
        }
        for (int k = F.wave; k < 64; k += NWAVES) {
            const int sbu = sg * 64 + k; const int bh = sbu >> 8, qb = sbu & 255;
            sb_unit(QS, KS, VS, F.OB, F.ssq, img, lane, bh >> 3, bh & 7, qb);
        }
    }
}

__device__ __forceinline__ void phase_outproj_simple(Frame& F) {
    const int r = F.lane & 31, h = F.lane >> 5, wm = F.wave >> 1, wn = F.wave & 1;
    constexpr int NPN = D / 128;
    float* x1 = F.out;
    for (int u = F.vcu; u < (M / 256) * NPN; u += F.G) {
        const int pm = u / NPN, pn = u % NPN, m0 = pm * 256 + wm * 64, n0 = pn * 128 + wn * 64;
        const bf16* pa[2] = {F.OB + (size_t)(m0 + r) * D + 8 * h, F.OB + (size_t)(m0 + 32 + r) * D + 8 * h};
        const bf16* pb[2] = {F.WoutT + (size_t)(n0 + r) * D + 8 * h, F.WoutT + (size_t)(n0 + 32 + r) * D + 8 * h};
        float rsd[2], rss[2];
#pragma unroll
        for (int mi = 0; mi < 2; ++mi) { const int m = m0 + 32 * mi + r; rsd[mi] = 1.0f / sqrtf(F.ssq[2 * m] * (1.f / DH) + NORM_EPS); rss[mi] = 1.0f / sqrtf(F.ssq[2 * m + 1] * (1.f / DH) + NORM_EPS); }
        f32x16 acc[2][2]; sg_zero<2>(acc);
        sg_mainloop<2>(acc, pa, pb, 0, DH);
#pragma unroll
        for (int ni = 0; ni < 2; ++ni)
#pragma unroll
            for (int mi = 0; mi < 2; ++mi) acc[ni][mi] = acc[ni][mi] * (rsd[mi] / rss[mi]);
        sg_mainloop<2>(acc, pa, pb, DH, D);
        const int b = m0 / SEQ;
#pragma unroll
        for (int ni = 0; ni < 2; ++ni)
#pragma unroll
            for (int mi = 0; mi < 2; ++mi)
#pragma unroll
                for (int g = 0; g < 4; ++g) {
                    const int n = n0 + 32 * ni + 8 * g + 4 * h; const int m = m0 + 32 * mi + r;
                    const f32x4 gate = *(const f32x4*)(F.mod + b * 6144 + 2048 + n), xv = *(const f32x4*)(F.x + (size_t)m * D + n);
                    f32x4 a; a.x = acc[ni][mi][4 * g]; a.y = acc[ni][mi][4 * g + 1]; a.z = acc[ni][mi][4 * g + 2]; a.w = acc[ni][mi][4 * g + 3];
                    *(f32x4*)(x1 + (size_t)m * D + n) = xv + gate * (a * rss[mi]);
                }
    }
}

__device__ __forceinline__ void phase_router(Frame& F) {
    LAS float* WR = (LAS float*)F.lds;
    for (int i = F.tid; i < D * 36; i += NTHREADS) { const int k = i / 36, c = i % 36; const int slot = ((k >> 8) * 4 + (k & 3)) * 64 + ((k >> 2) & 63);
        WR[slot * 36 + c] = (c < 4) ? F.w_group[k * 4 + c] : F.w_expert[k * 32 + (c - 4)]; }
    __syncthreads();
    const int gw = F.vcu * NWAVES + F.wave, NGW = F.G * NWAVES;
    const float* x1 = F.out;
    for (int ch = gw; ch < M / 32; ch += NGW) {
        const int b = ch / (SEQ / 32);
        f32x4 gs[4], sh[4];
#pragma unroll
        for (int j = 0; j < 4; ++j) { const int col = 4 * F.lane + 256 * j;
            const f32x4 g = *(const f32x4*)(F.g_ffn + col), scl = *(const f32x4*)(F.mod + b * 6144 + 4096 + col); sh[j] = *(const f32x4*)(F.mod + b * 6144 + 3072 + col);
            gs[j] = g * (scl + 1.0f); }
        int my_e1 = 0, my_e2 = 0; float my_w1 = 0.f, my_w2 = 0.f;
        for (int rr = 0; rr < 32; ++rr) {
            const size_t m = (size_t)ch * 32 + rr;
            const f32x4* xr = (const f32x4*)(x1 + m * D) + F.lane;
            f32x4 v[4]; float s = 0.f;
#pragma unroll
            for (int j = 0; j < 4; ++j) { v[j] = xr[64 * j]; s += (v[j].x * v[j].x + v[j].y * v[j].y) + (v[j].z * v[j].z + v[j].w * v[j].w); }
            const float rs = 1.0f / sqrtf(wave_sum(s) * (1.f / D) + NORM_EPS);
            unsigned long long* o8 = (unsigned long long*)(F.HB + m * D) + F.lane;
            float gl[4] = {0.f, 0.f, 0.f, 0.f};
#pragma unroll
            for (int j = 0; j < 4; ++j) { v[j] = v[j] * rs * gs[j] + sh[j];
                o8[64 * j] = (unsigned long long)pk2(v[j].x, v[j].y) | ((unsigned long long)pk2(v[j].z, v[j].w) << 32);
#pragma unroll
                for (int i = 0; i < 4; ++i) { const f32x4 w = *(const LAS f32x4*)(WR + ((j * 4 + i) * 64 + F.lane) * 36); const float hv = v[j][i];
                    gl[0] += hv * w.x; gl[1] += hv * w.y; gl[2] += hv * w.z; gl[3] += hv * w.w; } }
#pragma unroll
            for (int i = 0; i < 4; ++i) gl[i] = wave_sum(gl[i]);
            int grp = 0; float gmax = gl[0];
#pragma unroll
            for (int i = 1; i < 4; ++i) if (gl[i] > gmax) { gmax = gl[i]; grp = i; }
            float gden = 0.f;
#pragma unroll
            for (int i = 0; i < 4; ++i) gden += __expf(gl[i] - gmax);
            const float ggate = 1.0f / gden;
            grp = __builtin_amdgcn_readfirstlane(grp);
            float el[8];
#pragma unroll
            for (int i = 0; i < 8; ++i) el[i] = 0.f;
#pragma unroll
            for (int j = 0; j < 4; ++j)
#pragma unroll
                for (int i = 0; i < 4; ++i) { const LAS float* wp = WR + ((j * 4 + i) * 64 + F.lane) * 36 + 4 + grp * 8; const f32x4 w0 = *(const LAS f32x4*)wp, w1 = *(const LAS f32x4*)(wp + 4); const float hv = v[j][i];
                    el[0] += hv * w0.x; el[1] += hv * w0.y; el[2] += hv * w0.z; el[3] += hv * w0.w; el[4] += hv * w1.x; el[5] += hv * w1.y; el[6] += hv * w1.z; el[7] += hv * w1.w; }
#pragma unroll
            for (int i = 0; i < 8; ++i) el[i] = wave_sum(el[i]);
            int i1 = 0; float l1 = el[0];
#pragma unroll
            for (int i = 1; i < 8; ++i) if (el[i] > l1) { l1 = el[i]; i1 = i; }
            int i2 = -1; float l2 = -INFINITY;
#pragma unroll
            for (int i = 0; i < 8; ++i) if (i != i1 && el[i] > l2) { l2 = el[i]; i2 = i; }
            const float p2 = 1.0f / (1.0f + __expf(l1 - l2)), p1 = 1.0f - p2;
            if (F.lane == rr) { my_e1 = grp * 8 + i1; my_e2 = grp * 8 + i2; my_w1 = ggate * p1; my_w2 = ggate * p2; }
        }
        if (F.lane < 32) {
            const int m = ch * 32 + F.lane;
            const int pos1 = (int)atomicAdd(F.cnt + 64 * my_e1, 1u), pos2 = (int)atomicAdd(F.cnt + 64 * my_e2, 1u);
            F.list[(size_t)my_e1 * LIST_CAP + pos1] = m; F.list[(size_t)my_e2 * LIST_CAP + pos2] = m;
            i32x4 ts; ts.x = my_e1; ts.y = pos1; ts.z = my_e2; ts.w = pos2; F.tokslot[m] = ts;
            F.tokw[2 * m] = my_w1; F.tokw[2 * m + 1] = my_w2;
        }
    }
}

__device__ __forceinline__ void build_tiles(Frame& F) {
    __syncthreads();
    if (F.tid == 0) { unsigned acc = 0; for (int e = 0; e < NE; ++e) { F.MISC[e] = acc; acc += (__hip_atomic_load(F.cnt + 64 * e, __ATOMIC_RELAXED, __HIP_MEMORY_SCOPE_AGENT) + 255u) >> 8; } F.MISC[NE] = acc; }
    __syncthreads();
}
__device__ __forceinline__ int find_expert(Frame& F, int tile) { int e = 0;
#pragma unroll 1
    for (int i = 1; i < NE; ++i) if ((int)F.MISC[i] <= tile) e = i; else break;
    return e; }

__device__ __forceinline__ void phase_moe1_simple(Frame& F) {
    build_tiles(F);
    const int r = F.lane & 31, h = F.lane >> 5, wm = F.wave >> 1, wn = F.wave & 1;
    const int T = (int)F.MISC[NE];
    for (int u = F.vcu; u < T * 8; u += F.G) {
        const int tile = u >> 3, cn = u & 7, e = find_expert(F, tile), jt = tile - (int)F.MISC[e];
        const int cnt = (int)__hip_atomic_load(F.cnt + 64 * e, __ATOMIC_RELAXED, __HIP_MEMORY_SCOPE_AGENT);
        const bf16* pa[2];
#pragma unroll
        for (int mi = 0; mi < 2; ++mi) { const int pos = jt * 256 + wm * 64 + 32 * mi + r; const int tok = (pos < cnt) ? F.list[(size_t)e * LIST_CAP + pos] : 0; pa[mi] = F.HB + (size_t)tok * D + 8 * h; }
        const int j0 = cn * 64 + wn * 32, jj = j0 + r;
        const bf16* Wb = F.WguT + (size_t)e * D * D;
        const bf16* pb[2] = {Wb + (size_t)(8 * (jj >> 2) + (jj & 3)) * D + 8 * h, Wb + (size_t)(8 * (jj >> 2) + 4 + (jj & 3)) * D + 8 * h};
        f32x16 acc[2][2]; sg_zero<2>(acc);
        sg_mainloop<2>(acc, pa, pb, 0, D);
#pragma unroll
        for (int mi = 0; mi < 2; ++mi)
#pragma unroll
            for (int g = 0; g < 4; ++g) {
                const size_t row = (size_t)tile * 256 + wm * 64 + 32 * mi + r; const int col = j0 + 8 * g + 4 * h;
                float hv[4];
#pragma unroll
                for (int i = 0; i < 4; ++i) { const float ga = acc[0][mi][4 * g + i], up = acc[1][mi][4 * g + i]; hv[i] = ga / (1.0f + __expf(-ga)) * up; }
                u32x2 w; w.x = pk2(hv[0], hv[1]); w.y = pk2(hv[2], hv[3]);
                *(u32x2*)(F.HM + row * DFF + col) = w;
            }
    }
}
__device__ __forceinline__ void phase_moe2_simple(Frame& F) {
    build_tiles(F);
    const int r = F.lane & 31, h = F.lane >> 5, wm = F.wave >> 1, wn = F.wave & 1;
    const int T = (int)F.MISC[NE];
    for (int u = F.vcu; u < T * 8; u += F.G) {
        const int tile = u >> 3, pn = u & 7, e = find_expert(F, tile);
        const size_t row0 = (size_t)tile * 256 + wm * 64; const int n0 = pn * 128 + wn * 64;
        const bf16* pa[2] = {F.HM + (row0 + r) * DFF + 8 * h, F.HM + (row0 + 32 + r) * DFF + 8 * h};
        const bf16* Wb = F.WdT + (size_t)e * D * DFF;
        const bf16* pb[2] = {Wb + (size_t)(n0 + r) * DFF + 8 * h, Wb + (size_t)(n0 + 32 + r) * DFF + 8 * h};
        f32x16 acc[2][2]; sg_zero<2>(acc);
        sg_mainloop<2>(acc, pa, pb, 0, DFF);
#pragma unroll
        for (int ni = 0; ni < 2; ++ni)
#pragma unroll
            for (int mi = 0; mi < 2; ++mi)
#pragma unroll
                for (int g = 0; g < 4; ++g) {
                    const size_t row = row0 + 32 * mi + r; const int n = n0 + 32 * ni + 8 * g + 4 * h;
                    u32x2 w; w.x = pk2(acc[ni][mi][4 * g], acc[ni][mi][4 * g + 1]); w.y = pk2(acc[ni][mi][4 * g + 2], acc[ni][mi][4 * g + 3]);
                    *(u32x2*)(F.YB + row * D + n) = w;
                }
    }
}
__device__ __forceinline__ void phase_final(Frame& F) {
    build_tiles(F);
    const int gw = F.vcu * NWAVES + F.wave, NGW = F.G * NWAVES;
    for (int ch = gw; ch < M / 32; ch += NGW) {
        const int b = ch / (SEQ / 32);
        f32x4 gate[4], gf[4];
#pragma unroll
        for (int j = 0; j < 4; ++j) { const int col = 4 * F.lane + 256 * j; gate[j] = *(const f32x4*)(F.mod + b * 6144 + 5120 + col); gf[j] = *(const f32x4*)(F.g_final + col); }
        for (int rr = 0; rr < 32; ++rr) {
            const size_t m = (size_t)ch * 32 + rr;
            const i32x4 ts = F.tokslot[m]; const float w1 = F.tokw[2 * m], w2 = F.tokw[2 * m + 1];
            const size_t ra = (size_t)F.MISC[ts.x] * 256 + ts.y, rb = (size_t)F.MISC[ts.z] * 256 + ts.w;
            f32x4* xr = (f32x4*)(F.out + m * D) + F.lane;
            f32x4 v[4]; float s = 0.f;
#pragma unroll
            for (int j = 0; j < 4; ++j) { const int col = 4 * F.lane + 256 * j;
                const f32x4 ya = ld_bf4(F.YB + ra * D + col), yb = ld_bf4(F.YB + rb * D + col);
                v[j] = xr[64 * j] + gate[j] * (ya * w1 + yb * w2);
                s += (v[j].x * v[j].x + v[j].y * v[j].y) + (v[j].z * v[j].z + v[j].w * v[j].w); }
            const float rs = 1.0f / sqrtf(wave_sum(s) * (1.f / D) + NORM_EPS);
#pragma unroll
            for (int j = 0; j < 4; ++j) xr[64 * j] = v[j] * rs * gf[j];
        }
    }
}

__device__ __forceinline__ void phase_qkv_fast(Frame& F) {
    pg8::Gemm g{F.HB, F.WinT, D}; pg8::StaticOrder S; S.init(M, 3 * D, F.G, (int)blockIdx.x);
    pg8::EpiQKV E{F.QKV};
    pg8::gemm_phase<pg8::EpiQKV, pg8::StaticOrder, 0>(F.lds, g, S, E);
}
__device__ __forceinline__ void phase_outproj_fast(Frame& F) {
    pg8::StaticOrder S; S.init(M, D, F.G, (int)blockIdx.x);
    LAS float* side = (LAS float*)(F.lds + pg8::SIDE_OFF);
    pg8::Unit u;
    for (int i = 0; i < 8 && S.next(i, u); ++i) {
        if (F.tid < 256) { const int m = u.pm * 256 + F.tid; const float rsd = 1.0f / sqrtf(F.ssq[2 * m] * (1.f / DH) + NORM_EPS), rss = 1.0f / sqrtf(F.ssq[2 * m + 1] * (1.f / DH) + NORM_EPS);
            side[(i * 256 + F.tid) * 2] = rsd / rss; side[(i * 256 + F.tid) * 2 + 1] = rss; }
    }
    __syncthreads();
    pg8::Gemm g{F.OB, F.WoutT, D};
    pg8::EpiOutProj E{F.x, F.out, F.mod, (const LAS float*)side};
    pg8::gemm_phase<pg8::EpiOutProj, pg8::StaticOrder, 2>(F.lds, g, S, E);
}
struct MoeOrder {
    const volatile LAS unsigned* ts; int T4, G, c;
    __device__ __forceinline__ bool next(int i, pg8::Unit& u) const {
        const int L = i * G + c; if (L >= T4) return false;
        const int tile = L >> 2, pn = L & 3; int e = 0;
#pragma unroll 1
        for (int k = 1; k < NE; ++k) { if ((int)ts[k] <= tile) e = k; else break; }
        u.pm = tile; u.pn = pn; u.pb = e * 4 + pn; u.li = i; return true;
    }
};
__device__ __forceinline__ void phase_moe1_fast(Frame& F) {
    build_tiles(F);
    MoeOrder S{F.MISC, 4 * (int)F.MISC[NE], F.G, F.vcu};
    LAS int* idxtab = (LAS int*)(F.lds + pg8::SIDE_OFF);
    pg8::Unit u;
    for (int i = 0; i < 16 && S.next(i, u); ++i) {
        if (F.tid < 256) { const int e = u.pb >> 2, jt = u.pm - (int)F.MISC[e]; const int cnt = (int)__hip_atomic_load(F.cnt + 64 * e, __ATOMIC_RELAXED, __HIP_MEMORY_SCOPE_AGENT);
            const int pos = jt * 256 + F.tid; idxtab[i * 256 + F.tid] = (pos < cnt) ? F.list[(size_t)e * LIST_CAP + pos] : 0; }
    }
    __syncthreads();
    pg8::Gemm g{F.HB, F.WguT, D};
    pg8::EpiSwiGLU E{F.HM};
    pg8::gemm_phase<pg8::EpiSwiGLU, MoeOrder, 1>(F.lds, g, S, E);
}
__device__ __forceinline__ void phase_moe2_fast(Frame& F) {
    build_tiles(F);
    MoeOrder S{F.MISC, 4 * (int)F.MISC[NE], F.G, F.vcu};
    pg8::Gemm g{F.HM, F.WdT, DFF};
    pg8::EpiY E{F.YB, D};
    pg8::gemm_phase<pg8::EpiY, MoeOrder, 0>(F.lds, g, S, E);
}

constexpr int N_PHASES = 9;
struct Args { const float* in[16]; float* out; unsigned char* ws; int ph_lo, ph_hi; };
__global__ void __launch_bounds__(NTHREADS, 2) mk_fwd(Args args) {
    extern __shared__ __attribute__((aligned(16))) unsigned char lds[];
    Frame F;
    F.lds = (LAS unsigned char*)lds; F.MISC = (volatile LAS unsigned*)(F.lds + MISC_OFF);
    F.tid = threadIdx.x; F.lane = F.tid & 63; F.wave = __builtin_amdgcn_readfirstlane(F.tid >> 6);
    F.G = gridDim.x; { const int bx = blockIdx.x; F.vcu = (F.G % 8 == 0) ? (bx % 8) * (F.G / 8) + bx / 8 : bx; }
    unsigned char* ws = args.ws; F.ws = ws; F.ctl = (unsigned*)(ws + WS_CTL);
    F.x = args.in[0]; F.c = args.in[1]; F.w_ada = args.in[2]; F.b_ada = args.in[3]; F.g_mix = args.in[4]; F.w_in = args.in[5]; F.g_dil = args.in[6]; F.g_sb = args.in[7];
    F.w_out = args.in[8]; F.g_ffn = args.in[9]; F.w_group = args.in[10]; F.w_expert = args.in[11]; F.w_gate = args.in[12]; F.w_up = args.in[13]; F.w_down = args.in[14]; F.g_final = args.in[15];
    F.out = args.out;
    F.mod = (float*)(ws + WS_MOD); F.WinT = (bf16*)(ws + WS_WIN); F.WoutT = (bf16*)(ws + WS_WOUT); F.WguT = (bf16*)(ws + WS_WGU); F.WdT = (bf16*)(ws + WS_WD);
    F.HB = (bf16*)(ws + WS_H); F.QKV = (bf16*)(ws + WS_QKV); F.OB = (bf16*)(ws + WS_O); F.HM = (bf16*)(ws + WS_PART); F.YB = (bf16*)(ws + WS_QKV);
    F.list = (int*)(ws + WS_LIST); F.tokslot = (i32x4*)(ws + WS_TOKSLOT); F.tokw = (float*)(ws + WS_TOKW); F.ssq = (float*)(F.ctl + CW_SSQ); F.cnt = F.ctl + CW_CNT;
    for (int u = F.tid; u < 64; u += NTHREADS) F.MISC[u] = 0u;
    __syncthreads();
    const int lo = args.ph_lo, hi = args.ph_hi;
    XcdBarrier bar; bar.bar = F.ctl + CW_BAR; bar.x = 0; bar.st = nullptr;
    if (hi - lo > 1) bar = xcd_barrier_post(F.ctl + CW_BAR, F.MISC + 40);
#define IN(k) (lo <= (k) && (k) < hi)
#define SEAM(k) do { if (IN(k) && IN((k) + 1)) xcd_barrier(bar); } while (0)
    if (IN(0)) { phase_mod(F); } SEAM(0);
    if (IN(1)) { phase_prep(F); } SEAM(1);
    if (IN(2)) { if (FAST_QKV) phase_qkv_fast(F); else phase_qkv_simple(F); } SEAM(2);
    if (IN(3)) { if (FAST_ATTN) phase_attn_fast(F); else phase_attn_naive(F); } SEAM(3);
    if (IN(4)) { if (FAST_OUT) phase_outproj_fast(F); else phase_outproj_simple(F); } SEAM(4);
    if (IN(5)) { phase_router(F); } SEAM(5);
    if (IN(6)) { if (FAST_MOE1) phase_moe1_fast(F); else phase_moe1_simple(F); } SEAM(6);
    if (IN(7)) { if (FAST_MOE2) phase_moe2_fast(F); else phase_moe2_simple(F); } SEAM(7);
    if (IN(8)) { phase_final(F); }
#undef IN
#undef SEAM
}

extern "C" void kernel_launch(void* const* d_in, const int* in_sizes, int n_in, void* d_out, int out_size, void* d_ws, size_t ws_size, hipStream_t stream) {
    static int grid = 0;
    if (grid == 0) {
        if (n_in != 16 || in_sizes[0] != M * D || out_size != M * D || ws_size < WS_END) { fprintf(stderr, "kernel_launch: unexpected shapes / workspace (n_in %d, ws %zu)\n", n_in, ws_size); grid = -1; return; }
        int dev = 0, cus = 0;
        if (hipGetDevice(&dev) != hipSuccess || hipDeviceGetAttribute(&cus, hipDeviceAttributeMultiprocessorCount, dev) != hipSuccess) { grid = -1; return; }
        if (hipFuncSetAttribute((const void*)mk_fwd, hipFuncAttributeMaxDynamicSharedMemorySize, LDS_BYTES) != hipSuccess) { fprintf(stderr, "kernel_launch: hipFuncSetAttribute failed\n"); grid = -1; return; }
        int per_cu = 0;
        if (hipOccupancyMaxActiveBlocksPerMultiprocessor(&per_cu, (const void*)mk_fwd, NTHREADS, LDS_BYTES) != hipSuccess || per_cu < 1) fprintf(stderr, "kernel_launch: occupancy query says %d\n", per_cu);
        (void)hipGetLastError();
        grid = cus;
    }
    if (grid < 0) return;
    (void)hipMemsetAsync((char*)d_ws + WS_CTL, 0, CTL_ZERO_BYTES, stream);
    Args a{};
    for (int i = 0; i < 16; ++i) a.in[i] = (const float*)d_in[i];
    a.out = (float*)d_out; a.ws = (unsigned char*)d_ws;
    constexpr int NL = MK_N_LAUNCHES;
    for (int li = 0; li < NL; ++li) {
        a.ph_lo = (NL == N_PHASES) ? li : (li * N_PHASES) / NL; a.ph_hi = (NL == N_PHASES) ? li + 1 : ((li + 1) * N_PHASES) / NL;
        hipLaunchKernelGGL(mk_fwd, dim3(grid), dim3(NTHREADS), LDS_BYTES, stream, a);
    }
}
```

```cpp
#include <hip/hip_runtime.h>
#include <cstdio>
#include <cstdint>

#ifndef PROBE_PHASE
#define PROBE_PHASE -1
#endif
#ifndef FUSE_OUT_ROUTER
#define FUSE_OUT_ROUTER 0
#endif
#ifndef DIL_PIPE
#define DIL_PIPE 1
#endif
#ifndef FAST_ATTN
#define FAST_ATTN 2
#endif
#ifndef FAST_QKV
#define FAST_QKV 1
#endif
#ifndef FAST_OUT
#define FAST_OUT 1
#endif
#ifndef FAST_MOE1
#define FAST_MOE1 1
#endif
#ifndef FAST_MOE2
#define FAST_MOE2 1
#endif
#ifndef MK_N_LAUNCHES
#define MK_N_LAUNCHES 1
#endif

#define GAS __attribute__((address_space(1)))
#define LAS __attribute__((address_space(3)))
typedef unsigned short bf16;
typedef short bf16x8 __attribute__((ext_vector_type(8)));
typedef float f32x4 __attribute__((ext_vector_type(4)));
typedef float f32x16 __attribute__((ext_vector_type(16)));
typedef unsigned u32x4 __attribute__((ext_vector_type(4)));
typedef unsigned u32x2 __attribute__((ext_vector_type(2)));
typedef int i32x4 __attribute__((ext_vector_type(4)));

constexpr int NB = 8, SEQ = 8192, D = 1024, M = NB * SEQ;
constexpr int HD = 64, NH = 8, DH = 512;
constexpr int NE = 32, EPG = 8, NGRP = 4, DFF = 512;
constexpr float NORM_EPS = 1e-6f;
constexpr float LOG2E = 1.4426950408889634f;
constexpr float C2 = 0.125f * LOG2E;
constexpr int NWAVES = 8, NTHREADS = 512;
constexpr int LIST_CAP = M;
constexpr int MAX_TILES = (2 * M) / 256 + NE;

constexpr size_t MiB = 1u << 20;
constexpr size_t WS_CTL = 0, CTL_ZERO_BYTES = 128 * 1024;
constexpr size_t WS_MOD = 2 * MiB;
constexpr size_t WS_WIN = 4 * MiB;
constexpr size_t WS_WOUT = 10 * MiB;
constexpr size_t WS_WGU = 12 * MiB;
constexpr size_t WS_WD = 76 * MiB;
constexpr size_t WS_LIST = 108 * MiB;
constexpr size_t WS_TOKSLOT = 116 * MiB;
constexpr size_t WS_TOKW = 117 * MiB;
constexpr size_t WS_H = 120 * MiB;
constexpr size_t WS_QKV = 248 * MiB;
constexpr size_t WS_PART = 632 * MiB;
constexpr size_t WS_O = 768 * MiB;
constexpr size_t WS_SSQP = 896 * MiB;
constexpr size_t WS_END = 900 * MiB;
static_assert(WS_QKV + (size_t)MAX_TILES * 256 * 1024 * 2 <= WS_PART && WS_PART + (size_t)MAX_TILES * 256 * 512 * 2 <= WS_O, "overlays");
constexpr int CW_BAR = 4096;
constexpr int CW_CNT = 16384;
static_assert((CW_CNT + 64 * NE) * 4 <= (int)CTL_ZERO_BYTES && (CW_BAR + 3456) <= CW_CNT, "ctl");

constexpr int LDS_MAIN = 147456;
constexpr int MISC_OFF = LDS_MAIN;
constexpr int LDS_BYTES = LDS_MAIN + 1024;

__device__ __forceinline__ float bf2f(bf16 v) { return __uint_as_float((unsigned)v << 16); }
__device__ __forceinline__ unsigned f2bf(float f) { unsigned u = __float_as_uint(f); return (u + 0x7fffu + ((u >> 16) & 1u)) >> 16; }
__device__ __forceinline__ unsigned pk2(float lo, float hi) { return f2bf(lo) | (f2bf(hi) << 16); }
template <int CTRL> __device__ __forceinline__ float dpp_mov(float v) { return __int_as_float(__builtin_amdgcn_mov_dpp(__float_as_int(v), CTRL, 0xf, 0xf, true)); }
__device__ __forceinline__ float wave_sum(float v) {
    v += dpp_mov<0xB1>(v); v += dpp_mov<0x4E>(v); v += dpp_mov<0x141>(v); v += dpp_mov<0x140>(v);
    const float r0 = __int_as_float(__builtin_amdgcn_readlane(__float_as_int(v), 0)), r1 = __int_as_float(__builtin_amdgcn_readlane(__float_as_int(v), 16));
    const float r2 = __int_as_float(__builtin_amdgcn_readlane(__float_as_int(v), 32)), r3 = __int_as_float(__builtin_amdgcn_readlane(__float_as_int(v), 48));
    return (r0 + r1) + (r2 + r3);
}
__device__ __forceinline__ float rowsum16(float v) { v += dpp_mov<0xB1>(v); v += dpp_mov<0x4E>(v); v += dpp_mov<0x141>(v); v += dpp_mov<0x140>(v); return v; }
__device__ __forceinline__ float swap32_add(float a, float b) { auto rr = __builtin_amdgcn_permlane32_swap(__float_as_uint(a), __float_as_uint(b), false, false); return __uint_as_float(rr[0]) + __uint_as_float(rr[1]); }
__device__ __forceinline__ float swap16_add(float a, float b) { auto rr = __builtin_amdgcn_permlane16_swap(__float_as_uint(a), __float_as_uint(b), false, false); return __uint_as_float(rr[0]) + __uint_as_float(rr[1]); }
__device__ __forceinline__ float rdl(float v, int l) { return __int_as_float(__builtin_amdgcn_readlane(__float_as_int(v), l)); }
__device__ __forceinline__ void wave_sum4(float (&v)[4]) {
    const float a = swap32_add(v[0], v[2]), b = swap32_add(v[1], v[3]);
    const float c = rowsum16(swap16_add(a, b));
    v[0] = rdl(c, 0); v[1] = rdl(c, 16); v[2] = rdl(c, 32); v[3] = rdl(c, 48);
}
__device__ __forceinline__ void wave_sum8(float (&v)[8]) {
    const float a0 = swap32_add(v[0], v[4]), a1 = swap32_add(v[1], v[5]), a2 = swap32_add(v[2], v[6]), a3 = swap32_add(v[3], v[7]);
    const float c0 = rowsum16(swap16_add(a0, a2)), c1 = rowsum16(swap16_add(a1, a3));
    v[0] = rdl(c0, 0); v[1] = rdl(c1, 0); v[2] = rdl(c0, 16); v[3] = rdl(c1, 16); v[4] = rdl(c0, 32); v[5] = rdl(c1, 32); v[6] = rdl(c0, 48); v[7] = rdl(c1, 48);
}
__device__ __forceinline__ int crow(int r, int hi) { return (r & 3) + 8 * (r >> 2) + 4 * hi; }
#define MFMA32(a, b, c) __builtin_amdgcn_mfma_f32_32x32x16_bf16((a), (b), (c), 0, 0, 0)

#define XB_TMO      128
#define XB_XCNT(j)  (256  + 64 * (j))
#define XB_XSUB(j)  (1280 + 64 * (j))
#define XB_XGEN(j)  (2304 + 64 * (j))
#define XB_TOP      3328
#define XB_TOPGEN   3392
#define XCD_BAR_WORDS 3456
#define XB_SPIN_CAP (1u << 18)
__device__ __forceinline__ unsigned xb_ld(unsigned* p)              { return __hip_atomic_load(p, __ATOMIC_RELAXED, __HIP_MEMORY_SCOPE_AGENT); }
__device__ __forceinline__ unsigned xb_add(unsigned* p, unsigned v) { return __hip_atomic_fetch_add(p, v, __ATOMIC_RELAXED, __HIP_MEMORY_SCOPE_AGENT); }
__device__ __forceinline__ unsigned xb_xcc_id() { return (unsigned)__builtin_amdgcn_s_getreg((3 << 11) | 20) & 0xFu; }
#define XB_SPIN(cond, bar) do { unsigned _sp = 0; while (cond) { __builtin_amdgcn_s_sleep(1); \
    if ((++_sp & 255u) == 0u) { if (xb_ld(&(bar)[XB_TMO])) break; if (_sp > XB_SPIN_CAP) { atomicAdd(&(bar)[XB_TMO], 1u); break; } } } } while (0)
struct XcdBarrier { unsigned* bar; unsigned x; volatile LAS unsigned* st; };
__device__ __forceinline__ XcdBarrier xcd_barrier_post(unsigned* bar, volatile LAS unsigned* st) {
    XcdBarrier b; b.bar = bar; b.x = xb_xcc_id(); b.st = st;
    if (threadIdx.x == 0) (void)xb_add(&bar[XB_XCNT(b.x)], 1u);
    return b;
}
__device__ __forceinline__ void xcd_barrier_complete(unsigned* bar, unsigned x, unsigned& nloc, unsigned& nx) {
    const unsigned G = gridDim.x * gridDim.y * gridDim.z;
    unsigned sum, cnt, mine, sp = 0u;
    for (;;) {
        sum = 0u; cnt = 0u; mine = 0u;
#pragma unroll
        for (unsigned j = 0; j < 16; ++j) { const unsigned c = xb_ld(&bar[XB_XCNT(j)]); sum += c; cnt += (c > 0u) ? 1u : 0u; mine = (j == x) ? c : mine; }
        if (sum == G) break;
        __builtin_amdgcn_s_sleep(1);
        if ((++sp & 255u) == 0u) { if (xb_ld(&bar[XB_TMO])) break; if (sp > XB_SPIN_CAP) { atomicAdd(&bar[XB_TMO], 1u); break; } }
    }
    nloc = mine > 0u ? mine : 1u; nx = cnt > 0u ? cnt : 1u;
}
__device__ __forceinline__ void xcd_barrier(const XcdBarrier& b) {
    asm volatile("s_waitcnt vmcnt(0)" ::: "memory");
    __syncthreads();
    if (threadIdx.x == 0) {
        unsigned* bar = b.bar;
        __builtin_amdgcn_s_waitcnt(0);
        unsigned nloc = b.st[0], nx = b.st[1];
        if (nloc == 0u) { xcd_barrier_complete(bar, b.x, nloc, nx); b.st[0] = nloc; b.st[1] = nx; }
        const unsigned old = xb_add(&bar[XB_XSUB(b.x)], 1u);
        const unsigned gen = old / nloc;
        if (old + 1u == (gen + 1u) * nloc) {
            __builtin_amdgcn_fence(__ATOMIC_RELEASE, "agent");
            asm volatile("s_waitcnt vmcnt(0)" ::: "memory");
            const unsigned og = xb_add(&bar[XB_TOP], 1u);
            const unsigned tg = og / nx;
            if (og + 1u == (tg + 1u) * nx) xb_add(&bar[XB_TOPGEN], 1u);
            else XB_SPIN(xb_ld(&bar[XB_TOPGEN]) == tg, bar);
            __builtin_amdgcn_fence(__ATOMIC_ACQUIRE, "agent");
            xb_add(&bar[XB_XGEN(b.x)], 1u);
            asm volatile("s_waitcnt vmcnt(0)" ::: "memory");
        } else {
            XB_SPIN(xb_ld(&bar[XB_XGEN(b.x)]) == gen, bar);
            __builtin_amdgcn_fence(__ATOMIC_ACQUIRE, "agent");
            asm volatile("s_waitcnt vmcnt(0)" ::: "memory");
        }
    }
    __syncthreads();
}

struct Frame {
    LAS unsigned char* lds;
    volatile LAS unsigned* MISC;
    unsigned* ctl;
    int tid, lane, wave, vcu, G;
    const float *x, *c, *w_ada, *b_ada, *g_mix, *w_in, *g_dil, *g_sb, *w_out, *g_ffn, *w_group, *w_expert, *w_gate, *w_up, *w_down, *g_final;
    float* out; unsigned char* ws;
    float* mod; bf16 *WinT, *WoutT, *WguT, *WdT, *HB, *QKV, *OB, *HM, *YB;
    int* list; i32x4* tokslot; float* tokw; float* ssq; unsigned* cnt;
};

__device__ __forceinline__ void phase_mod(Frame& F) {
    LAS float* sc = (LAS float*)F.lds;
    LAS float* red = sc + 8192;
    for (int i = F.tid; i < NB * D; i += NTHREADS) { const float v = F.c[i]; sc[i] = v / (1.f + __expf(-v)); }
    __syncthreads();
    for (int cg = blockIdx.x; cg < 256; cg += F.G) {
        const int ks = F.tid >> 5, cl = F.tid & 31; const bool act = cl < 24; const int col = cg * 24 + (act ? cl : 0);
        float acc[8];
#pragma unroll
        for (int b = 0; b < 8; ++b) acc[b] = 0.f;
        const float* wp = F.w_ada + (size_t)(ks * 64) * 6144 + col;
#pragma unroll 16
        for (int kk = 0; kk < 64; ++kk) { const float wv = wp[(size_t)kk * 6144];
#pragma unroll
            for (int b = 0; b < 8; ++b) acc[b] += sc[b * 1024 + ks * 64 + kk] * wv; }
#pragma unroll
        for (int b = 0; b < 8; ++b) red[(ks * 8 + b) * 32 + cl] = acc[b];
        __syncthreads();
        if (F.tid < 256) { const int b = F.tid >> 5, c2 = F.tid & 31;
            if (c2 < 24) { float s = 0.f;
#pragma unroll
                for (int k2 = 0; k2 < 16; ++k2) s += red[(k2 * 8 + b) * 32 + c2];
                F.mod[b * 6144 + cg * 24 + c2] = s + F.b_ada[cg * 24 + c2]; } }
        __syncthreads();
    }
}

template <class RowMap, bool PERMK = false>
__device__ __forceinline__ void transpose_item(const float* W, int K, int N, bf16* WT, RowMap rm, const float* gk, LAS float* scr, int item, int lane) {
    const int nblk = N / 32, kb = item / nblk, nb = item % nblk, k0 = 64 * kb, n0 = 32 * nb;
#pragma unroll 8
    for (int i = 0; i < 32; ++i) { const int kk = 2 * i + (lane >> 5); float v = W[(size_t)(k0 + kk) * N + n0 + (lane & 31)]; if (gk) v *= gk[k0 + kk]; scr[kk * 33 + (lane & 31)] = v; }
    asm volatile("s_waitcnt lgkmcnt(0)" ::: "memory");
    const int c = lane & 7;
#pragma unroll
    for (int j = 0; j < 4; ++j) { const int n = (lane >> 3) + 8 * j;
        const int rbase = PERMK ? (32 * ((c >> 1) & 1) + 16 * (c & 1) + 4 * (c >> 2)) : 8 * c;
        const LAS float* s = scr + rbase * 33 + n;
        u32x4 o;
        if (PERMK) { o.x = pk2(s[0 * 33], s[1 * 33]); o.y = pk2(s[2 * 33], s[3 * 33]); o.z = pk2(s[8 * 33], s[9 * 33]); o.w = pk2(s[10 * 33], s[11 * 33]); }
        else { o.x = pk2(s[0 * 33], s[1 * 33]); o.y = pk2(s[2 * 33], s[3 * 33]); o.z = pk2(s[4 * 33], s[5 * 33]); o.w = pk2(s[6 * 33], s[7 * 33]); }
        *(u32x4*)(WT + (size_t)rm(n0 + n) * K + k0 + 8 * c) = o; }
    asm volatile("s_waitcnt lgkmcnt(0)" ::: "memory");
}
struct RmId { __device__ __forceinline__ int operator()(int n) const { return n; } };
struct RmGU { int up; __device__ __forceinline__ int operator()(int n) const { return 8 * (n >> 2) + 4 * up + (n & 3); } };

struct WItem { const float* W; bf16* WT; const float* gk; int K, N, k0, n0, rmode  , permk; };
__device__ __forceinline__ void witem_decode(const Frame& F, int it, WItem& w) {
    constexpr int I_IN = 16 * 96, I_OUT = 16 * 32, I_G = 16 * 16, I_D = 8 * 32;
    int r = it; w.gk = nullptr; w.rmode = 0; w.permk = 0;
    if (r < I_IN) { w.W = F.w_in; w.WT = F.WinT; w.K = D; w.N = 3 * D; }
    else { r -= I_IN;
        if (r < I_OUT) { w.W = F.w_out; w.WT = F.WoutT; w.K = D; w.N = D; w.gk = ((r / 32) < 8) ? F.g_dil : (F.g_sb - 512); w.permk = 1; }
        else { r -= I_OUT; const int e = r / (2 * I_G + I_D); r -= e * (2 * I_G + I_D);
            if (r < I_G) { w.W = F.w_gate + (size_t)e * D * DFF; w.WT = F.WguT + (size_t)e * D * D; w.K = D; w.N = DFF; w.rmode = 1; }
            else { r -= I_G;
                if (r < I_G) { w.W = F.w_up + (size_t)e * D * DFF; w.WT = F.WguT + (size_t)e * D * D; w.K = D; w.N = DFF; w.rmode = 2; }
                else { r -= I_G; w.W = F.w_down + (size_t)e * DFF * D; w.WT = F.WdT + (size_t)e * D * DFF; w.K = DFF; w.N = D; } } } }
    const int nblk = w.N / 32; w.k0 = 64 * (r / nblk); w.n0 = 32 * (r % nblk);
}
__device__ __forceinline__ void witem_load(const WItem& w, f32x4 (&v)[8], int lane) {
    const int c4 = 4 * (lane & 7), rr = lane >> 3;
#pragma unroll
    for (int i = 0; i < 8; ++i) v[i] = *(const f32x4*)(w.W + (size_t)(w.k0 + 8 * i + rr) * w.N + w.n0 + c4);
}
__device__ __forceinline__ void witem_finish(const WItem& w, const f32x4 (&v)[8], LAS float* scr, int lane) {
    { const int c4 = 4 * (lane & 7), rr = lane >> 3;
#pragma unroll
      for (int i = 0; i < 8; ++i) { const int kk = 8 * i + rr; const float g = w.gk ? w.gk[w.k0 + kk] : 1.0f; LAS float* d = scr + kk * 33 + c4;
          d[0] = v[i].x * g; d[1] = v[i].y * g; d[2] = v[i].z * g; d[3] = v[i].w * g; } }
    asm volatile("s_waitcnt lgkmcnt(0)" ::: "memory");
    const int c = lane & 7;
    const int rbase = w.permk ? (32 * ((c >> 1) & 1) + 16 * (c & 1) + 4 * (c >> 2)) : 8 * c; const int hi = w.permk ? 8 : 4;
#pragma unroll
    for (int j = 0; j < 4; ++j) { const int n = (lane >> 3) + 8 * j; const LAS float* s = scr + rbase * 33 + n;
        u32x4 o; o.x = pk2(s[0 * 33], s[1 * 33]); o.y = pk2(s[2 * 33], s[3 * 33]); o.z = pk2(s[hi * 33], s[(hi + 1) * 33]); o.w = pk2(s[(hi + 2) * 33], s[(hi + 3) * 33]);
        const int nn = w.n0 + n; const int row = (w.rmode == 0) ? nn : (8 * (nn >> 2) + 4 * (w.rmode - 1) + (nn & 3));
        *(u32x4*)(w.WT + (size_t)row * w.K + w.k0 + 8 * c) = o; }
    asm volatile("s_waitcnt lgkmcnt(0)" ::: "memory");
}
__device__ __forceinline__ void phase_weights(Frame& F) {
    LAS float* scr = (LAS float*)(F.lds + F.wave * 16384);
    const int gw = F.vcu * NWAVES + F.wave, NGW = F.G * NWAVES;
    constexpr int NITEMS = 16 * 96 + 16 * 32 + NE * (2 * 16 * 16 + 8 * 32);
    if (gw >= NITEMS) return;
    WItem cur, nxt; f32x4 v[8], vn[8];
    witem_decode(F, gw, cur); witem_load(cur, v, F.lane);
    __builtin_amdgcn_s_waitcnt(0x0F70);
    for (int it = gw; it < NITEMS; it += NGW) {
        const bool has_next = it + NGW < NITEMS;
        witem_decode(F, has_next ? it + NGW : it, nxt); witem_load(nxt, vn, F.lane);
        witem_finish(cur, v, scr, F.lane);
        cur = nxt;
#pragma unroll
        for (int i = 0; i < 8; ++i) v[i] = vn[i];
    }
}
__device__ __forceinline__ void phase_h(Frame& F) {
    const int gw = F.vcu * NWAVES + F.wave, NGW = F.G * NWAVES;
    for (int ch = gw; ch < M / 32; ch += NGW) {
        const int b = ch / (SEQ / 32);
        f32x4 gs[4], sh[4];
#pragma unroll
        for (int j = 0; j < 4; ++j) { const int col = 4 * F.lane + 256 * j;
            const f32x4 g = *(const f32x4*)(F.g_mix + col), scl = *(const f32x4*)(F.mod + b * 6144 + 1024 + col); sh[j] = *(const f32x4*)(F.mod + b * 6144 + col);
            gs[j] = g * (scl + 1.0f); }
        for (int rr = 0; rr < 32; ++rr) {
            const size_t m = (size_t)ch * 32 + rr;
            const f32x4* xr = (const f32x4*)(F.x + m * D) + F.lane;
            f32x4 v[4]; float s = 0.f;
#pragma unroll
            for (int j = 0; j < 4; ++j) { v[j] = __builtin_nontemporal_load(&xr[64 * j]); s += (v[j].x * v[j].x + v[j].y * v[j].y) + (v[j].z * v[j].z + v[j].w * v[j].w); }
            const float rs = 1.0f / sqrtf(wave_sum(s) * (1.f / D) + NORM_EPS);
            unsigned long long* o8 = (unsigned long long*)(F.HB + m * D) + F.lane;
#pragma unroll
            for (int j = 0; j < 4; ++j) { const f32x4 y = v[j] * rs * gs[j] + sh[j];
                o8[64 * j] = (unsigned long long)pk2(y.x, y.y) | ((unsigned long long)pk2(y.z, y.w) << 32); }
        }
    }
}

template <int NI>
__device__ __forceinline__ void sg_mainloop(f32x16 (&acc)[NI][2], const bf16* const (&pa)[2], const bf16* const (&pb)[NI], int kbeg, int kend) {
#pragma unroll 2
    for (int k = kbeg; k < kend; k += 32) {
        bf16x8 a[2][2], b[NI][2];
#pragma unroll
        for (int s = 0; s < 2; ++s) {
#pragma unroll
            for (int mi = 0; mi < 2; ++mi) a[mi][s] = *(const bf16x8*)(pa[mi] + k + 16 * s);
#pragma unroll
            for (int ni = 0; ni < NI; ++ni) b[ni][s] = *(const bf16x8*)(pb[ni] + k + 16 * s);
        }
#pragma unroll
        for (int s = 0; s < 2; ++s)
#pragma unroll
            for (int ni = 0; ni < NI; ++ni)
#pragma unroll
                for (int mi = 0; mi < 2; ++mi) acc[ni][mi] = MFMA32(b[ni][s], a[mi][s], acc[ni][mi]);
    }
}
template <int NI> __device__ __forceinline__ void sg_zero(f32x16 (&acc)[NI][2]) {
#pragma unroll
    for (int ni = 0; ni < NI; ++ni)
#pragma unroll
        for (int mi = 0; mi < 2; ++mi)
#pragma unroll
            for (int i = 0; i < 16; ++i) acc[ni][mi][i] = 0.f;
}

namespace pg8 {
typedef unsigned short bf16_t;
constexpr int BM = 256, BK = 64, HALF = 128, HTB = HALF * BK * 2, STAGE_BYTES = 8 * HTB, NXCD = 8, WGM = 8;
constexpr int SIDE_OFF = STAGE_BYTES;
__host__ __device__ __forceinline__ int lds_byte(int r, int c) { const int st = (r >> 4) * 2 + (c >> 5), rr = r & 15, cc = c & 31, ob = rr * 64 + cc * 2; return st * 1024 + (ob ^ (((ob >> 9) & 1) << 5)); }
__host__ __device__ __forceinline__ void stage_rc(int b, int& R, int& C) { const int st = b / 1024, sb = b % 1024, swz = sb ^ (((sb >> 9) & 1) << 5); R = (st >> 1) * 16 + swz / 64; C = (st & 1) * 32 + (swz % 64) / 2; }
__host__ __device__ __forceinline__ int perm32(int rho) { const int n = rho >> 4, i = rho & 15; return 8 * (i >> 2) + 4 * n + (i & 3); }
struct Unit { int pm, pn, pb, li; };
struct Gemm { const bf16_t* A; const bf16_t* Bt; int K; };
struct StaticOrder {
    int nM, nN, nwg, G, c;
    __device__ void init(int M_, int N_, int G_, int c_) { nM = M_ / BM; nN = N_ / BM; nwg = nM * nN; G = G_; c = c_; }
    __device__ bool next(int i, Unit& u) const {
        const long L = (long)i * G + c; if (L >= nwg) return false;
        int wgid = (int)L; { const int q = nwg / NXCD, r = nwg % NXCD, xcd = wgid % NXCD, off = wgid / NXCD; wgid = (xcd < r ? xcd * (q + 1) : r * (q + 1) + (xcd - r) * q) + off; }
        const int nig = WGM * nN, gid = wgid / nig, fm = gid * WGM, gsz = (nM - fm) < WGM ? (nM - fm) : WGM;
        u.pm = fm + ((wgid % nig) % gsz); u.pn = (wgid % nig) / gsz; u.pb = u.pn; u.li = i; return true;
    }
};
__device__ __forceinline__ unsigned cvt_pk_bf16(float lo, float hi) { unsigned r; asm volatile("v_cvt_pk_bf16_f32 %0, %1, %2" : "=v"(r) : "v"(lo), "v"(hi)); return r; }

template <class Epi, class Sched, int MODE>
__device__ __forceinline__ void gemm_phase(LAS unsigned char* lds, const Gemm g, const Sched& S, const Epi& E) {
    constexpr bool GATHER = (MODE == 1), RESCALE = (MODE == 2);
    const int tid = threadIdx.x, wid = __builtin_amdgcn_readfirstlane(tid >> 6), lane = tid & 63, wr = wid >> 2, wc = wid & 3, fr = lane & 15, fq = lane >> 4;
    const int K = g.K, nt = K / BK;
    unsigned voffA[2], voffB[2]; int RA[2], CA2[2];
#pragma unroll
    for (int i = 0; i < 2; ++i) { int R, C; stage_rc(tid * 16 + i * 8192, R, C); const int Rb = Epi::PERM ? ((R & ~31) + perm32(R & 31)) : R;
        voffA[i] = (unsigned)(R * K + C) * 2u; voffB[i] = (unsigned)(Rb * K + C) * 2u; RA[i] = R; CA2[i] = C * 2; }
    const size_t kstep = (size_t)(BK * 2);
    const size_t hstep = (size_t)HALF * K * 2;
    const size_t tstep = 2 * hstep;
    const unsigned ldsw = (unsigned)wid * 1024u;
    const int aoff = lds_byte(wr * 64 + fr, fq * 8), boff = lds_byte(wc * 32 + fr, fq * 8);
    const LAS int* idxtab = (const LAS int*)(lds + SIDE_OFF);
#define PG8_SA(b, h) (((b) * 2 + (h)) * HTB)
#define PG8_SB(b, h) ((4 + (b) * 2 + (h)) * HTB)
#define PG8_STAGE2(bufoff, gbase, o0, o1) do { \
        __builtin_amdgcn_global_load_lds((const unsigned*)((const char*)(gbase) + (o0)), (LAS unsigned*)(lds + (bufoff) + ldsw), 16, 0, 0); \
        __builtin_amdgcn_global_load_lds((const unsigned*)((const char*)(gbase) + (o1)), (LAS unsigned*)(lds + (bufoff) + ldsw + 8192), 16, 0, 0); } while (0)
#define PG8_STAGE(bufoff, gbase, voff) PG8_STAGE2(bufoff, gbase, (voff)[0], (voff)[1])
#define PG8_STAGE_A(bufoff, hf, aptr, NXT) do { if constexpr (GATHER) { const unsigned o0_ = (NXT) ? goffN[hf][0] : goffC[hf][0], o1_ = (NXT) ? goffN[hf][1] : goffC[hf][1]; PG8_STAGE2(bufoff, aptr, o0_, o1_); } \
        else { PG8_STAGE(bufoff, (aptr) + (hf) * hstep, voffA); } } while (0)
#define PG8_LDA(dst, b, h) do { _Pragma("unroll") for (int m = 0; m < 4; ++m) _Pragma("unroll") for (int k = 0; k < 2; ++k) dst[m][k] = *(const LAS bf16x8*)(lds + PG8_SA(b, h) + aoff + m * 2048 + k * 1024); } while (0)
#define PG8_LDB(dst, b, h) do { _Pragma("unroll") for (int n = 0; n < 2; ++n) _Pragma("unroll") for (int k = 0; k < 2; ++k) dst[n][k] = *(const LAS bf16x8*)(lds + PG8_SB(b, h) + boff + n * 2048 + k * 1024); } while (0)
#define PG8_MMA(ai, bj, At, Bt) do { __builtin_amdgcn_s_setprio(1); _Pragma("unroll") for (int m = 0; m < 4; ++m) _Pragma("unroll") for (int n = 0; n < 2; ++n) _Pragma("unroll") for (int k = 0; k < 2; ++k) \
        acc[ai][bj][m][n] = __builtin_amdgcn_mfma_f32_16x16x32_bf16(Bt[n][k], At[m][k], acc[ai][bj][m][n], 0, 0, 0); __builtin_amdgcn_s_setprio(0); } while (0)
#define PG8_WAIT_V(n) asm volatile("s_waitcnt vmcnt(" #n ")" ::: "memory")
#define PG8_WAIT_L(n) asm volatile("s_waitcnt lgkmcnt(" #n ")" ::: "memory")
#define PG8_BAR __builtin_amdgcn_s_barrier()
#define PG8_SCHED __builtin_amdgcn_sched_barrier(0)
#define PG8_GOFF(dst, u) do { _Pragma("unroll") for (int hf_ = 0; hf_ < 2; ++hf_) _Pragma("unroll") for (int i_ = 0; i_ < 2; ++i_) \
        dst[hf_][i_] = (unsigned)idxtab[(u).li * 256 + hf_ * 128 + RA[i_]] * (unsigned)(K * 2) + (unsigned)CA2[i_]; } while (0)
    Unit cur, nxt; int ui = 0;
    if (!S.next(0, cur)) return;
    f32x4 acc[2][2][4][2];
#pragma unroll
    for (int a = 0; a < 2; ++a)
#pragma unroll
        for (int b = 0; b < 2; ++b)
#pragma unroll
            for (int m = 0; m < 4; ++m)
#pragma unroll
                for (int n = 0; n < 2; ++n) acc[a][b][m][n] = (f32x4){0.f, 0.f, 0.f, 0.f};
    bf16x8 At[4][2], B0[2][2], B1[2][2];
    unsigned goffC[2][2] = {{0u, 0u}, {0u, 0u}}, goffN[2][2] = {{0u, 0u}, {0u, 0u}};
    if constexpr (GATHER) { PG8_GOFF(goffC, cur); }
    const char* cA = GATHER ? (const char*)g.A : (const char*)g.A + (size_t)cur.pm * tstep; const char* cB = (const char*)g.Bt + (size_t)cur.pb * tstep;
    PG8_STAGE(PG8_SB(0, 0), cB, voffB); PG8_STAGE(PG8_SB(0, 1), cB + hstep, voffB); PG8_STAGE_A(PG8_SA(0, 0), 0, cA, false); PG8_STAGE_A(PG8_SA(0, 1), 1, cA, false);
    if (wr == 1) PG8_BAR;
    PG8_WAIT_V(2); PG8_BAR;
    PG8_STAGE(PG8_SB(1, 0), cB + kstep, voffB); PG8_STAGE_A(PG8_SA(1, 0), 0, cA + kstep, false); PG8_STAGE(PG8_SB(1, 1), cB + hstep + kstep, voffB);
    PG8_WAIT_V(6); PG8_BAR;
    for (;;) {
        const bool has_next = S.next(ui + 1, nxt);
        const char* nA = GATHER ? cA : (has_next ? (const char*)g.A + (size_t)nxt.pm * tstep : cA); const char* nB = has_next ? (const char*)g.Bt + (size_t)nxt.pb * tstep : cB;
        if constexpr (GATHER) { if (has_next) { PG8_GOFF(goffN, nxt); } else {
#pragma unroll
            for (int hf = 0; hf < 2; ++hf) { goffN[hf][0] = goffC[hf][0]; goffN[hf][1] = goffC[hf][1]; } } }
        for (int t = 0; t < nt; t += 2) {
            const bool last = (t == nt - 2);
            const char* a1 = cA + (size_t)(t + 1) * kstep;
            const char* a2 = last ? nA : cA + (size_t)(t + 2) * kstep; const char* b2 = last ? nB : cB + (size_t)(t + 2) * kstep;
            const char* a3 = a2 + kstep; const char* b3 = b2 + kstep;
            if constexpr (RESCALE) { if (t == nt / 2) { const LAS float* sd = (const LAS float*)(lds + SIDE_OFF) + (size_t)cur.li * 512;
#pragma unroll
                for (int ai = 0; ai < 2; ++ai)
#pragma unroll
                    for (int m = 0; m < 4; ++m) { const float f = sd[2 * (ai * HALF + wr * 64 + m * 16 + fr)];
#pragma unroll
                        for (int bj = 0; bj < 2; ++bj)
#pragma unroll
                            for (int n = 0; n < 2; ++n) acc[ai][bj][m][n] = acc[ai][bj][m][n] * f; } } }
            PG8_LDB(B0, 0, 0); PG8_LDB(B1, 0, 1); PG8_SCHED; PG8_LDA(At, 0, 0); PG8_STAGE_A(PG8_SA(1, 1), 1, a1, false);
            PG8_WAIT_V(8); PG8_WAIT_L(0); PG8_BAR; PG8_MMA(0, 0, At, B0); PG8_MMA(0, 1, At, B1); PG8_BAR; PG8_SCHED;
            PG8_LDA(At, 0, 1); PG8_STAGE(PG8_SB(0, 0), b2, voffB); PG8_STAGE(PG8_SB(0, 1), b2 + hstep, voffB); PG8_STAGE_A(PG8_SA(0, 0), 0, a2, last);
            PG8_WAIT_V(8); PG8_WAIT_L(0); PG8_BAR; PG8_MMA(1, 0, At, B0); PG8_MMA(1, 1, At, B1); PG8_BAR; PG8_SCHED;
            PG8_LDB(B0, 1, 0); PG8_LDB(B1, 1, 1); PG8_SCHED; PG8_LDA(At, 1, 0); PG8_STAGE_A(PG8_SA(0, 1), 1, a2, last);
            PG8_WAIT_V(8); PG8_WAIT_L(0); PG8_BAR; PG8_MMA(0, 0, At, B0); PG8_MMA(0, 1, At, B1); PG8_BAR; PG8_SCHED;
            PG8_LDA(At, 1, 1); PG8_STAGE(PG8_SB(1, 0), b3, voffB); PG8_STAGE(PG8_SB(1, 1), b3 + hstep, voffB); PG8_STAGE_A(PG8_SA(1, 0), 0, a3, last);
            PG8_WAIT_V(8); PG8_WAIT_L(0); PG8_BAR; PG8_MMA(1, 0, At, B0); PG8_MMA(1, 1, At, B1); PG8_BAR; PG8_SCHED;
        }
        if (wr == 0) PG8_BAR;
        E(acc, cur, wr, wc, fr, fq);
        if (!has_next) break;
#pragma unroll
        for (int a = 0; a < 2; ++a)
#pragma unroll
            for (int b = 0; b < 2; ++b)
#pragma unroll
                for (int m = 0; m < 4; ++m)
#pragma unroll
                    for (int n = 0; n < 2; ++n) acc[a][b][m][n] = (f32x4){0.f, 0.f, 0.f, 0.f};
        cur = nxt; cA = nA; cB = nB; ++ui;
        if constexpr (GATHER) {
#pragma unroll
            for (int hf = 0; hf < 2; ++hf) { goffC[hf][0] = goffN[hf][0]; goffC[hf][1] = goffN[hf][1]; } }
        if (wr == 1) PG8_BAR;
    }
    PG8_WAIT_V(0);
    PG8_BAR;
#undef PG8_SA
#undef PG8_SB
#undef PG8_STAGE
#undef PG8_STAGE2
#undef PG8_STAGE_A
#undef PG8_LDA
#undef PG8_LDB
#undef PG8_MMA
#undef PG8_WAIT_V
#undef PG8_WAIT_L
#undef PG8_BAR
#undef PG8_SCHED
#undef PG8_GOFF
}

struct EpiQKV {
    static constexpr bool PERM = true;
    bf16_t* O;
    __device__ __forceinline__ void operator()(const f32x4 (&acc)[2][2][4][2], const Unit& u, int wr, int wc, int fr, int fq) const {
        const int row0 = u.pm * BM + wr * 64 + fr; const int colt = u.pn * BM; const int t = colt >> 9;
        const int b = (u.pm * BM) / SEQ, tok0 = row0 - b * SEQ;
        bf16_t* base = O + (size_t)t * M * DH; const float sc = (t == 0 || t == 3) ? C2 : 1.0f;
        const int cl = (colt & 511) + wc * 32 + 8 * fq, d = cl & 63, head0 = cl >> 6;
#pragma unroll
        for (int ai = 0; ai < 2; ++ai)
#pragma unroll
            for (int m = 0; m < 4; ++m) { const int tok = tok0 + ai * HALF + m * 16;
#pragma unroll
                for (int bj = 0; bj < 2; ++bj) { const f32x4 v0 = acc[ai][bj][m][0] * sc, v1 = acc[ai][bj][m][1] * sc;
                    u32x4 w; w.x = cvt_pk_bf16(v0[0], v0[1]); w.y = cvt_pk_bf16(v0[2], v0[3]); w.z = cvt_pk_bf16(v1[0], v1[1]); w.w = cvt_pk_bf16(v1[2], v1[3]);
                    *(u32x4*)(base + (((size_t)b * NH + head0 + 2 * bj) * SEQ + tok) * HD + d) = w; } }
    }
};
struct EpiY {
    static constexpr bool PERM = true;
    bf16_t* O; int ldc;
    __device__ __forceinline__ void operator()(const f32x4 (&acc)[2][2][4][2], const Unit& u, int wr, int wc, int fr, int fq) const {
        const int row0 = u.pm * BM + wr * 64 + fr; const int col0 = u.pn * BM + wc * 32 + 8 * fq;
#pragma unroll
        for (int ai = 0; ai < 2; ++ai)
#pragma unroll
            for (int m = 0; m < 4; ++m) { bf16_t* rowp = O + (size_t)(row0 + ai * HALF + m * 16) * ldc + col0;
#pragma unroll
                for (int bj = 0; bj < 2; ++bj) { const f32x4 v0 = acc[ai][bj][m][0], v1 = acc[ai][bj][m][1];
                    u32x4 w; w.x = cvt_pk_bf16(v0[0], v0[1]); w.y = cvt_pk_bf16(v0[2], v0[3]); w.z = cvt_pk_bf16(v1[0], v1[1]); w.w = cvt_pk_bf16(v1[2], v1[3]);
                    *(u32x4*)(rowp + bj * HALF) = w; } }
    }
};
struct EpiSwiGLU {
    static constexpr bool PERM = true;
    bf16_t* O;
    __device__ __forceinline__ void operator()(const f32x4 (&acc)[2][2][4][2], const Unit& u, int wr, int wc, int fr, int fq) const {
        const int row0 = u.pm * BM + wr * 64 + fr; const int col0 = u.pn * 128 + wc * 16 + 4 * fq;
#pragma unroll
        for (int ai = 0; ai < 2; ++ai)
#pragma unroll
            for (int m = 0; m < 4; ++m) { bf16_t* rowp = O + (size_t)(row0 + ai * HALF + m * 16) * DFF + col0;
#pragma unroll
                for (int bj = 0; bj < 2; ++bj) { const f32x4 ga = acc[ai][bj][m][0], up = acc[ai][bj][m][1]; float hv[4];
#pragma unroll
                    for (int i = 0; i < 4; ++i) hv[i] = ga[i] * __builtin_amdgcn_rcpf(1.0f + __builtin_amdgcn_exp2f(-LOG2E * ga[i])) * up[i];
                    u32x2 w; w.x = cvt_pk_bf16(hv[0], hv[1]); w.y = cvt_pk_bf16(hv[2], hv[3]);
                    *(u32x2*)(rowp + bj * 64) = w; } }
    }
};
struct EpiOutProj {
    static constexpr bool PERM = true;
    const float* x; bf16_t* x1; const float* mod; const LAS float* side;
    __device__ __forceinline__ void operator()(const f32x4 (&acc)[2][2][4][2], const Unit& u, int wr, int wc, int fr, int fq) const {
        const int b = (u.pm * BM) / SEQ; const int col0 = u.pn * BM + wc * 32 + 8 * fq;
        f32x4 gate[2][2];
#pragma unroll
        for (int bj = 0; bj < 2; ++bj)
#pragma unroll
            for (int n = 0; n < 2; ++n) gate[bj][n] = *(const f32x4*)(mod + b * 6144 + 2048 + col0 + bj * HALF + n * 4);
#pragma unroll
        for (int ai = 0; ai < 2; ++ai)
#pragma unroll
            for (int m = 0; m < 4; ++m) { const int rl = ai * HALF + wr * 64 + m * 16 + fr; const float rss = side[(size_t)u.li * 512 + 2 * rl + 1];
                const size_t row = (size_t)(u.pm * BM + rl);
#pragma unroll
                for (int bj = 0; bj < 2; ++bj) { const f32x4 xv0 = *(const f32x4*)(x + row * D + col0 + bj * HALF), xv1 = *(const f32x4*)(x + row * D + col0 + bj * HALF + 4);
                    const f32x4 r0 = xv0 + gate[bj][0] * (acc[ai][bj][m][0] * rss), r1 = xv1 + gate[bj][1] * (acc[ai][bj][m][1] * rss);
                    u32x4 w; w.x = cvt_pk_bf16(r0[0], r0[1]); w.y = cvt_pk_bf16(r0[2], r0[3]); w.z = cvt_pk_bf16(r1[0], r1[1]); w.w = cvt_pk_bf16(r1[2], r1[3]);
                    *(u32x4*)(x1 + row * (2 * D) + col0 + bj * HALF) = w; }
                if (m & 1) asm volatile("" ::: "memory"); }
    }
};
}

__device__ __forceinline__ f32x4 ld_bf4(const bf16* p) { const u32x2 w = *(const u32x2*)p; f32x4 r; r.x = __uint_as_float(w.x << 16); r.y = __uint_as_float(w.x & 0xffff0000u); r.z = __uint_as_float(w.y << 16); r.w = __uint_as_float(w.y & 0xffff0000u); return r; }
typedef short v4i16_t __attribute__((ext_vector_type(4)));
__device__ __forceinline__ ptrdiff_t hm_off(int b, int head, ptrdiff_t tok) { return (((ptrdiff_t)b * NH + head) * SEQ + tok) * HD; }
constexpr int VIMG_PITCH = 144, VIMG_BYTES = 8192;
__device__ __forceinline__ int pik(int rho) { return 16 * ((rho >> 2) & 1) + (rho & 3) + 4 * (rho >> 3); }
__device__ __forceinline__ unsigned cvtpk(float lo, float hi) { typedef float f2 __attribute__((ext_vector_type(2))); typedef __bf16 b2 __attribute__((ext_vector_type(2))); f2 v = {lo, hi}; b2 b = __builtin_convertvector(v, b2); return __builtin_bit_cast(unsigned, b); }
__device__ __forceinline__ bf16x8 pack8(const f32x16& p, int s) {
    u32x4 w; w.x = cvtpk(p[8 * s + 0], p[8 * s + 1]); w.y = cvtpk(p[8 * s + 2], p[8 * s + 3]); w.z = cvtpk(p[8 * s + 4], p[8 * s + 5]); w.w = cvtpk(p[8 * s + 6], p[8 * s + 7]);
    return __builtin_bit_cast(bf16x8, w);
}
__device__ __forceinline__ void load_kf(bf16x8 (&kf)[4], const bf16* rowp) {
#pragma unroll
    for (int d0 = 0; d0 < 4; ++d0) kf[d0] = *(const bf16x8*)(rowp + 16 * d0);
}
__device__ __forceinline__ void pv_block(f32x16 (&o)[2], const u32x4 (&vr)[4], const f32x16& p, LAS unsigned char* img, int lane) {
    const int h = lane >> 5;
#pragma unroll
    for (int i = 0; i < 4; ++i) *(LAS u32x4*)(img + ((lane >> 3) + 8 * i) * VIMG_PITCH + (lane & 7) * 16) = vr[i];
    const LAS unsigned char* vb = img + (16 * h + ((lane & 15) >> 2)) * VIMG_PITCH + (16 * ((lane >> 4) & 1) + 4 * (lane & 3)) * 2;
#pragma unroll
    for (int s = 0; s < 2; ++s) { const bf16x8 pf = pack8(p, s);
#pragma unroll
        for (int db = 0; db < 2; ++db) {
            const v4i16_t lo = __builtin_amdgcn_ds_read_tr16_b64_v4i16((LAS v4i16_t*)(vb + s * 8 * VIMG_PITCH + db * 64));
            const v4i16_t hi = __builtin_amdgcn_ds_read_tr16_b64_v4i16((LAS v4i16_t*)(vb + s * 8 * VIMG_PITCH + 4 * VIMG_PITCH + db * 64));
            const bf16x8 vf = (bf16x8){lo[0], lo[1], lo[2], lo[3], hi[0], hi[1], hi[2], hi[3]};
            o[db] = MFMA32(vf, pf, o[db]);
        } }
}
__device__ __forceinline__ float xhalf_max(float v) { return fmaxf(v, __shfl_xor(v, 32)); }
__device__ __forceinline__ float xhalf_sum(float v) { return v + __shfl_xor(v, 32); }

__device__ __forceinline__ float store_ot(bf16* dst, const f32x16 (&o)[2], float sc, int h) {
    float s = 0.f;
#pragma unroll
    for (int db = 0; db < 2; ++db)
#pragma unroll
        for (int gp = 0; gp < 2; ++gp) { u32x4 w; float v[8];
#pragma unroll
            for (int k = 0; k < 8; ++k) { v[k] = o[db][8 * gp + k] * sc; s += v[k] * v[k]; }
            w.x = cvtpk(v[0], v[1]); w.y = cvtpk(v[2], v[3]); w.z = cvtpk(v[4], v[5]); w.w = cvtpk(v[6], v[7]);
            *(u32x4*)(dst + 32 * h + 16 * db + 8 * gp) = w; }
    return s;
}
constexpr int STG_K = 0, STG_V = 49152, STG_BYTES = 98304;
template <int DIL>
__device__ __forceinline__ void stage_kv(const bf16* Kg, const bf16* Vg, LAS unsigned char* lds, size_t blk0_elem  ,
                                         int first_valid_bi, int wave, int lane) {
    constexpr unsigned RS = DIL * HD * 2;
    const int j = wave & 3, slot = 8 * j + (lane >> 3), x = lane & 7;
    const unsigned goK = (unsigned)pik(slot) * RS + (unsigned)((x ^ ((slot >> 1) & 7)) * 16);
    const unsigned goV = (unsigned)slot * RS + (unsigned)((x ^ (((slot >> 1) & 1) << 2)) * 16);
#pragma unroll
    for (int t = 0; t < 6; ++t) {
        const int bi = (wave >> 2) + 2 * t;
        if (bi >= first_valid_bi) {
            const char* kb_ = (const char*)(Kg + blk0_elem) + (size_t)bi * (32 * RS);
            const char* vb_ = (const char*)(Vg + blk0_elem) + (size_t)bi * (32 * RS);
            __builtin_amdgcn_global_load_lds((const unsigned*)(kb_ + goK), (LAS unsigned*)(lds + STG_K + bi * 4096 + j * 1024), 16, 0, 0);
            __builtin_amdgcn_global_load_lds((const unsigned*)(vb_ + goV), (LAS unsigned*)(lds + STG_V + bi * 4096 + j * 1024), 16, 0, 0);
        }
    }
}
struct FragOff { int kd[4]; int vo[2]; };
__device__ __forceinline__ FragOff frag_offsets(int lane) {
    FragOff f; const int r = lane & 31, h = lane >> 5, s = (r >> 1) & 7;
#pragma unroll
    for (int d0 = 0; d0 < 4; ++d0) f.kd[d0] = r * 128 + (((2 * d0 + h) ^ s) << 4);
    const int q = (lane & 15) >> 2, p = lane & 3, g1 = (lane >> 4) & 1, qs = q >> 1, cgp = 2 * g1 + (p >> 1);
#pragma unroll
    for (int db = 0; db < 2; ++db) f.vo[db] = (16 * h + q) * 128 + (p & 1) * 8 + ((4 * (db ^ qs) + cgp) << 4);
    return f;
}
__device__ __forceinline__ void pv_block_lds(f32x16 (&o)[2], const f32x16& p, const LAS unsigned char* vimg  , const FragOff& fo) {
#pragma unroll
    for (int s = 0; s < 2; ++s) { const bf16x8 pf = pack8(p, s);
#pragma unroll
        for (int db = 0; db < 2; ++db) {
            const v4i16_t lo = __builtin_amdgcn_ds_read_tr16_b64_v4i16((LAS v4i16_t*)(vimg + fo.vo[db] + s * 1024));
            const v4i16_t hi = __builtin_amdgcn_ds_read_tr16_b64_v4i16((LAS v4i16_t*)(vimg + fo.vo[db] + s * 1024 + 512));
            const bf16x8 vf = (bf16x8){lo[0], lo[1], lo[2], lo[3], hi[0], hi[1], hi[2], hi[3]};
            o[db] = MFMA32(vf, pf, o[db]);
        } }
}
__device__ __forceinline__ void pv_block_lds_pk(f32x16 (&o)[2], const u32x4 (&pk)[2], const LAS unsigned char* vimg, const FragOff& fo) {
#pragma unroll
    for (int s = 0; s < 2; ++s) { const bf16x8 pf = __builtin_bit_cast(bf16x8, pk[s]);
#pragma unroll
        for (int db = 0; db < 2; ++db) {
            const v4i16_t lo = __builtin_amdgcn_ds_read_tr16_b64_v4i16((LAS v4i16_t*)(vimg + fo.vo[db] + s * 1024));
            const v4i16_t hi = __builtin_amdgcn_ds_read_tr16_b64_v4i16((LAS v4i16_t*)(vimg + fo.vo[db] + s * 1024 + 512));
            const bf16x8 vf = (bf16x8){lo[0], lo[1], lo[2], lo[3], hi[0], hi[1], hi[2], hi[3]};
            o[db] = MFMA32(vf, pf, o[db]);
        } }
}
template <int DIL>
__device__ __forceinline__ void dil_wave_lds(const bf16x8 (&qf)[4], const LAS unsigned char* lds, const FragOff& fo, int lane, int wave, int head, int nblk, f32x16 (&o)[2], float& m_out, float& l_out) {
    const int r = lane & 31, h = lane >> 5;
    const float slope2d = exp2f(-(float)(head + 1)) * LOG2E * (float)DIL;
#pragma unroll
    for (int db = 0; db < 2; ++db)
#pragma unroll
        for (int ii = 0; ii < 16; ++ii) o[db][ii] = 0.f;
    float m = -INFINITY, l = 0.f;
    for (int it = 0; it < nblk; ++it) {
        const int bi = wave + 4 - it;
        const LAS unsigned char* kimg = lds + STG_K + bi * 4096;
        f32x16 acc;
#pragma unroll
        for (int ii = 0; ii < 16; ++ii) acc[ii] = 0.f;
#pragma unroll
        for (int d0 = 0; d0 < 4; ++d0) { const bf16x8 kf = *(const LAS bf16x8*)(kimg + fo.kd[d0]); acc = MFMA32(kf, qf[d0], acc); }
        const int dbase = 32 * it + r - 16 * h;
        float bm = -INFINITY;
#pragma unroll
        for (int ii = 0; ii < 16; ++ii) { const int dist = dbase - ii; const bool valid = (dist >= 0) && (dist <= 128);
            acc[ii] = valid ? (acc[ii] - slope2d * (float)dist) : -INFINITY; bm = fmaxf(bm, acc[ii]); }
        if (__any(bm > m + 8.0f)) {
            const float mn = xhalf_max(fmaxf(bm, m)); const float f = __builtin_amdgcn_exp2f(m - mn);
            l *= f;
#pragma unroll
            for (int db = 0; db < 2; ++db)
#pragma unroll
                for (int ii = 0; ii < 16; ++ii) o[db][ii] *= f;
            m = mn;
        }
#pragma unroll
        for (int ii = 0; ii < 16; ++ii) { acc[ii] = __builtin_amdgcn_exp2f(acc[ii] - m); l += acc[ii]; }
        pv_block_lds(o, acc, lds + STG_V + bi * 4096, fo);
    }
    m_out = m; l_out = xhalf_sum(l);
}
struct MixPre { u32x4 p1[4], p2[4]; f32x4 ml; };
template <int DIL>
__device__ __forceinline__ void dil_unit_wg(Frame& F, const bf16* QD, const bf16* KD, const bf16* VD, const FragOff& fo, int b, int head, int cls, int g, f32x16 (&o)[2], float& m_, float& l_,
                                            const bf16* P1 = nullptr, const bf16* P2 = nullptr, const float* ML1 = nullptr, const float* ML2 = nullptr, MixPre* pre = nullptr) {
    const int lane = F.lane, r = lane & 31, h = lane >> 5, wave = F.wave;
    const int I0 = 256 * g;
    const ptrdiff_t blk0 = hm_off(b, head, ((ptrdiff_t)I0 - 128) * DIL + cls);
    asm volatile("s_waitcnt lgkmcnt(0)\n\ts_barrier" ::: "memory");
    stage_kv<DIL>(KD, VD, F.lds, (size_t)blk0, (g == 0) ? 4 : 0, wave, lane);
    bf16x8 qf[4];
    { const bf16* qp = QD + hm_off(b, head, (ptrdiff_t)(I0 + 32 * wave + r) * DIL + cls) + 8 * h;
#pragma unroll
      for (int d0 = 0; d0 < 4; ++d0) qf[d0] = *(const bf16x8*)(qp + 16 * d0); }
    if (pre) { const ptrdiff_t tq = (ptrdiff_t)(I0 + 32 * wave + r) * DIL + cls; const size_t tok = (size_t)(((ptrdiff_t)b * NH + head) * SEQ + tq);
        const bf16* p1 = P1 + hm_off(b, head, tq) + 32 * h; const bf16* p2 = P2 + hm_off(b, head, tq) + 32 * h;
#pragma unroll
        for (int i = 0; i < 4; ++i) { pre->p1[i] = *(const u32x4*)(p1 + 8 * i); pre->p2[i] = *(const u32x4*)(p2 + 8 * i); }
        pre->ml.x = ML1[tok * 2]; pre->ml.y = ML1[tok * 2 + 1]; pre->ml.z = ML2[tok * 2]; pre->ml.w = ML2[tok * 2 + 1]; }
    asm volatile("s_waitcnt vmcnt(0)\n\ts_barrier" ::: "memory");
    const int i0 = I0 + 32 * wave; const int nblk = (i0 >= 128) ? 5 : (1 + (i0 >> 5));
    if (PROBE_PHASE == 34) { __syncthreads(); stage_kv<DIL>(KD, VD, F.lds, (size_t)blk0, (g == 0) ? 4 : 0, wave, lane); asm volatile("s_waitcnt vmcnt(0)" ::: "memory"); __syncthreads(); }
    if (PROBE_PHASE == 33) { dil_wave_lds<DIL>(qf, F.lds, fo, lane, wave, head, nblk, o, m_, l_); asm volatile("" : "+v"(m_), "+v"(l_)); }
    dil_wave_lds<DIL>(qf, F.lds, fo, lane, wave, head, nblk, o, m_, l_);
}
__device__ __forceinline__ void sb_unit_wg(Frame& F, const bf16* QS, const bf16* KS, const bf16* VS, const FragOff& fo, int b, int head, int g, bool dry) {
    const int lane = F.lane, r = lane & 31, h = lane >> 5, wave = F.wave;
    const int T0 = 256 * g, t0 = T0 + 32 * wave;
    const size_t rowbase = (size_t)b * SEQ;
    const ptrdiff_t blk0 = hm_off(b, head, (ptrdiff_t)T0 - 128);
    asm volatile("s_waitcnt lgkmcnt(0)\n\ts_barrier" ::: "memory");
    stage_kv<1>(KS, VS, F.lds, (size_t)blk0, (g == 0) ? 4 : 0, wave, lane);
    bf16x8 qf[4];
    { const bf16* qp = QS + hm_off(b, head, t0 + r) + 8 * h;
#pragma unroll
      for (int d0 = 0; d0 < 4; ++d0) qf[d0] = *(const bf16x8*)(qp + 16 * d0); }
    asm volatile("s_waitcnt vmcnt(0)\n\ts_barrier" ::: "memory");
    f32x16 o[2];
#pragma unroll
    for (int db = 0; db < 2; ++db)
#pragma unroll
        for (int ii = 0; ii < 16; ++ii) o[db][ii] = 0.f;
    float R = 1.0f; bool done = false;
    const int bi_lo = (g == 0) ? 4 : 0;
    for (int bi = wave + 4; bi >= bi_lo; --bi) {
        const LAS unsigned char* kimg = F.lds + STG_K + bi * 4096;
        f32x16 acc;
#pragma unroll
        for (int ii = 0; ii < 16; ++ii) acc[ii] = 0.f;
#pragma unroll
        for (int d0 = 0; d0 < 4; ++d0) { const bf16x8 kf = *(const LAS bf16x8*)(kimg + fo.kd[d0]); acc = MFMA32(kf, qf[d0], acc); }
        const bool diag = (bi == wave + 4);
        float cc[16]; float T = 1.0f;
#pragma unroll
        for (int ii = 0; ii < 16; ++ii) { float x = fminf(acc[ii], 100.0f); if (diag && (16 * h + ii >= r)) x = -INFINITY;
            const float e = __builtin_amdgcn_exp2f(x); const float c_ = __builtin_amdgcn_rcpf(1.0f + e); cc[ii] = c_; acc[ii] = e * c_; T *= c_; }
        const float Tp = __shfl_xor(T, 32);
        float E = h ? R : R * Tp;
#pragma unroll
        for (int ii = 15; ii >= 0; --ii) { acc[ii] = acc[ii] * E; E *= cc[ii]; }
        R = R * T * Tp;
        pv_block_lds(o, acc, F.lds + STG_V + bi * 4096, fo);
        if (__all(R < 7.8e-31f)) { done = true; break; }
    }
    if (!done && T0 - 128 - 32 >= 0) {
        LAS unsigned char* img = F.lds + STG_BYTES + wave * 5120;
        const bf16* Kl = KS + hm_off(b, head, pik(r)) + 8 * h;
        const bf16* Vl = VS + hm_off(b, head, lane >> 3) + 8 * (lane & 7);
        for (int kb = T0 - 160; kb >= 0; kb -= 32) {
            bf16x8 kf[4]; u32x4 vr[4];
            load_kf(kf, Kl + (size_t)kb * HD);
#pragma unroll
            for (int i = 0; i < 4; ++i) vr[i] = *(const u32x4*)(Vl + (size_t)(kb + 8 * i) * HD);
            f32x16 acc;
#pragma unroll
            for (int ii = 0; ii < 16; ++ii) acc[ii] = 0.f;
#pragma unroll
            for (int d0 = 0; d0 < 4; ++d0) acc = MFMA32(kf[d0], qf[d0], acc);
            float cc[16]; float T = 1.0f;
#pragma unroll
            for (int ii = 0; ii < 16; ++ii) { const float x = fminf(acc[ii], 100.0f);
                const float e = __builtin_amdgcn_exp2f(x); const float c_ = __builtin_amdgcn_rcpf(1.0f + e); cc[ii] = c_; acc[ii] = e * c_; T *= c_; }
            const float Tp = __shfl_xor(T, 32);
            float E = h ? R : R * Tp;
#pragma unroll
            for (int ii = 15; ii >= 0; --ii) { acc[ii] = acc[ii] * E; E *= cc[ii]; }
            R = R * T * Tp;
            pv_block(o, vr, acc, img, lane);
            if (__all(R < 7.8e-31f)) break;
        }
    }
    const size_t m = rowbase + t0 + r;
    float s = store_ot(F.OB + m * D + DH + head * HD, o, 1.0f, h);
    s = xhalf_sum(s);
    if (h == 0) F.ssq[m * 16 + 8 + head] = s;
}
struct DilUnit { int dil, b, head, cls, g; };
__device__ __forceinline__ bool dil_get_unit(int mode, int xc, int jx, int idx, DilUnit& u) {
    if (mode == 0) { if (idx >= 16) return false; const int bh = xc * 8 + (idx >> 1); u.b = bh >> 3; u.head = bh & 7;
        if ((idx & 1) == 0) { u.dil = 16; u.cls = jx >> 1; u.g = jx & 1; } else { u.dil = 4; u.cls = jx >> 3; u.g = jx & 7; } return true; }
    if (idx >= 8) return false; const int bh = xc * 8 + (7 - idx); u.b = bh >> 3; u.head = bh & 7; u.dil = 1; u.cls = 0; u.g = jx; return true;
}
__device__ __forceinline__ void glds16_asm(const void* gsrc, unsigned lds_dst) { unsigned keep;
    asm volatile("s_mov_b32 %0, m0\n\ts_mov_b32 m0, %2\n\ts_nop 0\n\tglobal_load_lds_dwordx4 %1, off\n\ts_mov_b32 m0, %0" : "=&s"(keep) : "v"(gsrc), "s"(lds_dst) : "memory"); }
template <bool ISK>
__device__ __forceinline__ void stage_half_any(const bf16* Xg, LAS unsigned char* region, const DilUnit& u, int wave, int lane_) {
    int lane = lane_; asm volatile("" : "+v"(lane));
    const unsigned RS = (unsigned)u.dil * (HD * 2);
    const int j = wave & 3, slot = 8 * j + (lane >> 3), x = lane & 7;
    const unsigned go = ISK ? ((unsigned)pik(slot) * RS + (unsigned)((x ^ ((slot >> 1) & 7)) * 16)) : ((unsigned)slot * RS + (unsigned)((x ^ (((slot >> 1) & 1) << 2)) * 16));
    const ptrdiff_t blk0 = hm_off(u.b, u.head, ((ptrdiff_t)256 * u.g - 128) * u.dil + u.cls);
    const int fv = (u.g == 0) ? 4 : 0;
    const char* base = (const char*)(Xg + blk0);
#pragma unroll
    for (int t = 0; t < 6; ++t) {
        const int bi = (wave >> 2) + 2 * t, bs = bi < fv ? fv : bi;
        const char* p = base + (ptrdiff_t)bs * (ptrdiff_t)(32u * RS);
        glds16_asm(p + go, (unsigned)__builtin_amdgcn_readfirstlane((int)(unsigned)(size_t)(region + bi * 4096 + j * 1024)));
    }
}
__device__ __forceinline__ void dil_pipeline(Frame& F, int mode, bool dry) {
    const bf16* QD = F.QKV; const bf16* KD = F.QKV + (size_t)M * DH; const bf16* VD = F.QKV + (size_t)2 * M * DH;
    bf16* P1 = (bf16*)(F.ws + WS_PART); bf16* P2 = P1 + (size_t)M * DH;
    float* ML1 = (float*)(F.ws + WS_PART + (size_t)2 * M * DH * 2); float* ML2 = ML1 + (size_t)2 * M * NH;
    const int lane = F.lane, r = lane & 31, h = lane >> 5, wave = F.wave;
    const FragOff fo = frag_offsets(lane);
    const int xc = F.vcu >> 5, jx = F.vcu & 31;
    constexpr int REG = 49152;
    DilUnit cur, nxt, prv; cur.dil = 1; cur.b = cur.head = cur.cls = cur.g = 0; nxt = cur; prv = cur;
    (void)dil_get_unit(mode, xc, jx, 0, cur);
    asm volatile("s_waitcnt vmcnt(0) lgkmcnt(0)\n\ts_barrier" ::: "memory");
    bf16x8 qf[4];
    stage_half_any<true>(KD, F.lds, cur, wave, lane);
    { const bf16* qp = QD + hm_off(cur.b, cur.head, (ptrdiff_t)(256 * cur.g + 32 * wave + r) * cur.dil + cur.cls) + 8 * h;
#pragma unroll
      for (int d0 = 0; d0 < 4; ++d0) qf[d0] = *(const bf16x8*)(qp + 16 * d0); }
    stage_half_any<false>(VD, F.lds + REG, cur, wave, lane);
    f32x16 o[2]; float m_prev = 0.f, l_prev = 1.f; bool have_prev = false;
#pragma unroll
    for (int db = 0; db < 2; ++db)
#pragma unroll
        for (int ii = 0; ii < 16; ++ii) o[db][ii] = 0.f;
    const int nunits = mode ? 8 : 16;
    int rk = 0;
    for (int u = 0; u < nunits; ++u) {
        const bool has_next = dil_get_unit(mode, xc, jx, u + 1, nxt);
        if (has_next || u == 0) asm volatile("s_waitcnt vmcnt(6)" ::: "memory"); else asm volatile("s_waitcnt vmcnt(0)" ::: "memory");
        asm volatile("s_waitcnt lgkmcnt(0)\n\ts_barrier" ::: "memory");
        asm volatile("" :: "v"(qf[0]), "v"(qf[1]), "v"(qf[2]), "v"(qf[3]));
        if (have_prev) {
            const ptrdiff_t tq = (ptrdiff_t)(256 * prv.g + 32 * wave + r) * prv.dil + prv.cls; const size_t tok = (size_t)prv.b * SEQ + (size_t)tq; const size_t hrow = (size_t)(((ptrdiff_t)prv.b * NH + prv.head) * SEQ + tq);
            if (mode == 0) { bf16* P = (prv.dil == 16) ? P1 : P2; float* ML = (prv.dil == 16) ? ML1 : ML2;
                (void)store_ot(P + hrow * HD, o, 1.0f / l_prev, h);
                if (h == 0) { ML[hrow * 2] = m_prev; ML[hrow * 2 + 1] = l_prev; }
            } else { float s = store_ot(F.OB + tok * D + prv.head * HD, o, 1.0f, h); s = xhalf_sum(s); if (h == 0) F.ssq[tok * 16 + prv.head] = s; }
        }
        const int r2 = (rk + 2 >= 3) ? rk - 1 : rk + 2;
        if (has_next) stage_half_any<true>(KD, F.lds + r2 * REG, nxt, wave, lane);
        const int i0 = 256 * cur.g + 32 * wave; const int nblk = (i0 >= 128) ? 5 : (1 + (i0 >> 5));
        const float slope2d = exp2f(-(float)(cur.head + 1)) * LOG2E * (float)cur.dil;
        const LAS unsigned char* kreg = F.lds + rk * REG;
        u32x4 pk[5][2]; float mref[5]; float mrun = -INFINITY, l = 0.f;
        typedef float f32x2 __attribute__((ext_vector_type(2)));
        f32x2 sl2[8];
#pragma unroll
        for (int k = 0; k < 8; ++k) sl2[k] = (f32x2){slope2d * (float)(2 * k), slope2d * (float)(2 * k + 1)};
#pragma unroll
        for (int it = 0; it < 5; ++it) {
            if (it < nblk) {
                const LAS unsigned char* kimg = kreg + (wave + 4 - it) * 4096;
                const int dbase = 32 * it + r - 16 * h;
                const float c0 = (it == 0) ? (-slope2d * (float)dbase) : (-slope2d * (float)dbase - mrun);
                f32x16 acc;
#pragma unroll
                for (int k = 0; k < 8; ++k) { const f32x2 ci = sl2[k] + (f32x2){c0, c0}; acc[2 * k] = ci.x; acc[2 * k + 1] = ci.y; }
#pragma unroll
                for (int d0 = 0; d0 < 4; ++d0) { const bf16x8 kf = *(const LAS bf16x8*)(kimg + fo.kd[d0]); acc = MFMA32(kf, qf[d0], acc); }
                float bm = -INFINITY;
#pragma unroll
                for (int ii = 0; ii < 16; ++ii) { if (it == 0) { if (ii > dbase) acc[ii] = -INFINITY; } else if (it == 4) { if (ii < dbase - 128) acc[ii] = -INFINITY; }
                    bm = fmaxf(bm, acc[ii]); }
                { auto rr = __builtin_amdgcn_permlane32_swap(__float_as_uint(bm), __float_as_uint(bm), false, false); bm = fmaxf(__uint_as_float(rr[0]), __uint_as_float(rr[1])); }
                if (it == 0) {
                    mrun = bm;
#pragma unroll
                    for (int k = 0; k < 8; ++k) { const f32x2 v = (f32x2){acc[2 * k], acc[2 * k + 1]} - (f32x2){bm, bm}; acc[2 * k] = v.x; acc[2 * k + 1] = v.y; }
                } else if (__any(bm > 8.0f)) {
                    const float dlt = fmaxf(bm, 0.f);
#pragma unroll
                    for (int k = 0; k < 8; ++k) { const f32x2 v = (f32x2){acc[2 * k], acc[2 * k + 1]} - (f32x2){dlt, dlt}; acc[2 * k] = v.x; acc[2 * k + 1] = v.y; }
                    mrun += dlt; l *= __builtin_amdgcn_exp2f(-dlt);
                }
                mref[it] = mrun;
                f32x2 ls2 = {0.f, 0.f};
#pragma unroll
                for (int k = 0; k < 8; ++k) { acc[2 * k] = __builtin_amdgcn_exp2f(acc[2 * k]); acc[2 * k + 1] = __builtin_amdgcn_exp2f(acc[2 * k + 1]); ls2 += (f32x2){acc[2 * k], acc[2 * k + 1]}; }
                l += ls2.x + ls2.y;
#pragma unroll
                for (int s = 0; s < 2; ++s) { pk[it][s].x = cvtpk(acc[8 * s + 0], acc[8 * s + 1]); pk[it][s].y = cvtpk(acc[8 * s + 2], acc[8 * s + 3]);
                    pk[it][s].z = cvtpk(acc[8 * s + 4], acc[8 * s + 5]); pk[it][s].w = cvtpk(acc[8 * s + 6], acc[8 * s + 7]); }
            } else { mref[it] = mrun; pk[it][0] = (u32x4){0u, 0u, 0u, 0u}; pk[it][1] = (u32x4){0u, 0u, 0u, 0u}; }
        }
        const float m = mrun;
        l = xhalf_sum(l);
        if (has_next) asm volatile("s_waitcnt vmcnt(6)" ::: "memory"); else asm volatile("s_waitcnt vmcnt(0)" ::: "memory");
        asm volatile("s_waitcnt lgkmcnt(0)\n\ts_barrier" ::: "memory");
        if (has_next) stage_half_any<false>(VD, F.lds + rk * REG, nxt, wave, lane);
        MixPre pre;
        if (mode == 1) { const size_t tok = (size_t)(((ptrdiff_t)cur.b * NH + cur.head) * SEQ + (ptrdiff_t)(256 * cur.g + 32 * wave + r) * cur.dil + cur.cls);
            const bf16* p1 = P1 + tok * HD + 32 * h; const bf16* p2 = P2 + tok * HD + 32 * h;
#pragma unroll
            for (int i = 0; i < 4; ++i) { pre.p1[i] = *(const u32x4*)(p1 + 8 * i); pre.p2[i] = *(const u32x4*)(p2 + 8 * i); }
            pre.ml.x = ML1[tok * 2]; pre.ml.y = ML1[tok * 2 + 1]; pre.ml.z = ML2[tok * 2]; pre.ml.w = ML2[tok * 2 + 1]; }
        if (has_next) { const bf16* qp = QD + hm_off(nxt.b, nxt.head, (ptrdiff_t)(256 * nxt.g + 32 * wave + r) * nxt.dil + nxt.cls) + 8 * h;
#pragma unroll
            for (int d0 = 0; d0 < 4; ++d0) qf[d0] = *(const bf16x8*)(qp + 16 * d0); }
        const int rv = (rk + 1 >= 3) ? 0 : rk + 1;
        const LAS unsigned char* vreg = F.lds + rv * REG;
#pragma unroll
        for (int db = 0; db < 2; ++db)
#pragma unroll
            for (int ii = 0; ii < 16; ++ii) o[db][ii] = 0.f;
#pragma unroll
        for (int it = 0; it < 5; ++it) {
            if (it < nblk) {
                if (it > 0) { const float f = __builtin_amdgcn_exp2f(mref[it - 1] - mref[it]);
                    if (__any(f != 1.0f)) {
#pragma unroll
                        for (int db = 0; db < 2; ++db)
#pragma unroll
                            for (int ii = 0; ii < 16; ++ii) o[db][ii] *= f; } }
                pv_block_lds_pk(o, pk[it], vreg + (wave + 4 - it) * 4096, fo);
            }
        }
        if (mode == 1) {
            const float m1 = pre.ml.x, l1 = pre.ml.y, m2 = pre.ml.z, l2 = pre.ml.w;
            const float mm = fmaxf(fmaxf(m1, m2), m);
            const float w1 = l1 * exp2f(m1 - mm), w2 = l2 * exp2f(m2 - mm), e3 = exp2f(m - mm);
            const float inv = 1.0f / (w1 + w2 + l * e3);
            const float a1 = w1 * inv, a2 = w2 * inv, a3 = e3 * inv;
#pragma unroll
            for (int db = 0; db < 2; ++db)
#pragma unroll
                for (int gp = 0; gp < 2; ++gp) { const u32x4 w1_ = pre.p1[2 * db + gp], w2_ = pre.p2[2 * db + gp];
#pragma unroll
                    for (int k = 0; k < 4; ++k) { const unsigned a_ = w1_[k], b_ = w2_[k];
                        o[db][8 * gp + 2 * k] = a3 * o[db][8 * gp + 2 * k] + a1 * __uint_as_float(a_ << 16) + a2 * __uint_as_float(b_ << 16);
                        o[db][8 * gp + 2 * k + 1] = a3 * o[db][8 * gp + 2 * k + 1] + a1 * __uint_as_float(a_ & 0xffff0000u) + a2 * __uint_as_float(b_ & 0xffff0000u); } }
        }
        m_prev = m; l_prev = l; prv = cur; cur = nxt; have_prev = true;
        rk = r2;
    }
    { const ptrdiff_t tq = (ptrdiff_t)(256 * prv.g + 32 * wave + r) * prv.dil + prv.cls; const size_t tok = (size_t)prv.b * SEQ + (size_t)tq; const size_t hrow = (size_t)(((ptrdiff_t)prv.b * NH + prv.head) * SEQ + tq);
      if (mode == 0) { bf16* P = (prv.dil == 16) ? P1 : P2; float* ML = (prv.dil == 16) ? ML1 : ML2;
          (void)store_ot(P + hrow * HD, o, 1.0f / l_prev, h);
          if (h == 0) { ML[hrow * 2] = m_prev; ML[hrow * 2 + 1] = l_prev; }
      } else { float s = store_ot(F.OB + tok * D + prv.head * HD, o, 1.0f, h); s = xhalf_sum(s); if (h == 0) F.ssq[tok * 16 + prv.head] = s; } }
    asm volatile("s_waitcnt lgkmcnt(0)\n\ts_barrier" ::: "memory");
}
__device__ __forceinline__ void phase_attn_a(Frame& F, bool dry, bool skip_sb = false) {
    const bf16* QD = F.QKV; const bf16* KD = F.QKV + (size_t)M * DH; const bf16* VD = F.QKV + (size_t)2 * M * DH;
    const bf16* QS = F.QKV + (size_t)3 * M * DH; const bf16* KS = F.QKV + (size_t)4 * M * DH; const bf16* VS = F.QKV + (size_t)5 * M * DH;
    bf16* P1 = (bf16*)(F.ws + WS_PART); bf16* P2 = P1 + (size_t)M * DH;
    float* ML1 = (float*)(F.ws + WS_PART + (size_t)2 * M * DH * 2); float* ML2 = ML1 + (size_t)2 * M * NH;
    const int lane = F.lane, r = lane & 31, h = lane >> 5;
    const FragOff fo = frag_offsets(lane);
    const int nx = (F.G % 32 == 0) ? F.G / 32 : 1, wpx = F.G / nx, xc = F.vcu / wpx, jx = F.vcu % wpx;
    const int bh_per_x = 64 / ((nx <= 64 && 64 % nx == 0) ? nx : 1), nxe = 64 / bh_per_x;
    const bool piped = (DIL_PIPE != 0) && (F.G == 256);
    for (int k = 0; xc < nxe && k < bh_per_x * 3; ++k) {
      if (piped && (k % 3) != 2) continue;
      for (int rem = (k % 3) * 32 + jx; rem < (k % 3) * 32 + 32; rem += wpx) {
        const int bh = xc * bh_per_x + k / 3, b = bh >> 3, head = bh & 7;
        if (rem < 32) {
            f32x16 o[2]; float m_, l_;
            const int cls3 = rem >> 1, g3 = rem & 1;
            dil_unit_wg<16>(F, QD, KD, VD, fo, b, head, cls3, g3, o, m_, l_);
            const size_t tok = (size_t)(((ptrdiff_t)b * NH + head) * SEQ + (ptrdiff_t)(256 * g3 + 32 * F.wave + r) * 16 + cls3);
            (void)store_ot(P1 + tok * HD, o, 1.0f / l_, h);
            if (h == 0) { ML1[tok * 2] = m_; ML1[tok * 2 + 1] = l_; }
        } else if (rem < 64) {
            const int cls = (rem - 32) >> 3, g = (rem - 32) & 7;
            f32x16 o[2]; float m_, l_;
            dil_unit_wg<4>(F, QD, KD, VD, fo, b, head, cls, g, o, m_, l_);
            const size_t tok = (size_t)(((ptrdiff_t)b * NH + head) * SEQ + (ptrdiff_t)(256 * g + 32 * F.wave + r) * 4 + cls);
            (void)store_ot(P2 + tok * HD, o, 1.0f / l_, h);
            if (h == 0) { ML2[tok * 2] = m_; ML2[tok * 2 + 1] = l_; }
        } else if (!skip_sb) {
            if (PROBE_PHASE == 35) sb_unit_wg(F, QS, KS, VS, fo, b, head, rem - 64, true);
            sb_unit_wg(F, QS, KS, VS, fo, b, head, rem - 64, dry);
        }
      }
    }
    __syncthreads();
    if (piped) dil_pipeline(F, 0, dry);
}
__device__ __forceinline__ void phase_attn_b(Frame& F, bool dry) {
    const bf16* QD = F.QKV; const bf16* KD = F.QKV + (size_t)M * DH; const bf16* VD = F.QKV + (size_t)2 * M * DH;
    const bf16* P1 = (const bf16*)(F.ws + WS_PART); const bf16* P2 = P1 + (size_t)M * DH;
    const float* ML1 = (const float*)(F.ws + WS_PART + (size_t)2 * M * DH * 2); const float* ML2 = ML1 + (size_t)2 * M * NH;
    const int lane = F.lane, r = lane & 31, h = lane >> 5;
    const FragOff fo = frag_offsets(lane);
    const int nx = (F.G % 32 == 0) ? F.G / 32 : 1, wpx = F.G / nx, xc = F.vcu / wpx, jx = F.vcu % wpx;
    const int bh_per_x = 64 / ((nx <= 64 && 64 % nx == 0) ? nx : 1), nxe = 64 / bh_per_x;
    if ((DIL_PIPE != 0) && (F.G == 256)) { dil_pipeline(F, 1, dry); return; }
    for (int k = 0; xc < nxe && k < bh_per_x; ++k) {
      for (int rem = jx; rem < 32; rem += wpx) {
        const int bh = xc * bh_per_x + k, b = bh >> 3, head = bh & 7;
        f32x16 o[2]; float m3, l3;
        MixPre pre;
        dil_unit_wg<1>(F, QD, KD, VD, fo, b, head, 0, rem, o, m3, l3, P1, P2, ML1, ML2, &pre);
        const size_t tok = (size_t)b * SEQ + (size_t)(256 * rem + 32 * F.wave + r);
        const float m1 = pre.ml.x, l1 = pre.ml.y, m2 = pre.ml.z, l2 = pre.ml.w;
        const float mm = fmaxf(fmaxf(m1, m2), m3);
        const float w1 = l1 * exp2f(m1 - mm), w2 = l2 * exp2f(m2 - mm), e3 = exp2f(m3 - mm);
        const float inv = 1.0f / (w1 + w2 + l3 * e3);
        const float a1 = w1 * inv, a2 = w2 * inv, a3 = e3 * inv;
#pragma unroll
        for (int db = 0; db < 2; ++db)
#pragma unroll
            for (int gp = 0; gp < 2; ++gp) { const u32x4 w1_ = pre.p1[2 * db + gp], w2_ = pre.p2[2 * db + gp];
#pragma unroll
                for (int k = 0; k < 4; ++k) { const unsigned a_ = w1_[k], b_ = w2_[k];
                    o[db][8 * gp + 2 * k] = a3 * o[db][8 * gp + 2 * k] + a1 * __uint_as_float(a_ << 16) + a2 * __uint_as_float(b_ << 16);
                    o[db][8 * gp + 2 * k + 1] = a3 * o[db][8 * gp + 2 * k + 1] + a1 * __uint_as_float(a_ & 0xffff0000u) + a2 * __uint_as_float(b_ & 0xffff0000u); } }
        float s = store_ot(F.OB + tok * D + head * HD, o, 1.0f, h);
        s = xhalf_sum(s);
        if (h == 0) F.ssq[tok * 16 + head] = s;
      }
    }
    __syncthreads();
}

__device__ __forceinline__ void phase_outproj_simple(Frame& F) {
    const int r = F.lane & 31, h = F.lane >> 5, wm = F.wave >> 1, wn = F.wave & 1;
    constexpr int NPN = D / 128;
    bf16* x1 = (bf16*)F.out;
    for (int u = F.vcu; u < (M / 256) * NPN; u += F.G) {
        const int pm = u / NPN, pn = u % NPN, m0 = pm * 256 + wm * 64, n0 = pn * 128 + wn * 64;
        const bf16* pa[2] = {F.OB + (size_t)(m0 + r) * D + 8 * h, F.OB + (size_t)(m0 + 32 + r) * D + 8 * h};
        const bf16* pb[2] = {F.WoutT + (size_t)(n0 + r) * D + 8 * h, F.WoutT + (size_t)(n0 + 32 + r) * D + 8 * h};
        float rsd[2], rss[2];
#pragma unroll
        for (int mi = 0; mi < 2; ++mi) { const int m = m0 + 32 * mi + r; float sd = 0.f, ss = 0.f; for (int q = 0; q < 8; ++q) { sd += F.ssq[(size_t)m * 16 + q]; ss += F.ssq[(size_t)m * 16 + 8 + q]; } rsd[mi] = 1.0f / sqrtf(sd * (1.f / DH) + NORM_EPS); rss[mi] = 1.0f / sqrtf(ss * (1.f / DH) + NORM_EPS); }
        f32x16 acc[2][2]; sg_zero<2>(acc);
        sg_mainloop<2>(acc, pa, pb, 0, DH);
#pragma unroll
        for (int ni = 0; ni < 2; ++ni)
#pragma unroll
            for (int mi = 0; mi < 2; ++mi) acc[ni][mi] = acc[ni][mi] * (rsd[mi] / rss[mi]);
        sg_mainloop<2>(acc, pa, pb, DH, D);
        const int b = m0 / SEQ;
#pragma unroll
        for (int ni = 0; ni < 2; ++ni)
#pragma unroll
            for (int mi = 0; mi < 2; ++mi)
#pragma unroll
                for (int g = 0; g < 4; ++g) {
                    const int n = n0 + 32 * ni + 8 * g + 4 * h; const int m = m0 + 32 * mi + r;
                    const f32x4 gate = *(const f32x4*)(F.mod + b * 6144 + 2048 + n), xv = *(const f32x4*)(F.x + (size_t)m * D + n);
                    f32x4 a; a.x = acc[ni][mi][4 * g]; a.y = acc[ni][mi][4 * g + 1]; a.z = acc[ni][mi][4 * g + 2]; a.w = acc[ni][mi][4 * g + 3];
                    const f32x4 rv = xv + gate * (a * rss[mi]); u32x2 w; w.x = pk2(rv.x, rv.y); w.y = pk2(rv.z, rv.w);
                    *(u32x2*)(x1 + (size_t)m * (2 * D) + n) = w;
                }
    }
}

__device__ __forceinline__ void phase_router(Frame& F, bool dry, bool panels = false) {
    LAS float* WR = (LAS float*)F.lds;
    {
        f32x4 we[16], wg[2];
#pragma unroll
        for (int u = 0; u < 16; ++u) we[u] = ((const f32x4*)F.w_expert)[F.tid + u * NTHREADS];
#pragma unroll
        for (int u = 0; u < 2; ++u) wg[u] = ((const f32x4*)F.w_group)[F.tid + u * NTHREADS];
#pragma unroll
        for (int u = 0; u < 16; ++u) { const int i = F.tid + u * NTHREADS, k = i >> 3, c4 = i & 7; const int slot = ((k >> 8) * 4 + (k & 3)) * 64 + ((k >> 2) & 63);
            *(LAS f32x4*)(WR + slot * 36 + 4 + 4 * c4) = we[u]; }
#pragma unroll
        for (int u = 0; u < 2; ++u) { const int k = F.tid + u * NTHREADS; const int slot = ((k >> 8) * 4 + (k & 3)) * 64 + ((k >> 2) & 63);
            *(LAS f32x4*)(WR + slot * 36) = wg[u]; }
    }
    __syncthreads();
    const int gw = panels ? ((int)blockIdx.x * NWAVES + F.wave) : (F.vcu * NWAVES + F.wave), NGW = F.G * NWAVES;
    const bf16* x1 = (const bf16*)F.out;
    f32x4 wgr[16];
#pragma unroll
    for (int q = 0; q < 16; ++q) wgr[q] = *(const LAS f32x4*)(WR + (q * 64 + F.lane) * 36);
    for (int ch0 = 0; ch0 < M / 32; ch0 += NGW) {
        const int ch = ch0 + gw; const bool have = ch < M / 32;
        const int b = have ? ch / (SEQ / 32) : 0;
        f32x4 gs[4], sh[4];
#pragma unroll
        for (int j = 0; j < 4; ++j) { const int col = 4 * F.lane + 256 * j;
            const f32x4 g = *(const f32x4*)(F.g_ffn + col), scl = *(const f32x4*)(F.mod + b * 6144 + 4096 + col); sh[j] = *(const f32x4*)(F.mod + b * 6144 + 3072 + col);
            gs[j] = g * (scl + 1.0f); }
        int my_e1 = 0, my_e2 = 0; float my_w1 = 0.f, my_w2 = 0.f;
        u32x2 vn[4];
        if (have) { const u32x2* xr = (const u32x2*)(x1 + (size_t)ch * 32 * (2 * D)) + F.lane;
#pragma unroll
            for (int j = 0; j < 4; ++j) vn[j] = xr[64 * j]; }
        __builtin_amdgcn_s_waitcnt(0x0F70);
        for (int rr = 0; have && rr < 32; ++rr) {
            const size_t m = (size_t)ch * 32 + rr;
            f32x4 v[4]; float s = 0.f;
#pragma unroll
            for (int j = 0; j < 4; ++j) { v[j].x = __uint_as_float(vn[j].x << 16); v[j].y = __uint_as_float(vn[j].x & 0xffff0000u); v[j].z = __uint_as_float(vn[j].y << 16); v[j].w = __uint_as_float(vn[j].y & 0xffff0000u); }
            if (rr < 31) { const u32x2* xr = (const u32x2*)(x1 + (m + 1) * (2 * D)) + F.lane;
#pragma unroll
                for (int j = 0; j < 4; ++j) vn[j] = xr[64 * j]; }
#pragma unroll
            for (int j = 0; j < 4; ++j) s += (v[j].x * v[j].x + v[j].y * v[j].y) + (v[j].z * v[j].z + v[j].w * v[j].w);
            const float rs = 1.0f / sqrtf(wave_sum(s) * (1.f / D) + NORM_EPS);
            unsigned long long* o8 = (unsigned long long*)(F.HB + m * D) + F.lane;
            typedef float f32x2 __attribute__((ext_vector_type(2)));
            f32x2 g01 = {0.f, 0.f}, g23 = {0.f, 0.f};
#pragma unroll
            for (int j = 0; j < 4; ++j) { v[j] = v[j] * rs * gs[j] + sh[j];
                o8[64 * j] = (unsigned long long)pk2(v[j].x, v[j].y) | ((unsigned long long)pk2(v[j].z, v[j].w) << 32);
#pragma unroll
                for (int i = 0; i < 4; ++i) { const f32x4 w = wgr[j * 4 + i]; const f32x2 hv = {v[j][i], v[j][i]};
                    g01 += hv * (f32x2){w.x, w.y}; g23 += hv * (f32x2){w.z, w.w}; } }
            float gl[4] = {g01.x, g01.y, g23.x, g23.y};
            wave_sum4(gl);
            int grp = 0; float gmax = gl[0];
#pragma unroll
            for (int i = 1; i < 4; ++i) if (gl[i] > gmax) { gmax = gl[i]; grp = i; }
            float gden = 0.f;
#pragma unroll
            for (int i = 0; i < 4; ++i) gden += __expf(gl[i] - gmax);
            const float ggate = 1.0f / gden;
            grp = __builtin_amdgcn_readfirstlane(grp);
            f32x2 e01 = {0.f, 0.f}, e23 = {0.f, 0.f}, e45 = {0.f, 0.f}, e67 = {0.f, 0.f};
#pragma unroll
            for (int j = 0; j < 4; ++j)
#pragma unroll
                for (int i = 0; i < 4; ++i) { const LAS float* wp = WR + ((j * 4 + i) * 64 + F.lane) * 36 + 4 + grp * 8; const f32x4 w0 = *(const LAS f32x4*)wp, w1 = *(const LAS f32x4*)(wp + 4); const f32x2 hv = {v[j][i], v[j][i]};
                    e01 += hv * (f32x2){w0.x, w0.y}; e23 += hv * (f32x2){w0.z, w0.w}; e45 += hv * (f32x2){w1.x, w1.y}; e67 += hv * (f32x2){w1.z, w1.w}; }
            float el[8] = {e01.x, e01.y, e23.x, e23.y, e45.x, e45.y, e67.x, e67.y};
            wave_sum8(el);
            int i1 = 0; float l1 = el[0];
#pragma unroll
            for (int i = 1; i < 8; ++i) if (el[i] > l1) { l1 = el[i]; i1 = i; }
            int i2 = -1; float l2 = -INFINITY;
#pragma unroll
            for (int i = 0; i < 8; ++i) if (i != i1 && el[i] > l2) { l2 = el[i]; i2 = i; }
            if (i2 < 0) i2 = (i1 + 1) & 7;
            const float p2 = 1.0f / (1.0f + __expf(l1 - l2)), p1 = 1.0f - p2;
            if (F.lane == rr) { my_e1 = grp * 8 + i1; my_e2 = grp * 8 + i2; my_w1 = ggate * p1; my_w2 = ggate * p2; }
        }
        if (!dry) {
            volatile LAS unsigned* lcnt = F.MISC + 64; volatile LAS unsigned* lbase = F.MISC + 96;
            if (F.tid < 32) lcnt[F.tid] = 0u;
            __syncthreads();
            int lp1 = 0, lp2 = 0;
            if (F.lane < 32 && have) { lp1 = (int)__hip_atomic_fetch_add((LAS unsigned*)(F.MISC + 64) + my_e1, 1u, __ATOMIC_RELAXED, __HIP_MEMORY_SCOPE_WORKGROUP); lp2 = (int)__hip_atomic_fetch_add((LAS unsigned*)(F.MISC + 64) + my_e2, 1u, __ATOMIC_RELAXED, __HIP_MEMORY_SCOPE_WORKGROUP); }
            __syncthreads();
            if (F.tid < 32) { const unsigned n = lcnt[F.tid]; lbase[F.tid] = n ? atomicAdd(F.cnt + 64 * F.tid, n) : 0u; }
            __syncthreads();
            if (F.lane < 32 && have) {
                const int m = ch * 32 + F.lane;
                const int pos1 = (int)lbase[my_e1] + lp1, pos2 = (int)lbase[my_e2] + lp2;
                F.list[(size_t)my_e1 * LIST_CAP + pos1] = m; F.list[(size_t)my_e2 * LIST_CAP + pos2] = m;
                i32x4 ts; ts.x = my_e1; ts.y = pos1; ts.z = my_e2; ts.w = pos2; F.tokslot[m] = ts;
                F.tokw[2 * m] = my_w1; F.tokw[2 * m + 1] = my_w2;
            }
            __syncthreads();
        }
    }
}

__device__ __forceinline__ void build_tiles(Frame& F) {
    __syncthreads();
    if (F.tid == 0) { unsigned acc = 0; for (int e = 0; e < NE; ++e) { F.MISC[e] = acc; acc += (__hip_atomic_load(F.cnt + 64 * e, __ATOMIC_RELAXED, __HIP_MEMORY_SCOPE_AGENT) + 255u) >> 8; } F.MISC[NE] = acc; }
    __syncthreads();
}
__device__ __forceinline__ int find_expert(Frame& F, int tile) { int e = 0;
#pragma unroll 1
    for (int i = 1; i < NE; ++i) if ((int)F.MISC[i] <= tile) e = i; else break;
    return e; }

__device__ __forceinline__ void phase_moe1_simple(Frame& F) {
    build_tiles(F);
    const int r = F.lane & 31, h = F.lane >> 5, wm = F.wave >> 1, wn = F.wave & 1;
    const int T = (int)F.MISC[NE];
    for (int u = F.vcu; u < T * 8; u += F.G) {
        const int tile = u >> 3, cn = u & 7, e = find_expert(F, tile), jt = tile - (int)F.MISC[e];
        const int cnt = (int)__hip_atomic_load(F.cnt + 64 * e, __ATOMIC_RELAXED, __HIP_MEMORY_SCOPE_AGENT);
        const bf16* pa[2];
#pragma unroll
        for (int mi = 0; mi < 2; ++mi) { const int pos = jt * 256 + wm * 64 + 32 * mi + r; const int tok = (pos < cnt) ? F.list[(size_t)e * LIST_CAP + pos] : 0; pa[mi] = F.HB + (size_t)tok * D + 8 * h; }
        const int j0 = cn * 64 + wn * 32, jj = j0 + r;
        const bf16* Wb = F.WguT + (size_t)e * D * D;
        const bf16* pb[2] = {Wb + (size_t)(8 * (jj >> 2) + (jj & 3)) * D + 8 * h, Wb + (size_t)(8 * (jj >> 2) + 4 + (jj & 3)) * D + 8 * h};
        f32x16 acc[2][2]; sg_zero<2>(acc);
        sg_mainloop<2>(acc, pa, pb, 0, D);
#pragma unroll
        for (int mi = 0; mi < 2; ++mi)
#pragma unroll
            for (int g = 0; g < 4; ++g) {
                const size_t row = (size_t)tile * 256 + wm * 64 + 32 * mi + r; const int col = j0 + 8 * g + 4 * h;
                float hv[4];
#pragma unroll
                for (int i = 0; i < 4; ++i) { const float ga = acc[0][mi][4 * g + i], up = acc[1][mi][4 * g + i]; hv[i] = ga / (1.0f + __expf(-ga)) * up; }
                u32x2 w; w.x = pk2(hv[0], hv[1]); w.y = pk2(hv[2], hv[3]);
                *(u32x2*)(F.HM + row * DFF + col) = w;
            }
    }
}
__device__ __forceinline__ void phase_moe2_simple(Frame& F) {
    build_tiles(F);
    const int r = F.lane & 31, h = F.lane >> 5, wm = F.wave >> 1, wn = F.wave & 1;
    const int T = (int)F.MISC[NE];
    for (int u = F.vcu; u < T * 8; u += F.G) {
        const int tile = u >> 3, pn = u & 7, e = find_expert(F, tile);
        const size_t row0 = (size_t)tile * 256 + wm * 64; const int n0 = pn * 128 + wn * 64;
        const bf16* pa[2] = {F.HM + (row0 + r) * DFF + 8 * h, F.HM + (row0 + 32 + r) * DFF + 8 * h};
        const bf16* Wb = F.WdT + (size_t)e * D * DFF;
        const bf16* pb[2] = {Wb + (size_t)(n0 + r) * DFF + 8 * h, Wb + (size_t)(n0 + 32 + r) * DFF + 8 * h};
        f32x16 acc[2][2]; sg_zero<2>(acc);
        sg_mainloop<2>(acc, pa, pb, 0, DFF);
#pragma unroll
        for (int ni = 0; ni < 2; ++ni)
#pragma unroll
            for (int mi = 0; mi < 2; ++mi)
#pragma unroll
                for (int g = 0; g < 4; ++g) {
                    const size_t row = row0 + 32 * mi + r; const int n = n0 + 32 * ni + 8 * g + 4 * h;
                    u32x2 w; w.x = pk2(acc[ni][mi][4 * g], acc[ni][mi][4 * g + 1]); w.y = pk2(acc[ni][mi][4 * g + 2], acc[ni][mi][4 * g + 3]);
                    *(u32x2*)(F.YB + row * D + n) = w;
                }
    }
}
__device__ __forceinline__ void phase_final(Frame& F, bool dry) {
    build_tiles(F);
    const int gw = F.vcu * NWAVES + F.wave, NGW = F.G * NWAVES;
    for (int ch = gw; ch < M / 32; ch += NGW) {
        const int b = ch / (SEQ / 32);
        f32x4 gate[4], gf[4];
#pragma unroll
        for (int j = 0; j < 4; ++j) { const int col = 4 * F.lane + 256 * j; gate[j] = *(const f32x4*)(F.mod + b * 6144 + 5120 + col); gf[j] = *(const f32x4*)(F.g_final + col); }
        for (int rr = 0; rr < 32; ++rr) {
            const size_t m = (size_t)ch * 32 + rr;
            const i32x4 ts = F.tokslot[m]; const float w1 = F.tokw[2 * m], w2 = F.tokw[2 * m + 1];
            const size_t ra = (size_t)F.MISC[ts.x] * 256 + ts.y, rb = (size_t)F.MISC[ts.z] * 256 + ts.w;
            f32x4* xr = (f32x4*)(F.out + m * D) + F.lane; const u32x2* xb = (const u32x2*)(F.out + m * D) + F.lane;
            f32x4 v[4]; float s = 0.f; u32x2 xw[4];
#pragma unroll
            for (int j = 0; j < 4; ++j) xw[j] = __builtin_nontemporal_load(&xb[64 * j]);
#pragma unroll
            for (int j = 0; j < 4; ++j) { const int col = 4 * F.lane + 256 * j;
                const f32x4 ya = ld_bf4(F.YB + ra * D + col), yb = ld_bf4(F.YB + rb * D + col);
                f32x4 xv; xv.x = __uint_as_float(xw[j].x << 16); xv.y = __uint_as_float(xw[j].x & 0xffff0000u); xv.z = __uint_as_float(xw[j].y << 16); xv.w = __uint_as_float(xw[j].y & 0xffff0000u);
                v[j] = xv + gate[j] * (ya * w1 + yb * w2);
                s += (v[j].x * v[j].x + v[j].y * v[j].y) + (v[j].z * v[j].z + v[j].w * v[j].w); }
            const float rs = 1.0f / sqrtf(wave_sum(s) * (1.f / D) + NORM_EPS);
            f32x4* wr_ = dry ? ((f32x4*)((float*)(F.ws + WS_H) + (m & 16383) * D) + F.lane) : xr;
#pragma unroll
            for (int j = 0; j < 4; ++j) __builtin_nontemporal_store(v[j] * rs * gf[j], &wr_[64 * j]);
        }
    }
}

__device__ __forceinline__ void phase_qkv_fast(Frame& F) {
    pg8::Gemm g{F.HB, F.WinT, D}; pg8::StaticOrder S; S.init(M, 3 * D, F.G, (int)blockIdx.x);
    pg8::EpiQKV E{F.QKV};
    pg8::gemm_phase<pg8::EpiQKV, pg8::StaticOrder, 0>(F.lds, g, S, E);
}
__device__ __forceinline__ void phase_outproj_fast(Frame& F) {
    pg8::StaticOrder S; S.init(M, D, F.G, (int)blockIdx.x);
    LAS float* side = (LAS float*)(F.lds + pg8::SIDE_OFF);
    pg8::Unit u;
    for (int i = 0; i < 8 && S.next(i, u); ++i) {
        if (F.tid < 256) { const int m = u.pm * 256 + F.tid; const f32x4 q0 = *(const f32x4*)(F.ssq + (size_t)m * 16), q1 = *(const f32x4*)(F.ssq + (size_t)m * 16 + 4), q2 = *(const f32x4*)(F.ssq + (size_t)m * 16 + 8), q3 = *(const f32x4*)(F.ssq + (size_t)m * 16 + 12);
            const float sd = ((q0.x + q0.y) + (q0.z + q0.w)) + ((q1.x + q1.y) + (q1.z + q1.w)), ss = ((q2.x + q2.y) + (q2.z + q2.w)) + ((q3.x + q3.y) + (q3.z + q3.w));
            const float rsd = 1.0f / sqrtf(sd * (1.f / DH) + NORM_EPS), rss = 1.0f / sqrtf(ss * (1.f / DH) + NORM_EPS);
            side[(i * 256 + F.tid) * 2] = rsd / rss; side[(i * 256 + F.tid) * 2 + 1] = rss; }
    }
    __syncthreads();
    pg8::Gemm g{F.OB, F.WoutT, D};
    pg8::EpiOutProj E{F.x, (bf16*)F.out, F.mod, (const LAS float*)side};
    pg8::gemm_phase<pg8::EpiOutProj, pg8::StaticOrder, 2>(F.lds, g, S, E);
}
struct PanelOrder {
    int G, c;
    __device__ __forceinline__ bool next(int i, pg8::Unit& u) const { const int pm = c + (i >> 2) * G; if (pm >= M / 256) return false; u.pm = pm; u.pn = i & 3; u.pb = u.pn; u.li = i; return true; }
};
__device__ __forceinline__ void phase_outproj_router(Frame& F, bool dry) {
    PanelOrder S{F.G, (int)blockIdx.x};
    LAS float* side = (LAS float*)(F.lds + pg8::SIDE_OFF);
    pg8::Unit u;
    for (int i = 0; i < 8 && S.next(i, u); ++i) {
        if (F.tid < 256) { const int m = u.pm * 256 + F.tid; const f32x4 q0 = *(const f32x4*)(F.ssq + (size_t)m * 16), q1 = *(const f32x4*)(F.ssq + (size_t)m * 16 + 4), q2 = *(const f32x4*)(F.ssq + (size_t)m * 16 + 8), q3 = *(const f32x4*)(F.ssq + (size_t)m * 16 + 12);
            const float sd = ((q0.x + q0.y) + (q0.z + q0.w)) + ((q1.x + q1.y) + (q1.z + q1.w)), ss = ((q2.x + q2.y) + (q2.z + q2.w)) + ((q3.x + q3.y) + (q3.z + q3.w));
            const float rsd = 1.0f / sqrtf(sd * (1.f / DH) + NORM_EPS), rss = 1.0f / sqrtf(ss * (1.f / DH) + NORM_EPS);
            side[(i * 256 + F.tid) * 2] = rsd / rss; side[(i * 256 + F.tid) * 2 + 1] = rss; }
    }
    __syncthreads();
    pg8::Gemm g{F.OB, F.WoutT, D};
    pg8::EpiOutProj E{F.x, (bf16*)F.out, F.mod, (const LAS float*)side};
    pg8::gemm_phase<pg8::EpiOutProj, PanelOrder, 2>(F.lds, g, S, E);
    asm volatile("s_waitcnt vmcnt(0)" ::: "memory");
    __syncthreads();
    phase_router(F, dry, true);
}
struct MoeOrder {
    const volatile LAS unsigned* ts; int T4, G, c;
    __device__ __forceinline__ bool next(int i, pg8::Unit& u) const {
        const int L = i * G + c; if (L >= T4) return false;
        const int tile = L >> 2, pn = L & 3; int e = 0;
#pragma unroll 1
        for (int k = 1; k < NE; ++k) { if ((int)ts[k] <= tile) e = k; else break; }
        u.pm = tile; u.pn = pn; u.pb = e * 4 + pn; u.li = i; return true;
    }
};
__device__ __forceinline__ void phase_moe1_fast(Frame& F) {
    build_tiles(F);
    MoeOrder S{F.MISC, 4 * (int)F.MISC[NE], F.G, F.vcu};
    LAS int* idxtab = (LAS int*)(F.lds + pg8::SIDE_OFF);
    pg8::Unit u;
    for (int i = 0; i < 16 && S.next(i, u); ++i) {
        if (F.tid < 256) { const int e = u.pb >> 2, jt = u.pm - (int)F.MISC[e]; const int cnt = (int)__hip_atomic_load(F.cnt + 64 * e, __ATOMIC_RELAXED, __HIP_MEMORY_SCOPE_AGENT);
            const int pos = jt * 256 + F.tid; idxtab[i * 256 + F.tid] = (pos < cnt) ? F.list[(size_t)e * LIST_CAP + pos] : 0; }
    }
    __syncthreads();
    pg8::Gemm g{F.HB, F.WguT, D};
    pg8::EpiSwiGLU E{F.HM};
    pg8::gemm_phase<pg8::EpiSwiGLU, MoeOrder, 1>(F.lds, g, S, E);
}
__device__ __forceinline__ void phase_moe2_fast(Frame& F) {
    build_tiles(F);
    MoeOrder S{F.MISC, 4 * (int)F.MISC[NE], F.G, F.vcu};
    pg8::Gemm g{F.HM, F.WdT, DFF};
    pg8::EpiY E{F.YB, D};
    pg8::gemm_phase<pg8::EpiY, MoeOrder, 0>(F.lds, g, S, E);
}

constexpr int N_PHASES = 9;
struct Args { const float* in[16]; float* out; unsigned char* ws; int ph_lo, ph_hi; };
__global__ void __launch_bounds__(NTHREADS, 2) mk_fwd(Args args) {
    extern __shared__ __attribute__((aligned(16))) unsigned char lds[];
    Frame F;
    F.lds = (LAS unsigned char*)lds; F.MISC = (volatile LAS unsigned*)(F.lds + MISC_OFF);
    F.tid = threadIdx.x; F.lane = F.tid & 63; F.wave = __builtin_amdgcn_readfirstlane(F.tid >> 6);
    F.G = gridDim.x; { const int bx = blockIdx.x; F.vcu = (F.G % 8 == 0) ? (bx % 8) * (F.G / 8) + bx / 8 : bx; }
    unsigned char* ws = args.ws; F.ws = ws; F.ctl = (unsigned*)(ws + WS_CTL);
    F.x = args.in[0]; F.c = args.in[1]; F.w_ada = args.in[2]; F.b_ada = args.in[3]; F.g_mix = args.in[4]; F.w_in = args.in[5]; F.g_dil = args.in[6]; F.g_sb = args.in[7];
    F.w_out = args.in[8]; F.g_ffn = args.in[9]; F.w_group = args.in[10]; F.w_expert = args.in[11]; F.w_gate = args.in[12]; F.w_up = args.in[13]; F.w_down = args.in[14]; F.g_final = args.in[15];
    F.out = args.out;
    F.mod = (float*)(ws + WS_MOD); F.WinT = (bf16*)(ws + WS_WIN); F.WoutT = (bf16*)(ws + WS_WOUT); F.WguT = (bf16*)(ws + WS_WGU); F.WdT = (bf16*)(ws + WS_WD);
    F.HB = (bf16*)(ws + WS_H); F.QKV = (bf16*)(ws + WS_QKV); F.OB = (bf16*)(ws + WS_O); F.HM = (bf16*)(ws + WS_PART); F.YB = (bf16*)(ws + WS_QKV);
    F.list = (int*)(ws + WS_LIST); F.tokslot = (i32x4*)(ws + WS_TOKSLOT); F.tokw = (float*)(ws + WS_TOKW); F.ssq = (float*)(ws + WS_SSQP); F.cnt = F.ctl + CW_CNT;
    for (int u = F.tid; u < 64; u += NTHREADS) F.MISC[u] = 0u;
    __syncthreads();
    const int lo = args.ph_lo, hi = args.ph_hi;
    XcdBarrier bar; bar.bar = F.ctl + CW_BAR; bar.x = 0; bar.st = nullptr;
    if (hi - lo > 1) bar = xcd_barrier_post(F.ctl + CW_BAR, F.MISC + 40);
#define IN(k) (lo <= (k) && (k) < hi)
#define SEAM(k) do { if (IN(k) && IN((k) + 1)) { \
        if (PROBE_PHASE == 201) { asm volatile("s_waitcnt vmcnt(0)" ::: "memory"); __syncthreads(); if (F.tid == 0) atomicMax((unsigned long long*)(F.ctl + 1024) + 8 * (k), (unsigned long long)__builtin_amdgcn_s_memrealtime()); } \
        xcd_barrier(bar); if (PROBE_PHASE == 200) xcd_barrier(bar); \
        if (PROBE_PHASE == 201) { const unsigned long long la_ = __hip_atomic_load((unsigned long long*)(F.ctl + 1024) + 8 * (k), __ATOMIC_RELAXED, __HIP_MEMORY_SCOPE_AGENT); const unsigned long long t1_ = __builtin_amdgcn_s_memrealtime(); \
            while (__builtin_amdgcn_s_memrealtime() - t1_ < t1_ - la_) __builtin_amdgcn_s_sleep(8); } } } while (0)
#define RPT(k) (PROBE_PHASE == (k))
#define TMD(k, call) do { if (PROBE_PHASE == 100 + (k)) { const unsigned long long t0_ = __builtin_amdgcn_s_memrealtime(); call; asm volatile("s_waitcnt vmcnt(0)" ::: "memory"); const unsigned long long t1_ = __builtin_amdgcn_s_memrealtime(); \
        while (__builtin_amdgcn_s_memrealtime() - t1_ < t1_ - t0_) __builtin_amdgcn_s_sleep(8); } else { call; } } while (0)
    if (IN(0)) { TMD(0, phase_mod(F); __syncthreads(); phase_weights(F)); if (RPT(0)) { phase_mod(F); __syncthreads(); phase_weights(F); } } SEAM(0);
    if (IN(1)) { TMD(1, phase_h(F)); if (RPT(1)) phase_h(F); } SEAM(1);
    if (IN(2)) { { TMD(2, phase_qkv_fast(F)); if (RPT(2)) phase_qkv_fast(F); } } SEAM(2);
    if (IN(3)) { if (RPT(3)) { phase_attn_a(F, true); phase_attn_b(F, true); } if (RPT(31)) phase_attn_a(F, true); if (RPT(36)) phase_attn_a(F, true, true); if (RPT(32)) phase_attn_b(F, true); TMD(31, phase_attn_a(F, false)); xcd_barrier(bar); TMD(32, phase_attn_b(F, false)); } SEAM(3);
    if (FUSE_OUT_ROUTER) { if (IN(4)) { if (RPT(4)) phase_outproj_router(F, true); phase_outproj_router(F, false); } if (IN(4) && IN(6)) xcd_barrier(bar); }
    else {
    if (IN(4)) { if (FAST_OUT) { TMD(4, phase_outproj_fast(F)); if (RPT(4)) phase_outproj_fast(F); } else phase_outproj_simple(F); } SEAM(4);
    if (IN(5)) { if (RPT(5)) phase_router(F, true); TMD(5, phase_router(F, false)); } SEAM(5);
    }
    if (IN(6)) { if (FAST_MOE1) { TMD(6, phase_moe1_fast(F)); if (RPT(6)) phase_moe1_fast(F); } else phase_moe1_simple(F); } SEAM(6);
    if (IN(7)) { if (FAST_MOE2) { TMD(7, phase_moe2_fast(F)); if (RPT(7)) phase_moe2_fast(F); } else phase_moe2_simple(F); } SEAM(7);
    if (IN(8)) { if (RPT(8)) phase_final(F, true); TMD(8, phase_final(F, false)); }
#undef RPT
#undef TMD
#undef IN
#undef SEAM
}

extern "C" void kernel_launch(void* const* d_in, const int* in_sizes, int n_in, void* d_out, int out_size, void* d_ws, size_t ws_size, hipStream_t stream) {
    static int grid = 0;
    if (grid == 0) {
        if (n_in != 16 || in_sizes[0] != M * D || out_size != M * D || ws_size < WS_END) { fprintf(stderr, "kernel_launch: unexpected shapes / workspace (n_in %d, ws %zu)\n", n_in, ws_size); grid = -1; return; }
        int dev = 0, cus = 0;
        if (hipGetDevice(&dev) != hipSuccess || hipDeviceGetAttribute(&cus, hipDeviceAttributeMultiprocessorCount, dev) != hipSuccess) { grid = -1; return; }
        if (hipFuncSetAttribute((const void*)mk_fwd, hipFuncAttributeMaxDynamicSharedMemorySize, LDS_BYTES) != hipSuccess) { fprintf(stderr, "kernel_launch: hipFuncSetAttribute failed\n"); grid = -1; return; }
        int per_cu = 0;
        if (hipOccupancyMaxActiveBlocksPerMultiprocessor(&per_cu, (const void*)mk_fwd, NTHREADS, LDS_BYTES) != hipSuccess || per_cu < 1) fprintf(stderr, "kernel_launch: occupancy query says %d\n", per_cu);
        (void)hipGetLastError();
        grid = cus;
    }
    if (grid < 0) return;
    (void)hipMemsetAsync((char*)d_ws + WS_CTL, 0, CTL_ZERO_BYTES, stream);
    Args a{};
    for (int i = 0; i < 16; ++i) a.in[i] = (const float*)d_in[i];
    a.out = (float*)d_out; a.ws = (unsigned char*)d_ws;
    constexpr int NL = MK_N_LAUNCHES;
    for (int li = 0; li < NL; ++li) {
        a.ph_lo = (NL == N_PHASES) ? li : (li * N_PHASES) / NL; a.ph_hi = (NL == N_PHASES) ? li + 1 : ((li + 1) * N_PHASES) / NL;
        hipLaunchKernelGGL(mk_fwd, dim3(grid), dim3(NTHREADS), LDS_BYTES, stream, a);
    }
}
```

```cpp
#include <hip/hip_runtime.h>
#include <cstdio>
#include <cstdint>

#ifndef PROBE_PHASE
#define PROBE_PHASE -1
#endif
#ifndef FUSE_OUT_ROUTER
#define FUSE_OUT_ROUTER 0
#endif
#ifndef SB_STOP
#define SB_STOP 9.0e-13f
#endif
#ifndef DIL_PIPE
#define DIL_PIPE 1
#endif
#ifndef FAST_ATTN
#define FAST_ATTN 2
#endif
#ifndef FAST_QKV
#define FAST_QKV 1
#endif
#ifndef FAST_OUT
#define FAST_OUT 1
#endif
#ifndef FAST_MOE1
#define FAST_MOE1 1
#endif
#ifndef FAST_MOE2
#define FAST_MOE2 1
#endif
#ifndef MK_N_LAUNCHES
#define MK_N_LAUNCHES 1
#endif

#define GAS __attribute__((address_space(1)))
#define LAS __attribute__((address_space(3)))
typedef unsigned short bf16;
typedef short bf16x8 __attribute__((ext_vector_type(8)));
typedef float f32x4 __attribute__((ext_vector_type(4)));
typedef float f32x16 __attribute__((ext_vector_type(16)));
typedef unsigned u32x4 __attribute__((ext_vector_type(4)));
typedef unsigned u32x2 __attribute__((ext_vector_type(2)));
typedef int i32x4 __attribute__((ext_vector_type(4)));

constexpr int NB = 8, SEQ = 8192, D = 1024, M = NB * SEQ;
constexpr int HD = 64, NH = 8, DH = 512;
constexpr int NE = 32, EPG = 8, NGRP = 4, DFF = 512;
constexpr float NORM_EPS = 1e-6f;
constexpr float LOG2E = 1.4426950408889634f;
constexpr float C2 = 0.125f * LOG2E;
constexpr int NWAVES = 8, NTHREADS = 512;
constexpr int LIST_CAP = M;
constexpr int MAX_TILES = (2 * M) / 256 + NE;

constexpr size_t MiB = 1u << 20;
constexpr size_t WS_CTL = 0, CTL_ZERO_BYTES = 128 * 1024;
constexpr size_t WS_MOD = 2 * MiB;
constexpr size_t WS_WIN = 4 * MiB;
constexpr size_t WS_WOUT = 10 * MiB;
constexpr size_t WS_WGU = 12 * MiB;
constexpr size_t WS_WD = 76 * MiB;
constexpr size_t WS_LIST = 108 * MiB;
constexpr size_t WS_TOKSLOT = 116 * MiB;
constexpr size_t WS_TOKW = 117 * MiB;
constexpr size_t WS_H = 120 * MiB;
constexpr size_t WS_QKV = 248 * MiB;
constexpr size_t WS_PART = 632 * MiB;
constexpr size_t WS_O = 768 * MiB;
constexpr size_t WS_SSQP = 76 * MiB;
constexpr size_t WS_X1 = 896 * MiB;
constexpr size_t WS_END = 1024 * MiB;
static_assert(WS_QKV + (size_t)MAX_TILES * 256 * 1024 * 2 <= WS_PART && WS_PART + (size_t)MAX_TILES * 256 * 512 * 2 <= WS_O, "overlays");
constexpr int CW_BAR = 4096;
constexpr int CW_CNT = 16384;
static_assert((CW_CNT + 64 * NE) * 4 <= (int)CTL_ZERO_BYTES && (CW_BAR + 3456) <= 8192 && 8192 + 2048 + 64 <= CW_CNT, "ctl");

constexpr int LDS_MAIN = 156672;
constexpr int MISC_OFF = LDS_MAIN;
constexpr int LDS_BYTES = LDS_MAIN + 1024;

__device__ __forceinline__ float bf2f(bf16 v) { return __uint_as_float((unsigned)v << 16); }
__device__ __forceinline__ unsigned f2bf(float f) { unsigned u = __float_as_uint(f); return (u + 0x7fffu + ((u >> 16) & 1u)) >> 16; }
__device__ __forceinline__ unsigned pk2(float lo, float hi) { return f2bf(lo) | (f2bf(hi) << 16); }
template <int CTRL> __device__ __forceinline__ float dpp_mov(float v) { return __int_as_float(__builtin_amdgcn_mov_dpp(__float_as_int(v), CTRL, 0xf, 0xf, true)); }
__device__ __forceinline__ float wave_sum(float v) {
    v += dpp_mov<0xB1>(v); v += dpp_mov<0x4E>(v); v += dpp_mov<0x141>(v); v += dpp_mov<0x140>(v);
    const float r0 = __int_as_float(__builtin_amdgcn_readlane(__float_as_int(v), 0)), r1 = __int_as_float(__builtin_amdgcn_readlane(__float_as_int(v), 16));
    const float r2 = __int_as_float(__builtin_amdgcn_readlane(__float_as_int(v), 32)), r3 = __int_as_float(__builtin_amdgcn_readlane(__float_as_int(v), 48));
    return (r0 + r1) + (r2 + r3);
}
__device__ __forceinline__ float rowsum16(float v) { v += dpp_mov<0xB1>(v); v += dpp_mov<0x4E>(v); v += dpp_mov<0x141>(v); v += dpp_mov<0x140>(v); return v; }
__device__ __forceinline__ float swap32_add(float a, float b) { auto rr = __builtin_amdgcn_permlane32_swap(__float_as_uint(a), __float_as_uint(b), false, false); return __uint_as_float(rr[0]) + __uint_as_float(rr[1]); }
__device__ __forceinline__ float swap16_add(float a, float b) { auto rr = __builtin_amdgcn_permlane16_swap(__float_as_uint(a), __float_as_uint(b), false, false); return __uint_as_float(rr[0]) + __uint_as_float(rr[1]); }
__device__ __forceinline__ float rdl(float v, int l) { return __int_as_float(__builtin_amdgcn_readlane(__float_as_int(v), l)); }
__device__ __forceinline__ void wave_sum4(float (&v)[4]) {
    const float a = swap32_add(v[0], v[2]), b = swap32_add(v[1], v[3]);
    const float c = rowsum16(swap16_add(a, b));
    v[0] = rdl(c, 0); v[1] = rdl(c, 16); v[2] = rdl(c, 32); v[3] = rdl(c, 48);
}
__device__ __forceinline__ void wave_sum8(float (&v)[8]) {
    const float a0 = swap32_add(v[0], v[4]), a1 = swap32_add(v[1], v[5]), a2 = swap32_add(v[2], v[6]), a3 = swap32_add(v[3], v[7]);
    const float c0 = rowsum16(swap16_add(a0, a2)), c1 = rowsum16(swap16_add(a1, a3));
    v[0] = rdl(c0, 0); v[1] = rdl(c1, 0); v[2] = rdl(c0, 16); v[3] = rdl(c1, 16); v[4] = rdl(c0, 32); v[5] = rdl(c1, 32); v[6] = rdl(c0, 48); v[7] = rdl(c1, 48);
}
__device__ __forceinline__ int crow(int r, int hi) { return (r & 3) + 8 * (r >> 2) + 4 * hi; }
#define MFMA32(a, b, c) __builtin_amdgcn_mfma_f32_32x32x16_bf16((a), (b), (c), 0, 0, 0)

#define XB_TMO      128
#define XB_XCNT(j)  (256  + 64 * (j))
#define XB_XSUB(j)  (1280 + 64 * (j))
#define XB_XGEN(j)  (2304 + 64 * (j))
#define XB_TOP      3328
#define XB_TOPGEN   3392
#define XCD_BAR_WORDS 3456
#define XB_SPIN_CAP (1u << 18)
__device__ __forceinline__ unsigned xb_ld(unsigned* p)              { return __hip_atomic_load(p, __ATOMIC_RELAXED, __HIP_MEMORY_SCOPE_AGENT); }
__device__ __forceinline__ unsigned xb_add(unsigned* p, unsigned v) { return __hip_atomic_fetch_add(p, v, __ATOMIC_RELAXED, __HIP_MEMORY_SCOPE_AGENT); }
__device__ __forceinline__ unsigned xb_xcc_id() { return (unsigned)__builtin_amdgcn_s_getreg((3 << 11) | 20) & 0xFu; }
#define XB_SPIN(cond, bar) do { unsigned _sp = 0; while (cond) { __builtin_amdgcn_s_sleep(1); \
    if ((++_sp & 255u) == 0u) { if (xb_ld(&(bar)[XB_TMO])) break; if (_sp > XB_SPIN_CAP) { atomicAdd(&(bar)[XB_TMO], 1u); break; } } } } while (0)
struct XcdBarrier { unsigned* bar; unsigned x; volatile LAS unsigned* st; };
__device__ __forceinline__ XcdBarrier xcd_barrier_post(unsigned* bar, volatile LAS unsigned* st) {
    XcdBarrier b; b.bar = bar; b.x = xb_xcc_id(); b.st = st;
    if (threadIdx.x == 0) (void)xb_add(&bar[XB_XCNT(b.x)], 1u);
    return b;
}
__device__ __forceinline__ void xcd_barrier_complete(unsigned* bar, unsigned x, unsigned& nloc, unsigned& nx) {
    const unsigned G = gridDim.x * gridDim.y * gridDim.z;
    unsigned sum, cnt, mine, sp = 0u;
    for (;;) {
        sum = 0u; cnt = 0u; mine = 0u;
#pragma unroll
        for (unsigned j = 0; j < 16; ++j) { const unsigned c = xb_ld(&bar[XB_XCNT(j)]); sum += c; cnt += (c > 0u) ? 1u : 0u; mine = (j == x) ? c : mine; }
        if (sum == G) break;
        __builtin_amdgcn_s_sleep(1);
        if ((++sp & 255u) == 0u) { if (xb_ld(&bar[XB_TMO])) break; if (sp > XB_SPIN_CAP) { atomicAdd(&bar[XB_TMO], 1u); break; } }
    }
    nloc = mine > 0u ? mine : 1u; nx = cnt > 0u ? cnt : 1u;
}
__device__ __forceinline__ void xcd_barrier(const XcdBarrier& b) {
    asm volatile("s_waitcnt vmcnt(0)" ::: "memory");
    __syncthreads();
    if (threadIdx.x == 0) {
        unsigned* bar = b.bar;
        __builtin_amdgcn_s_waitcnt(0);
        unsigned nloc = b.st[0], nx = b.st[1];
        if (nloc == 0u) { xcd_barrier_complete(bar, b.x, nloc, nx); b.st[0] = nloc; b.st[1] = nx; }
        const unsigned old = xb_add(&bar[XB_XSUB(b.x)], 1u);
        const unsigned gen = old / nloc;
        if (old + 1u == (gen + 1u) * nloc) {
            __builtin_amdgcn_fence(__ATOMIC_RELEASE, "agent");
            asm volatile("s_waitcnt vmcnt(0)" ::: "memory");
            const unsigned og = xb_add(&bar[XB_TOP], 1u);
            const unsigned tg = og / nx;
            if (og + 1u == (tg + 1u) * nx) xb_add(&bar[XB_TOPGEN], 1u);
            else XB_SPIN(xb_ld(&bar[XB_TOPGEN]) == tg, bar);
            __builtin_amdgcn_fence(__ATOMIC_ACQUIRE, "agent");
            xb_add(&bar[XB_XGEN(b.x)], 1u);
            asm volatile("s_waitcnt vmcnt(0)" ::: "memory");
        } else {
            XB_SPIN(xb_ld(&bar[XB_XGEN(b.x)]) == gen, bar);
            __builtin_amdgcn_fence(__ATOMIC_ACQUIRE, "agent");
            asm volatile("s_waitcnt vmcnt(0)" ::: "memory");
        }
    }
    __syncthreads();
}

constexpr int CW_GB = 8192, CW_IRREG = CW_GB + 2048;
__device__ __forceinline__ void group_barrier(unsigned* ctl, unsigned x, unsigned n) {
    asm volatile("s_waitcnt vmcnt(0)" ::: "memory");
    __syncthreads();
    if (threadIdx.x == 0) {
        unsigned* cntw = ctl + CW_GB + 128 * x; unsigned* genw = cntw + 64;
        __builtin_amdgcn_s_waitcnt(0);
        const unsigned old = xb_add(cntw, 1u); const unsigned gen = old / n;
        if (old + 1u == (gen + 1u) * n) (void)xb_add(genw, 1u);
        else XB_SPIN(xb_ld(genw) == gen, ctl + CW_BAR);
        __builtin_amdgcn_fence(__ATOMIC_ACQUIRE, "agent");
        asm volatile("s_waitcnt vmcnt(0)" ::: "memory");
    }
    __syncthreads();
}

struct Frame {
    LAS unsigned char* lds;
    volatile LAS unsigned* MISC;
    unsigned* ctl;
    int tid, lane, wave, vcu, G;
    const float *x, *c, *w_ada, *b_ada, *g_mix, *w_in, *g_dil, *g_sb, *w_out, *g_ffn, *w_group, *w_expert, *w_gate, *w_up, *w_down, *g_final;
    float* out; unsigned char* ws;
    float* mod; bf16 *WinT, *WoutT, *WguT, *WdT, *HB, *QKV, *OB, *HM, *YB, *XB;
    int* list; i32x4* tokslot; float* tokw; float* ssq; unsigned* cnt;
};

__device__ __forceinline__ void phase_mod(Frame& F) {
    LAS float* sc = (LAS float*)F.lds;
    LAS float* red = sc + 8192;
    for (int i = F.tid; i < NB * D; i += NTHREADS) { const float v = F.c[i]; sc[i] = v / (1.f + __expf(-v)); }
    __syncthreads();
    for (int cg = blockIdx.x; cg < 256; cg += F.G) {
        const int ks = F.tid >> 5, cl = F.tid & 31; const bool act = cl < 24; const int col = cg * 24 + (act ? cl : 0);
        float acc[8];
#pragma unroll
        for (int b = 0; b < 8; ++b) acc[b] = 0.f;
        const float* wp = F.w_ada + (size_t)(ks * 64) * 6144 + col;
#pragma unroll
        for (int kk = 0; kk < 64; ++kk) { const float wv = wp[(size_t)kk * 6144];
#pragma unroll
            for (int b = 0; b < 8; ++b) acc[b] += sc[b * 1024 + ks * 64 + kk] * wv; }
#pragma unroll
        for (int b = 0; b < 8; ++b) red[(ks * 8 + b) * 32 + cl] = acc[b];
        __syncthreads();
        if (F.tid < 256) { const int b = F.tid >> 5, c2 = F.tid & 31;
            if (c2 < 24) { float s = 0.f;
#pragma unroll
                for (int k2 = 0; k2 < 16; ++k2) s += red[(k2 * 8 + b) * 32 + c2];
                F.mod[b * 6144 + cg * 24 + c2] = s + F.b_ada[cg * 24 + c2]; } }
        __syncthreads();
    }
}

template <class RowMap, bool PERMK = false>
__device__ __forceinline__ void transpose_item(const float* W, int K, int N, bf16* WT, RowMap rm, const float* gk, LAS float* scr, int item, int lane) {
    const int nblk = N / 32, kb = item / nblk, nb = item % nblk, k0 = 64 * kb, n0 = 32 * nb;
#pragma unroll 8
    for (int i = 0; i < 32; ++i) { const int kk = 2 * i + (lane >> 5); float v = W[(size_t)(k0 + kk) * N + n0 + (lane & 31)]; if (gk) v *= gk[k0 + kk]; scr[kk * 33 + (lane & 31)] = v; }
    asm volatile("s_waitcnt lgkmcnt(0)" ::: "memory");
    const int c = lane & 7;
#pragma unroll
    for (int j = 0; j < 4; ++j) { const int n = (lane >> 3) + 8 * j;
        const int rbase = PERMK ? (32 * ((c >> 1) & 1) + 16 * (c & 1) + 4 * (c >> 2)) : 8 * c;
        const LAS float* s = scr + rbase * 33 + n;
        u32x4 o;
        if (PERMK) { o.x = pk2(s[0 * 33], s[1 * 33]); o.y = pk2(s[2 * 33], s[3 * 33]); o.z = pk2(s[8 * 33], s[9 * 33]); o.w = pk2(s[10 * 33], s[11 * 33]); }
        else { o.x = pk2(s[0 * 33], s[1 * 33]); o.y = pk2(s[2 * 33], s[3 * 33]); o.z = pk2(s[4 * 33], s[5 * 33]); o.w = pk2(s[6 * 33], s[7 * 33]); }
        *(u32x4*)(WT + (size_t)rm(n0 + n) * K + k0 + 8 * c) = o; }
    asm volatile("s_waitcnt lgkmcnt(0)" ::: "memory");
}
struct RmId { __device__ __forceinline__ int operator()(int n) const { return n; } };
struct RmGU { int up; __device__ __forceinline__ int operator()(int n) const { return 8 * (n >> 2) + 4 * up + (n & 3); } };

struct WItem { const float* W; bf16* WT; const float* gk; int K, N, k0, n0, rmode  , permk; };
__device__ __forceinline__ void witem_decode(const Frame& F, int it, WItem& w) {
    constexpr int I_IN = 16 * 96, I_OUT = 16 * 32, I_G = 16 * 16, I_D = 8 * 32;
    int r = it; w.gk = nullptr; w.rmode = 0; w.permk = 0;
    if (r < I_IN) { w.W = F.w_in; w.WT = F.WinT; w.K = D; w.N = 3 * D; }
    else { r -= I_IN;
        if (r < I_OUT) { w.W = F.w_out; w.WT = F.WoutT; w.K = D; w.N = D; w.gk = ((r / 32) < 8) ? F.g_dil : (F.g_sb - 512); w.permk = 1; }
        else { r -= I_OUT; const int e = r / (2 * I_G + I_D); r -= e * (2 * I_G + I_D);
            if (r < I_G) { w.W = F.w_gate + (size_t)e * D * DFF; w.WT = F.WguT + (size_t)e * D * D; w.K = D; w.N = DFF; w.rmode = 1; }
            else { r -= I_G;
                if (r < I_G) { w.W = F.w_up + (size_t)e * D * DFF; w.WT = F.WguT + (size_t)e * D * D; w.K = D; w.N = DFF; w.rmode = 2; }
                else { r -= I_G; w.W = F.w_down + (size_t)e * DFF * D; w.WT = F.WdT + (size_t)e * D * DFF; w.K = DFF; w.N = D; } } } }
    const int nblk = w.N / 32; w.k0 = 64 * (r / nblk); w.n0 = 32 * (r % nblk);
}
__device__ __forceinline__ void witem_load(const WItem& w, f32x4 (&v)[8], int lane) {
    const int c4 = 4 * (lane & 7), rr = lane >> 3;
#pragma unroll
    for (int i = 0; i < 8; ++i) v[i] = __builtin_nontemporal_load((const f32x4*)(w.W + (size_t)(w.k0 + 8 * i + rr) * w.N + w.n0 + c4));
}
__device__ __forceinline__ void witem_finish(const WItem& w, const f32x4 (&v)[8], LAS float* scr, int lane) {
    { const int c4 = 4 * (lane & 7), rr = lane >> 3;
#pragma unroll
      for (int i = 0; i < 8; ++i) { const int kk = 8 * i + rr; const float g = w.gk ? w.gk[w.k0 + kk] : 1.0f; LAS float* d = scr + kk * 33 + c4;
          d[0] = v[i].x * g; d[1] = v[i].y * g; d[2] = v[i].z * g; d[3] = v[i].w * g; } }
    asm volatile("s_waitcnt lgkmcnt(0)" ::: "memory");
    const int c = lane & 7;
    const int rbase = w.permk ? (32 * ((c >> 1) & 1) + 16 * (c & 1) + 4 * (c >> 2)) : 8 * c; const int hi = w.permk ? 8 : 4;
#pragma unroll
    for (int j = 0; j < 4; ++j) { const int n = (lane >> 3) + 8 * j; const LAS float* s = scr + rbase * 33 + n;
        u32x4 o; o.x = pk2(s[0 * 33], s[1 * 33]); o.y = pk2(s[2 * 33], s[3 * 33]); o.z = pk2(s[hi * 33], s[(hi + 1) * 33]); o.w = pk2(s[(hi + 2) * 33], s[(hi + 3) * 33]);
        const int nn = w.n0 + n; const int row = (w.rmode == 0) ? nn : (8 * (nn >> 2) + 4 * (w.rmode - 1) + (nn & 3));
        *(u32x4*)(w.WT + (size_t)row * w.K + w.k0 + 8 * c) = o; }
    asm volatile("s_waitcnt lgkmcnt(0)" ::: "memory");
}
template <int MODE>
__device__ __forceinline__ int witem_index(int j) {
    if (MODE == 0) return j;
    if (MODE == 1) return 2048 + (j >> 8) * 768 + 512 + (j & 255);
    return 2048 + (j >> 9) * 768 + (j & 511);
}
template <int MODE>
__device__ __forceinline__ void weights_items(Frame& F, LAS float* scr, int first, int end, int stride) {
    if (first >= end) return;
    WItem cur, nxt; f32x4 v[8], vn[8];
    witem_decode(F, witem_index<MODE>(first), cur); witem_load(cur, v, F.lane);
    __builtin_amdgcn_s_waitcnt(0x0F70);
    for (int it = first; it < end; it += stride) {
        const bool has_next = it + stride < end;
        witem_decode(F, witem_index<MODE>(has_next ? it + stride : it), nxt); witem_load(nxt, vn, F.lane);
        witem_finish(cur, v, scr, F.lane);
        cur = nxt;
#pragma unroll
        for (int i = 0; i < 8; ++i) v[i] = vn[i];
    }
}
__device__ __forceinline__ void phase_weights(Frame& F) {
    weights_items<0>(F, (LAS float*)(F.lds + F.wave * 16384), F.vcu * NWAVES + F.wave, 2048, F.G * NWAVES);
}
__device__ __forceinline__ void phase_p0(Frame& F) {
    const int first = F.vcu * NWAVES + F.wave, stride = F.G * NWAVES;
    WItem it0; f32x4 v0[8];
    const bool has0 = first < 2048;
    witem_decode(F, witem_index<0>(has0 ? first : 0), it0); witem_load(it0, v0, F.lane);
    phase_mod(F);
    __syncthreads();
    if (has0) witem_finish(it0, v0, (LAS float*)(F.lds + F.wave * 16384), F.lane);
    weights_items<0>(F, (LAS float*)(F.lds + F.wave * 16384), first + stride, 2048, stride);
}
__device__ __forceinline__ void phase_h(Frame& F) {
    const int gw = F.vcu * NWAVES + F.wave, NGW = F.G * NWAVES;
    for (int ch = gw; ch < M / 32; ch += NGW) {
        const int b = ch / (SEQ / 32);
        f32x4 gs[4], sh[4];
#pragma unroll
        for (int j = 0; j < 4; ++j) { const int col = 4 * F.lane + 256 * j;
            const f32x4 g = *(const f32x4*)(F.g_mix + col), scl = *(const f32x4*)(F.mod + b * 6144 + 1024 + col); sh[j] = *(const f32x4*)(F.mod + b * 6144 + col);
            gs[j] = g * (scl + 1.0f); }
        for (int rr = 0; rr < 32; ++rr) {
            const size_t m = (size_t)ch * 32 + rr;
            const f32x4* xr = (const f32x4*)(F.x + m * D) + F.lane;
            f32x4 v[4]; float s = 0.f;
#pragma unroll
            for (int j = 0; j < 4; ++j) { v[j] = __builtin_nontemporal_load(&xr[64 * j]); s += (v[j].x * v[j].x + v[j].y * v[j].y) + (v[j].z * v[j].z + v[j].w * v[j].w); }
            const float rs = 1.0f / sqrtf(wave_sum(s) * (1.f / D) + NORM_EPS);
            unsigned long long* o8 = (unsigned long long*)(F.HB + m * D) + F.lane;
#pragma unroll
            for (int j = 0; j < 4; ++j) { const f32x4 y = v[j] * rs * gs[j] + sh[j];
                o8[64 * j] = (unsigned long long)pk2(y.x, y.y) | ((unsigned long long)pk2(y.z, y.w) << 32); }
        }
    }
}

template <int NI>
__device__ __forceinline__ void sg_mainloop(f32x16 (&acc)[NI][2], const bf16* const (&pa)[2], const bf16* const (&pb)[NI], int kbeg, int kend) {
#pragma unroll 2
    for (int k = kbeg; k < kend; k += 32) {
        bf16x8 a[2][2], b[NI][2];
#pragma unroll
        for (int s = 0; s < 2; ++s) {
#pragma unroll
            for (int mi = 0; mi < 2; ++mi) a[mi][s] = *(const bf16x8*)(pa[mi] + k + 16 * s);
#pragma unroll
            for (int ni = 0; ni < NI; ++ni) b[ni][s] = *(const bf16x8*)(pb[ni] + k + 16 * s);
        }
#pragma unroll
        for (int s = 0; s < 2; ++s)
#pragma unroll
            for (int ni = 0; ni < NI; ++ni)
#pragma unroll
                for (int mi = 0; mi < 2; ++mi) acc[ni][mi] = MFMA32(b[ni][s], a[mi][s], acc[ni][mi]);
    }
}
template <int NI> __device__ __forceinline__ void sg_zero(f32x16 (&acc)[NI][2]) {
#pragma unroll
    for (int ni = 0; ni < NI; ++ni)
#pragma unroll
        for (int mi = 0; mi < 2; ++mi)
#pragma unroll
            for (int i = 0; i < 16; ++i) acc[ni][mi][i] = 0.f;
}

namespace pg8 {
typedef unsigned short bf16_t;
constexpr int BM = 256, BK = 64, HALF = 128, HTB = HALF * BK * 2, STAGE_BYTES = 8 * HTB, NXCD = 8, WGM = 8;
constexpr int SIDE_OFF = STAGE_BYTES;
__host__ __device__ __forceinline__ int lds_byte(int r, int c) { const int st = (r >> 4) * 2 + (c >> 5), rr = r & 15, cc = c & 31, ob = rr * 64 + cc * 2; return st * 1024 + (ob ^ (((ob >> 9) & 1) << 5)); }
__host__ __device__ __forceinline__ void stage_rc(int b, int& R, int& C) { const int st = b / 1024, sb = b % 1024, swz = sb ^ (((sb >> 9) & 1) << 5); R = (st >> 1) * 16 + swz / 64; C = (st & 1) * 32 + (swz % 64) / 2; }
__host__ __device__ __forceinline__ int perm32(int rho) { const int n = rho >> 4, i = rho & 15; return 8 * (i >> 2) + 4 * n + (i & 3); }
struct Unit { int pm, pn, pb, li; };
struct Gemm { const bf16_t* A; const bf16_t* Bt; int K; };
struct StaticOrder {
    int nM, nN, nwg, G, c;
    __device__ void init(int M_, int N_, int G_, int c_) { nM = M_ / BM; nN = N_ / BM; nwg = nM * nN; G = G_; c = c_; }
    __device__ bool next(int i, Unit& u) const {
        const long L = (long)i * G + c; if (L >= nwg) return false;
        int wgid = (int)L; { const int q = nwg / NXCD, r = nwg % NXCD, xcd = wgid % NXCD, off = wgid / NXCD; wgid = (xcd < r ? xcd * (q + 1) : r * (q + 1) + (xcd - r) * q) + off; }
        const int nig = WGM * nN, gid = wgid / nig, fm = gid * WGM, gsz = (nM - fm) < WGM ? (nM - fm) : WGM;
        u.pm = fm + ((wgid % nig) % gsz); u.pn = (wgid % nig) / gsz; u.pb = u.pn; u.li = i; return true;
    }
};
__device__ __forceinline__ unsigned cvt_pk_bf16(float lo, float hi) { unsigned r; asm volatile("v_cvt_pk_bf16_f32 %0, %1, %2" : "=v"(r) : "v"(lo), "v"(hi)); return r; }

template <class Epi, class Sched, int MODE>
__device__ __forceinline__ void gemm_phase(LAS unsigned char* lds, const Gemm g, const Sched& S, const Epi& E) {
    constexpr bool GATHER = (MODE == 1), RESCALE = (MODE == 2);
    const int tid = threadIdx.x, wid = __builtin_amdgcn_readfirstlane(tid >> 6), lane = tid & 63, wr = wid >> 2, wc = wid & 3, fr = lane & 15, fq = lane >> 4;
    const int K = g.K, nt = K / BK;
    unsigned voffA[2], voffB[2]; int RA[2], CA2[2];
#pragma unroll
    for (int i = 0; i < 2; ++i) { int R, C; stage_rc(tid * 16 + i * 8192, R, C); const int Rb = Epi::PERM ? ((R & ~31) + perm32(R & 31)) : R;
        voffA[i] = (unsigned)(R * K + C) * 2u; voffB[i] = (unsigned)(Rb * K + C) * 2u; RA[i] = R; CA2[i] = C * 2; }
    const size_t kstep = (size_t)(BK * 2);
    const size_t hstep = (size_t)HALF * K * 2;
    const size_t tstep = 2 * hstep;
    const unsigned ldsw = (unsigned)wid * 1024u;
    const int aoff = lds_byte(wr * 64 + fr, fq * 8), boff = lds_byte(wc * 32 + fr, fq * 8);
    const LAS int* idxtab = (const LAS int*)(lds + SIDE_OFF);
#define PG8_SA(b, h) (((b) * 2 + (h)) * HTB)
#define PG8_SB(b, h) ((4 + (b) * 2 + (h)) * HTB)
#define PG8_STAGE2(bufoff, gbase, o0, o1) do { \
        __builtin_amdgcn_global_load_lds((const unsigned*)((const char*)(gbase) + (o0)), (LAS unsigned*)(lds + (bufoff) + ldsw), 16, 0, 0); \
        __builtin_amdgcn_global_load_lds((const unsigned*)((const char*)(gbase) + (o1)), (LAS unsigned*)(lds + (bufoff) + ldsw + 8192), 16, 0, 0); } while (0)
#define PG8_STAGE(bufoff, gbase, voff) PG8_STAGE2(bufoff, gbase, (voff)[0], (voff)[1])
#define PG8_STAGE_A(bufoff, hf, aptr, NXT) do { if constexpr (GATHER) { const unsigned o0_ = (NXT) ? goffN[hf][0] : goffC[hf][0], o1_ = (NXT) ? goffN[hf][1] : goffC[hf][1]; PG8_STAGE2(bufoff, aptr, o0_, o1_); } \
        else { PG8_STAGE(bufoff, (aptr) + (hf) * hstep, voffA); } } while (0)
#define PG8_LDA(dst, b, h) do { _Pragma("unroll") for (int m = 0; m < 4; ++m) _Pragma("unroll") for (int k = 0; k < 2; ++k) dst[m][k] = *(const LAS bf16x8*)(lds + PG8_SA(b, h) + aoff + m * 2048 + k * 1024); } while (0)
#define PG8_LDB(dst, b, h) do { _Pragma("unroll") for (int n = 0; n < 2; ++n) _Pragma("unroll") for (int k = 0; k < 2; ++k) dst[n][k] = *(const LAS bf16x8*)(lds + PG8_SB(b, h) + boff + n * 2048 + k * 1024); } while (0)
#define PG8_MMA(ai, bj, At, Bt) do { __builtin_amdgcn_s_setprio(1); _Pragma("unroll") for (int m = 0; m < 4; ++m) _Pragma("unroll") for (int n = 0; n < 2; ++n) _Pragma("unroll") for (int k = 0; k < 2; ++k) \
        acc[ai][bj][m][n] = __builtin_amdgcn_mfma_f32_16x16x32_bf16(Bt[n][k], At[m][k], acc[ai][bj][m][n], 0, 0, 0); __builtin_amdgcn_s_setprio(0); } while (0)
#define PG8_WAIT_V(n) asm volatile("s_waitcnt vmcnt(" #n ")" ::: "memory")
#define PG8_WAIT_L(n) asm volatile("s_waitcnt lgkmcnt(" #n ")" ::: "memory")
#define PG8_BAR __builtin_amdgcn_s_barrier()
#define PG8_SCHED __builtin_amdgcn_sched_barrier(0)
#define PG8_GOFF(dst, u) do { _Pragma("unroll") for (int hf_ = 0; hf_ < 2; ++hf_) _Pragma("unroll") for (int i_ = 0; i_ < 2; ++i_) \
        dst[hf_][i_] = (unsigned)idxtab[(u).li * 256 + hf_ * 128 + RA[i_]] * (unsigned)(K * 2) + (unsigned)CA2[i_]; } while (0)
    Unit cur, nxt; int ui = 0;
    if (!S.next(0, cur)) return;
    f32x4 acc[2][2][4][2];
#pragma unroll
    for (int a = 0; a < 2; ++a)
#pragma unroll
        for (int b = 0; b < 2; ++b)
#pragma unroll
            for (int m = 0; m < 4; ++m)
#pragma unroll
                for (int n = 0; n < 2; ++n) acc[a][b][m][n] = (f32x4){0.f, 0.f, 0.f, 0.f};
    bf16x8 At[4][2], B0[2][2], B1[2][2];
    unsigned goffC[2][2] = {{0u, 0u}, {0u, 0u}}, goffN[2][2] = {{0u, 0u}, {0u, 0u}};
    if constexpr (GATHER) { PG8_GOFF(goffC, cur); }
    const char* cA = GATHER ? (const char*)g.A : (const char*)g.A + (size_t)cur.pm * tstep; const char* cB = (const char*)g.Bt + (size_t)cur.pb * tstep;
    PG8_STAGE(PG8_SB(0, 0), cB, voffB); PG8_STAGE(PG8_SB(0, 1), cB + hstep, voffB); PG8_STAGE_A(PG8_SA(0, 0), 0, cA, false); PG8_STAGE_A(PG8_SA(0, 1), 1, cA, false);
    if (wr == 1) PG8_BAR;
    PG8_WAIT_V(2); PG8_BAR;
    PG8_STAGE(PG8_SB(1, 0), cB + kstep, voffB); PG8_STAGE_A(PG8_SA(1, 0), 0, cA + kstep, false); PG8_STAGE(PG8_SB(1, 1), cB + hstep + kstep, voffB);
    PG8_WAIT_V(6); PG8_BAR;
    for (;;) {
        const bool has_next = S.next(ui + 1, nxt);
        const char* nA = GATHER ? cA : (has_next ? (const char*)g.A + (size_t)nxt.pm * tstep : cA); const char* nB = has_next ? (const char*)g.Bt + (size_t)nxt.pb * tstep : cB;
        if constexpr (GATHER) { if (has_next) { PG8_GOFF(goffN, nxt); } else {
#pragma unroll
            for (int hf = 0; hf < 2; ++hf) { goffN[hf][0] = goffC[hf][0]; goffN[hf][1] = goffC[hf][1]; } } }
        for (int t = 0; t < nt; t += 2) {
            const bool last = (t == nt - 2);
            const char* a1 = cA + (size_t)(t + 1) * kstep;
            const char* a2 = last ? nA : cA + (size_t)(t + 2) * kstep; const char* b2 = last ? nB : cB + (size_t)(t + 2) * kstep;
            const char* a3 = a2 + kstep; const char* b3 = b2 + kstep;
            if constexpr (RESCALE) { if (t == nt / 2) { const LAS float* sd = (const LAS float*)(lds + SIDE_OFF) + (size_t)cur.li * 512;
#pragma unroll
                for (int ai = 0; ai < 2; ++ai)
#pragma unroll
                    for (int m = 0; m < 4; ++m) { const float f = sd[2 * (ai * HALF + wr * 64 + m * 16 + fr)];
#pragma unroll
                        for (int bj = 0; bj < 2; ++bj)
#pragma unroll
                            for (int n = 0; n < 2; ++n) acc[ai][bj][m][n] = acc[ai][bj][m][n] * f; } } }
            PG8_LDB(B0, 0, 0); PG8_LDB(B1, 0, 1); PG8_SCHED; PG8_LDA(At, 0, 0); PG8_STAGE_A(PG8_SA(1, 1), 1, a1, false);
            PG8_WAIT_V(8); PG8_WAIT_L(0); PG8_BAR; PG8_MMA(0, 0, At, B0); PG8_MMA(0, 1, At, B1); PG8_BAR; PG8_SCHED;
            PG8_LDA(At, 0, 1); PG8_STAGE(PG8_SB(0, 0), b2, voffB); PG8_STAGE(PG8_SB(0, 1), b2 + hstep, voffB); PG8_STAGE_A(PG8_SA(0, 0), 0, a2, last);
            PG8_WAIT_V(8); PG8_WAIT_L(0); PG8_BAR; PG8_MMA(1, 0, At, B0); PG8_MMA(1, 1, At, B1); PG8_BAR; PG8_SCHED;
            PG8_LDB(B0, 1, 0); PG8_LDB(B1, 1, 1); PG8_SCHED; PG8_LDA(At, 1, 0); PG8_STAGE_A(PG8_SA(0, 1), 1, a2, last);
            PG8_WAIT_V(8); PG8_WAIT_L(0); PG8_BAR; PG8_MMA(0, 0, At, B0); PG8_MMA(0, 1, At, B1); PG8_BAR; PG8_SCHED;
            PG8_LDA(At, 1, 1); PG8_STAGE(PG8_SB(1, 0), b3, voffB); PG8_STAGE(PG8_SB(1, 1), b3 + hstep, voffB); PG8_STAGE_A(PG8_SA(1, 0), 0, a3, last);
            PG8_WAIT_V(8); PG8_WAIT_L(0); PG8_BAR; PG8_MMA(1, 0, At, B0); PG8_MMA(1, 1, At, B1); PG8_BAR; PG8_SCHED;
        }
        if (wr == 0) PG8_BAR;
        E(acc, cur, wr, wc, fr, fq);
        if (!has_next) break;
#pragma unroll
        for (int a = 0; a < 2; ++a)
#pragma unroll
            for (int b = 0; b < 2; ++b)
#pragma unroll
                for (int m = 0; m < 4; ++m)
#pragma unroll
                    for (int n = 0; n < 2; ++n) acc[a][b][m][n] = (f32x4){0.f, 0.f, 0.f, 0.f};
        cur = nxt; cA = nA; cB = nB; ++ui;
        if constexpr (GATHER) {
#pragma unroll
            for (int hf = 0; hf < 2; ++hf) { goffC[hf][0] = goffN[hf][0]; goffC[hf][1] = goffN[hf][1]; } }
        if (wr == 1) PG8_BAR;
    }
    PG8_WAIT_V(0);
    PG8_BAR;
#undef PG8_SA
#undef PG8_SB
#undef PG8_STAGE
#undef PG8_STAGE2
#undef PG8_STAGE_A
#undef PG8_LDA
#undef PG8_LDB
#undef PG8_MMA
#undef PG8_WAIT_V
#undef PG8_WAIT_L
#undef PG8_BAR
#undef PG8_SCHED
#undef PG8_GOFF
}

struct EpiQKV {
    static constexpr bool PERM = true;
    bf16_t* O;
    __device__ __forceinline__ void operator()(const f32x4 (&acc)[2][2][4][2], const Unit& u, int wr, int wc, int fr, int fq) const {
        const int row0 = u.pm * BM + wr * 64 + fr; const int colt = u.pn * BM; const int t = colt >> 9;
        const int b = (u.pm * BM) / SEQ, tok0 = row0 - b * SEQ;
        bf16_t* base = O + (size_t)t * M * DH; const float sc = (t == 0 || t == 3) ? C2 : 1.0f;
        const int cl = (colt & 511) + wc * 32 + 8 * fq, d = cl & 63, head0 = cl >> 6;
#pragma unroll
        for (int ai = 0; ai < 2; ++ai)
#pragma unroll
            for (int m = 0; m < 4; ++m) { const int tok = tok0 + ai * HALF + m * 16;
#pragma unroll
                for (int bj = 0; bj < 2; ++bj) { const f32x4 v0 = acc[ai][bj][m][0] * sc, v1 = acc[ai][bj][m][1] * sc;
                    u32x4 w; w.x = cvt_pk_bf16(v0[0], v0[1]); w.y = cvt_pk_bf16(v0[2], v0[3]); w.z = cvt_pk_bf16(v1[0], v1[1]); w.w = cvt_pk_bf16(v1[2], v1[3]);
                    *(u32x4*)(base + (((size_t)b * NH + head0 + 2 * bj) * SEQ + tok) * HD + d) = w; } }
    }
};
struct EpiY {
    static constexpr bool PERM = true;
    bf16_t* O; int ldc;
    __device__ __forceinline__ void operator()(const f32x4 (&acc)[2][2][4][2], const Unit& u, int wr, int wc, int fr, int fq) const {
        const int row0 = u.pm * BM + wr * 64 + fr; const int col0 = u.pn * BM + wc * 32 + 8 * fq;
#pragma unroll
        for (int ai = 0; ai < 2; ++ai)
#pragma unroll
            for (int m = 0; m < 4; ++m) { bf16_t* rowp = O + (size_t)(row0 + ai * HALF + m * 16) * ldc + col0;
#pragma unroll
                for (int bj = 0; bj < 2; ++bj) { const f32x4 v0 = acc[ai][bj][m][0], v1 = acc[ai][bj][m][1];
                    u32x4 w; w.x = cvt_pk_bf16(v0[0], v0[1]); w.y = cvt_pk_bf16(v0[2], v0[3]); w.z = cvt_pk_bf16(v1[0], v1[1]); w.w = cvt_pk_bf16(v1[2], v1[3]);
                    *(u32x4*)(rowp + bj * HALF) = w; } }
    }
};
struct EpiSwiGLU {
    static constexpr bool PERM = true;
    bf16_t* O;
    __device__ __forceinline__ void operator()(const f32x4 (&acc)[2][2][4][2], const Unit& u, int wr, int wc, int fr, int fq) const {
        const int row0 = u.pm * BM + wr * 64 + fr; const int col0 = u.pn * 128 + wc * 16 + 4 * fq;
#pragma unroll
        for (int ai = 0; ai < 2; ++ai)
#pragma unroll
            for (int m = 0; m < 4; ++m) { bf16_t* rowp = O + (size_t)(row0 + ai * HALF + m * 16) * DFF + col0;
#pragma unroll
                for (int bj = 0; bj < 2; ++bj) { const f32x4 ga = acc[ai][bj][m][0], up = acc[ai][bj][m][1]; float hv[4];
#pragma unroll
                    for (int i = 0; i < 4; ++i) hv[i] = ga[i] * __builtin_amdgcn_rcpf(1.0f + __builtin_amdgcn_exp2f(-LOG2E * ga[i])) * up[i];
                    u32x2 w; w.x = cvt_pk_bf16(hv[0], hv[1]); w.y = cvt_pk_bf16(hv[2], hv[3]);
                    *(u32x2*)(rowp + bj * 64) = w; } }
    }
};
struct EpiOutProj {
    static constexpr bool PERM = true;
    const float* x; bf16_t* x1; const float* mod; const LAS float* side;
    __device__ __forceinline__ void operator()(const f32x4 (&acc)[2][2][4][2], const Unit& u, int wr, int wc, int fr, int fq) const {
        const int b = (u.pm * BM) / SEQ; const int col0 = u.pn * BM + wc * 32 + 8 * fq;
        f32x4 gate[2][2];
#pragma unroll
        for (int bj = 0; bj < 2; ++bj)
#pragma unroll
            for (int n = 0; n < 2; ++n) gate[bj][n] = *(const f32x4*)(mod + b * 6144 + 2048 + col0 + bj * HALF + n * 4);
#pragma unroll
        for (int ai = 0; ai < 2; ++ai) {
            f32x4 xv[4][2][2];
#pragma unroll
            for (int m = 0; m < 4; ++m) { const size_t row = (size_t)(u.pm * BM + ai * HALF + wr * 64 + m * 16 + fr);
#pragma unroll
                for (int bj = 0; bj < 2; ++bj) { xv[m][bj][0] = *(const f32x4*)(x + row * D + col0 + bj * HALF); xv[m][bj][1] = *(const f32x4*)(x + row * D + col0 + bj * HALF + 4); } }
#pragma unroll
            for (int m = 0; m < 4; ++m) { const int rl = ai * HALF + wr * 64 + m * 16 + fr; const float rss = side[(size_t)u.li * 512 + 2 * rl + 1];
                const size_t row = (size_t)(u.pm * BM + rl);
#pragma unroll
                for (int bj = 0; bj < 2; ++bj) {
                    const f32x4 r0 = xv[m][bj][0] + gate[bj][0] * (acc[ai][bj][m][0] * rss), r1 = xv[m][bj][1] + gate[bj][1] * (acc[ai][bj][m][1] * rss);
                    u32x4 w; w.x = cvt_pk_bf16(r0[0], r0[1]); w.y = cvt_pk_bf16(r0[2], r0[3]); w.z = cvt_pk_bf16(r1[0], r1[1]); w.w = cvt_pk_bf16(r1[2], r1[3]);
                    *(u32x4*)(x1 + row * (1 * D) + col0 + bj * HALF) = w; } }
            asm volatile("" ::: "memory");
        }
    }
};
}

__device__ __forceinline__ f32x4 ld_bf4(const bf16* p) { const u32x2 w = *(const u32x2*)p; f32x4 r; r.x = __uint_as_float(w.x << 16); r.y = __uint_as_float(w.x & 0xffff0000u); r.z = __uint_as_float(w.y << 16); r.w = __uint_as_float(w.y & 0xffff0000u); return r; }
typedef short v4i16_t __attribute__((ext_vector_type(4)));
__device__ __forceinline__ ptrdiff_t hm_off(int b, int head, ptrdiff_t tok) { return (((ptrdiff_t)b * NH + head) * SEQ + tok) * HD; }
constexpr int VIMG_PITCH = 144, VIMG_BYTES = 8192;
__device__ __forceinline__ int pik(int rho) { return 16 * ((rho >> 2) & 1) + (rho & 3) + 4 * (rho >> 3); }
__device__ __forceinline__ unsigned cvtpk(float lo, float hi) { typedef float f2 __attribute__((ext_vector_type(2))); typedef __bf16 b2 __attribute__((ext_vector_type(2))); f2 v = {lo, hi}; b2 b = __builtin_convertvector(v, b2); return __builtin_bit_cast(unsigned, b); }
__device__ __forceinline__ bf16x8 pack8(const f32x16& p, int s) {
    u32x4 w; w.x = cvtpk(p[8 * s + 0], p[8 * s + 1]); w.y = cvtpk(p[8 * s + 2], p[8 * s + 3]); w.z = cvtpk(p[8 * s + 4], p[8 * s + 5]); w.w = cvtpk(p[8 * s + 6], p[8 * s + 7]);
    return __builtin_bit_cast(bf16x8, w);
}
__device__ __forceinline__ void load_kf(bf16x8 (&kf)[4], const bf16* rowp) {
#pragma unroll
    for (int d0 = 0; d0 < 4; ++d0) kf[d0] = *(const bf16x8*)(rowp + 16 * d0);
}
__device__ __forceinline__ void pv_block(f32x16 (&o)[2], const u32x4 (&vr)[4], const f32x16& p, LAS unsigned char* img, int lane) {
    const int h = lane >> 5;
#pragma unroll
    for (int i = 0; i < 4; ++i) *(LAS u32x4*)(img + ((lane >> 3) + 8 * i) * VIMG_PITCH + (lane & 7) * 16) = vr[i];
    const LAS unsigned char* vb = img + (16 * h + ((lane & 15) >> 2)) * VIMG_PITCH + (16 * ((lane >> 4) & 1) + 4 * (lane & 3)) * 2;
#pragma unroll
    for (int s = 0; s < 2; ++s) { const bf16x8 pf = pack8(p, s);
#pragma unroll
        for (int db = 0; db < 2; ++db) {
            const v4i16_t lo = __builtin_amdgcn_ds_read_tr16_b64_v4i16((LAS v4i16_t*)(vb + s * 8 * VIMG_PITCH + db * 64));
            const v4i16_t hi = __builtin_amdgcn_ds_read_tr16_b64_v4i16((LAS v4i16_t*)(vb + s * 8 * VIMG_PITCH + 4 * VIMG_PITCH + db * 64));
            const bf16x8 vf = (bf16x8){lo[0], lo[1], lo[2], lo[3], hi[0], hi[1], hi[2], hi[3]};
            o[db] = MFMA32(vf, pf, o[db]);
        } }
}
__device__ __forceinline__ float xhalf_max(float v) { return fmaxf(v, __shfl_xor(v, 32)); }
__device__ __forceinline__ float xhalf_sum(float v) { return v + __shfl_xor(v, 32); }

__device__ __forceinline__ float store_ot(bf16* dst, const f32x16 (&o)[2], float sc, int h) {
    float s = 0.f;
#pragma unroll
    for (int db = 0; db < 2; ++db)
#pragma unroll
        for (int gp = 0; gp < 2; ++gp) { u32x4 w; float v[8];
#pragma unroll
            for (int k = 0; k < 8; ++k) { v[k] = o[db][8 * gp + k] * sc; s += v[k] * v[k]; }
            w.x = cvtpk(v[0], v[1]); w.y = cvtpk(v[2], v[3]); w.z = cvtpk(v[4], v[5]); w.w = cvtpk(v[6], v[7]);
            *(u32x4*)(dst + 32 * h + 16 * db + 8 * gp) = w; }
    return s;
}
constexpr int STG_K = 0, STG_V = 49152, STG_BYTES = 98304;
template <int DIL>
__device__ __forceinline__ void stage_kv(const bf16* Kg, const bf16* Vg, LAS unsigned char* lds, size_t blk0_elem  ,
                                         int first_valid_bi, int wave, int lane) {
    constexpr unsigned RS = DIL * HD * 2;
    const int j = wave & 3, slot = 8 * j + (lane >> 3), x = lane & 7;
    const unsigned goK = (unsigned)pik(slot) * RS + (unsigned)((x ^ ((slot >> 1) & 7)) * 16);
    const unsigned goV = (unsigned)slot * RS + (unsigned)((x ^ (((slot >> 1) & 1) << 2)) * 16);
#pragma unroll
    for (int t = 0; t < 6; ++t) {
        const int bi = (wave >> 2) + 2 * t;
        if (bi >= first_valid_bi) {
            const char* kb_ = (const char*)(Kg + blk0_elem) + (size_t)bi * (32 * RS);
            const char* vb_ = (const char*)(Vg + blk0_elem) + (size_t)bi * (32 * RS);
            __builtin_amdgcn_global_load_lds((const unsigned*)(kb_ + goK), (LAS unsigned*)(lds + STG_K + bi * 4096 + j * 1024), 16, 0, 0);
            __builtin_amdgcn_global_load_lds((const unsigned*)(vb_ + goV), (LAS unsigned*)(lds + STG_V + bi * 4096 + j * 1024), 16, 0, 0);
        }
    }
}
struct FragOff { int kd[4]; int vo[2]; };
__device__ __forceinline__ FragOff frag_offsets(int lane) {
    FragOff f; const int r = lane & 31, h = lane >> 5, s = (r >> 1) & 7;
#pragma unroll
    for (int d0 = 0; d0 < 4; ++d0) f.kd[d0] = r * 128 + (((2 * d0 + h) ^ s) << 4);
    const int q = (lane & 15) >> 2, p = lane & 3, g1 = (lane >> 4) & 1, qs = q >> 1, cgp = 2 * g1 + (p >> 1);
#pragma unroll
    for (int db = 0; db < 2; ++db) f.vo[db] = (16 * h + q) * 128 + (p & 1) * 8 + ((4 * (db ^ qs) + cgp) << 4);
    return f;
}
__device__ __forceinline__ void pv_block_lds(f32x16 (&o)[2], const f32x16& p, const LAS unsigned char* vimg  , const FragOff& fo) {
#pragma unroll
    for (int s = 0; s < 2; ++s) { const bf16x8 pf = pack8(p, s);
#pragma unroll
        for (int db = 0; db < 2; ++db) {
            const v4i16_t lo = __builtin_amdgcn_ds_read_tr16_b64_v4i16((LAS v4i16_t*)(vimg + fo.vo[db] + s * 1024));
            const v4i16_t hi = __builtin_amdgcn_ds_read_tr16_b64_v4i16((LAS v4i16_t*)(vimg + fo.vo[db] + s * 1024 + 512));
            const bf16x8 vf = (bf16x8){lo[0], lo[1], lo[2], lo[3], hi[0], hi[1], hi[2], hi[3]};
            o[db] = MFMA32(vf, pf, o[db]);
        } }
}
__device__ __forceinline__ void pv_block_lds_pk(f32x16 (&o)[2], const u32x4 (&pk)[2], const LAS unsigned char* vimg, const FragOff& fo) {
#pragma unroll
    for (int s = 0; s < 2; ++s) { const bf16x8 pf = __builtin_bit_cast(bf16x8, pk[s]);
#pragma unroll
        for (int db = 0; db < 2; ++db) {
            const v4i16_t lo = __builtin_amdgcn_ds_read_tr16_b64_v4i16((LAS v4i16_t*)(vimg + fo.vo[db] + s * 1024));
            const v4i16_t hi = __builtin_amdgcn_ds_read_tr16_b64_v4i16((LAS v4i16_t*)(vimg + fo.vo[db] + s * 1024 + 512));
            const bf16x8 vf = (bf16x8){lo[0], lo[1], lo[2], lo[3], hi[0], hi[1], hi[2], hi[3]};
            o[db] = MFMA32(vf, pf, o[db]);
        } }
}
template <int DIL>
__device__ __forceinline__ void dil_wave_lds(const bf16x8 (&qf)[4], const LAS unsigned char* lds, const FragOff& fo, int lane, int wave, int head, int nblk, f32x16 (&o)[2], float& m_out, float& l_out) {
    const int r = lane & 31, h = lane >> 5;
    const float slope2d = exp2f(-(float)(head + 1)) * LOG2E * (float)DIL;
#pragma unroll
    for (int db = 0; db < 2; ++db)
#pragma unroll
        for (int ii = 0; ii < 16; ++ii) o[db][ii] = 0.f;
    float m = -INFINITY, l = 0.f;
    for (int it = 0; it < nblk; ++it) {
        const int bi = wave + 4 - it;
        const LAS unsigned char* kimg = lds + STG_K + bi * 4096;
        f32x16 acc;
#pragma unroll
        for (int ii = 0; ii < 16; ++ii) acc[ii] = 0.f;
#pragma unroll
        for (int d0 = 0; d0 < 4; ++d0) { const bf16x8 kf = *(const LAS bf16x8*)(kimg + fo.kd[d0]); acc = MFMA32(kf, qf[d0], acc); }
        const int dbase = 32 * it + r - 16 * h;
        float bm = -INFINITY;
#pragma unroll
        for (int ii = 0; ii < 16; ++ii) { const int dist = dbase - ii; const bool valid = (dist >= 0) && (dist <= 128);
            acc[ii] = valid ? (acc[ii] - slope2d * (float)dist) : -INFINITY; bm = fmaxf(bm, acc[ii]); }
        if (__any(bm > m + 8.0f)) {
            const float mn = xhalf_max(fmaxf(bm, m)); const float f = __builtin_amdgcn_exp2f(m - mn);
            l *= f;
#pragma unroll
            for (int db = 0; db < 2; ++db)
#pragma unroll
                for (int ii = 0; ii < 16; ++ii) o[db][ii] *= f;
            m = mn;
        }
#pragma unroll
        for (int ii = 0; ii < 16; ++ii) { acc[ii] = __builtin_amdgcn_exp2f(acc[ii] - m); l += acc[ii]; }
        pv_block_lds(o, acc, lds + STG_V + bi * 4096, fo);
    }
    m_out = m; l_out = xhalf_sum(l);
}
struct MixPre { u32x4 p1[4], p2[4]; f32x4 ml; };
template <int DIL>
__device__ __forceinline__ void dil_unit_wg(Frame& F, const bf16* QD, const bf16* KD, const bf16* VD, const FragOff& fo, int b, int head, int cls, int g, f32x16 (&o)[2], float& m_, float& l_,
                                            const bf16* P1 = nullptr, const bf16* P2 = nullptr, const float* ML1 = nullptr, const float* ML2 = nullptr, MixPre* pre = nullptr) {
    const int lane = F.lane, r = lane & 31, h = lane >> 5, wave = F.wave;
    const int I0 = 256 * g;
    const ptrdiff_t blk0 = hm_off(b, head, ((ptrdiff_t)I0 - 128) * DIL + cls);
    asm volatile("s_waitcnt lgkmcnt(0)\n\ts_barrier" ::: "memory");
    stage_kv<DIL>(KD, VD, F.lds, (size_t)blk0, (g == 0) ? 4 : 0, wave, lane);
    bf16x8 qf[4];
    { const bf16* qp = QD + hm_off(b, head, (ptrdiff_t)(I0 + 32 * wave + r) * DIL + cls) + 8 * h;
#pragma unroll
      for (int d0 = 0; d0 < 4; ++d0) qf[d0] = *(const bf16x8*)(qp + 16 * d0); }
    if (pre) { const ptrdiff_t tq = (ptrdiff_t)(I0 + 32 * wave + r) * DIL + cls; const size_t tok = (size_t)(((ptrdiff_t)b * NH + head) * SEQ + tq);
        const bf16* p1 = P1 + hm_off(b, head, tq) + 32 * h; const bf16* p2 = P2 + hm_off(b, head, tq) + 32 * h;
#pragma unroll
        for (int i = 0; i < 4; ++i) { pre->p1[i] = *(const u32x4*)(p1 + 8 * i); pre->p2[i] = *(const u32x4*)(p2 + 8 * i); }
        pre->ml.x = ML1[tok * 2]; pre->ml.y = ML1[tok * 2 + 1]; pre->ml.z = ML2[tok * 2]; pre->ml.w = ML2[tok * 2 + 1]; }
    asm volatile("s_waitcnt vmcnt(0)\n\ts_barrier" ::: "memory");
    const int i0 = I0 + 32 * wave; const int nblk = (i0 >= 128) ? 5 : (1 + (i0 >> 5));
    if (PROBE_PHASE == 34) { __syncthreads(); stage_kv<DIL>(KD, VD, F.lds, (size_t)blk0, (g == 0) ? 4 : 0, wave, lane); asm volatile("s_waitcnt vmcnt(0)" ::: "memory"); __syncthreads(); }
    if (PROBE_PHASE == 33) { dil_wave_lds<DIL>(qf, F.lds, fo, lane, wave, head, nblk, o, m_, l_); asm volatile("" : "+v"(m_), "+v"(l_)); }
    dil_wave_lds<DIL>(qf, F.lds, fo, lane, wave, head, nblk, o, m_, l_);
}
__device__ __forceinline__ void sb_unit_wg(Frame& F, const bf16* QS, const bf16* KS, const bf16* VS, const FragOff& fo, int b, int head, int g, bool dry) {
    const int lane = F.lane, r = lane & 31, h = lane >> 5, wave = F.wave;
    const int T0 = 256 * g, t0 = T0 + 32 * wave;
    const size_t rowbase = (size_t)b * SEQ;
    const ptrdiff_t blk0 = hm_off(b, head, (ptrdiff_t)T0 - 128);
    asm volatile("s_waitcnt lgkmcnt(0)\n\ts_barrier" ::: "memory");
    stage_kv<1>(KS, VS, F.lds, (size_t)blk0, (g == 0) ? 4 : 0, wave, lane);
    bf16x8 qf[4];
    { const bf16* qp = QS + hm_off(b, head, t0 + r) + 8 * h;
#pragma unroll
      for (int d0 = 0; d0 < 4; ++d0) qf[d0] = *(const bf16x8*)(qp + 16 * d0); }
    asm volatile("s_waitcnt vmcnt(0)\n\ts_barrier" ::: "memory");
    f32x16 o[2];
#pragma unroll
    for (int db = 0; db < 2; ++db)
#pragma unroll
        for (int ii = 0; ii < 16; ++ii) o[db][ii] = 0.f;
    float R = 1.0f; bool done = false;
    const int bi_lo = (g == 0) ? 4 : 0;
    for (int bi = wave + 4; bi >= bi_lo; --bi) {
        const LAS unsigned char* kimg = F.lds + STG_K + bi * 4096;
        f32x16 acc;
#pragma unroll
        for (int ii = 0; ii < 16; ++ii) acc[ii] = 0.f;
#pragma unroll
        for (int d0 = 0; d0 < 4; ++d0) { const bf16x8 kf = *(const LAS bf16x8*)(kimg + fo.kd[d0]); acc = MFMA32(kf, qf[d0], acc); }
        const bool diag = (bi == wave + 4);
        float cc[16]; float T = 1.0f;
#pragma unroll
        for (int ii = 0; ii < 16; ++ii) { float x = fminf(acc[ii], 100.0f); if (diag && (16 * h + ii >= r)) x = -INFINITY;
            const float e = __builtin_amdgcn_exp2f(x); const float c_ = __builtin_amdgcn_rcpf(1.0f + e); cc[ii] = c_; acc[ii] = e * c_; T *= c_; }
        const float Tp = __shfl_xor(T, 32);
        float E = h ? R : R * Tp;
#pragma unroll
        for (int ii = 15; ii >= 0; --ii) { acc[ii] = acc[ii] * E; E *= cc[ii]; }
        R = R * T * Tp;
        pv_block_lds(o, acc, F.lds + STG_V + bi * 4096, fo);
        if (__all(R < SB_STOP)) { done = true; break; }
    }
    if (!done && T0 - 128 - 32 >= 0) {
        LAS unsigned char* img = F.lds + STG_BYTES + wave * 5120;
        const bf16* Kl = KS + hm_off(b, head, pik(r)) + 8 * h;
        const bf16* Vl = VS + hm_off(b, head, lane >> 3) + 8 * (lane & 7);
        for (int kb = T0 - 160; kb >= 0; kb -= 32) {
            bf16x8 kf[4]; u32x4 vr[4];
            load_kf(kf, Kl + (size_t)kb * HD);
#pragma unroll
            for (int i = 0; i < 4; ++i) vr[i] = *(const u32x4*)(Vl + (size_t)(kb + 8 * i) * HD);
            f32x16 acc;
#pragma unroll
            for (int ii = 0; ii < 16; ++ii) acc[ii] = 0.f;
#pragma unroll
            for (int d0 = 0; d0 < 4; ++d0) acc = MFMA32(kf[d0], qf[d0], acc);
            float cc[16]; float T = 1.0f;
#pragma unroll
            for (int ii = 0; ii < 16; ++ii) { const float x = fminf(acc[ii], 100.0f);
                const float e = __builtin_amdgcn_exp2f(x); const float c_ = __builtin_amdgcn_rcpf(1.0f + e); cc[ii] = c_; acc[ii] = e * c_; T *= c_; }
            const float Tp = __shfl_xor(T, 32);
            float E = h ? R : R * Tp;
#pragma unroll
            for (int ii = 15; ii >= 0; --ii) { acc[ii] = acc[ii] * E; E *= cc[ii]; }
            R = R * T * Tp;
            pv_block(o, vr, acc, img, lane);
            if (__all(R < SB_STOP)) break;
        }
    }
    const size_t m = rowbase + t0 + r;
    float s = store_ot(F.OB + m * D + DH + head * HD, o, 1.0f, h);
    s = xhalf_sum(s);
    if (h == 0) F.ssq[m * 16 + 8 + head] = s;
}
struct DilUnit { int dil, b, head, cls, g; };
__device__ __forceinline__ bool dil_get_unit(int mode, int xc, int jx, int idx, DilUnit& u) {
    if (mode == 0) { if (idx >= 16) return false; const int bh = xc * 8 + (idx >> 1); u.b = bh >> 3; u.head = bh & 7;
        if ((idx & 1) == 0) { u.dil = 16; u.cls = jx >> 1; u.g = jx & 1; } else { u.dil = 4; u.cls = jx >> 3; u.g = jx & 7; } return true; }
    if (idx >= 8) return false; const int bh = xc * 8 + (7 - idx); u.b = bh >> 3; u.head = bh & 7; u.dil = 1; u.cls = 0; u.g = jx; return true;
}
__device__ __forceinline__ void glds16_asm(const void* gsrc, unsigned lds_dst) { unsigned keep;
    asm volatile("s_mov_b32 %0, m0\n\ts_mov_b32 m0, %2\n\ts_nop 0\n\tglobal_load_lds_dwordx4 %1, off\n\ts_mov_b32 m0, %0" : "=&s"(keep) : "v"(gsrc), "s"(lds_dst) : "memory"); }
template <bool ISK>
__device__ __forceinline__ void stage_half_any(const bf16* Xg, LAS unsigned char* region, const DilUnit& u, int wave, int lane_) {
    int lane = lane_; asm volatile("" : "+v"(lane));
    const unsigned RS = (unsigned)u.dil * (HD * 2);
    const int j = wave & 3, slot = 8 * j + (lane >> 3), x = lane & 7;
    const unsigned go = ISK ? ((unsigned)pik(slot) * RS + (unsigned)((x ^ ((slot >> 1) & 7)) * 16)) : ((unsigned)slot * RS + (unsigned)((x ^ (((slot >> 1) & 1) << 2)) * 16));
    const ptrdiff_t blk0 = hm_off(u.b, u.head, ((ptrdiff_t)256 * u.g - 128) * u.dil + u.cls);
    const int fv = (u.g == 0) ? 4 : 0;
    const char* base = (const char*)(Xg + blk0);
#pragma unroll
    for (int t = 0; t < 6; ++t) {
        const int bi = (wave >> 2) + 2 * t, bs = bi < fv ? fv : bi;
        const char* p = base + (ptrdiff_t)bs * (ptrdiff_t)(32u * RS);
        glds16_asm(p + go, (unsigned)__builtin_amdgcn_readfirstlane((int)(unsigned)(size_t)(region + bi * 4096 + j * 1024)));
    }
}
__device__ __forceinline__ void dil_pipeline(Frame& F, int mode, bool dry) {
    const bf16* QD = F.QKV; const bf16* KD = F.QKV + (size_t)M * DH; const bf16* VD = F.QKV + (size_t)2 * M * DH;
    bf16* P1 = (bf16*)(F.ws + WS_PART); bf16* P2 = P1 + (size_t)M * DH;
    float* ML1 = (float*)(F.ws + WS_PART + (size_t)2 * M * DH * 2); float* ML2 = ML1 + (size_t)2 * M * NH;
    const int lane = F.lane, r = lane & 31, h = lane >> 5, wave = F.wave;
    const FragOff fo = frag_offsets(lane);
    const int xc = F.vcu >> 5, jx = F.vcu & 31;
    constexpr int REG = 49152;
    DilUnit cur, nxt, prv; cur.dil = 1; cur.b = cur.head = cur.cls = cur.g = 0; nxt = cur; prv = cur;
    (void)dil_get_unit(mode, xc, jx, 0, cur);
    asm volatile("s_waitcnt vmcnt(0) lgkmcnt(0)\n\ts_barrier" ::: "memory");
    bf16x8 qf[4];
    stage_half_any<true>(KD, F.lds, cur, wave, lane);
    { const bf16* qp = QD + hm_off(cur.b, cur.head, (ptrdiff_t)(256 * cur.g + 32 * wave + r) * cur.dil + cur.cls) + 8 * h;
#pragma unroll
      for (int d0 = 0; d0 < 4; ++d0) qf[d0] = *(const bf16x8*)(qp + 16 * d0); }
    stage_half_any<false>(VD, F.lds + REG, cur, wave, lane);
    f32x16 o[2]; float m_prev = 0.f, l_prev = 1.f; bool have_prev = false;
#pragma unroll
    for (int db = 0; db < 2; ++db)
#pragma unroll
        for (int ii = 0; ii < 16; ++ii) o[db][ii] = 0.f;
    const int nunits = mode ? 8 : 16;
    int rk = 0;
    for (int u = 0; u < nunits; ++u) {
        const bool has_next = dil_get_unit(mode, xc, jx, u + 1, nxt);
        if (has_next || u == 0) asm volatile("s_waitcnt vmcnt(6)" ::: "memory"); else asm volatile("s_waitcnt vmcnt(0)" ::: "memory");
        asm volatile("s_waitcnt lgkmcnt(0)\n\ts_barrier" ::: "memory");
        asm volatile("" :: "v"(qf[0]), "v"(qf[1]), "v"(qf[2]), "v"(qf[3]));
        if (have_prev) {
            const ptrdiff_t tq = (ptrdiff_t)(256 * prv.g + 32 * wave + r) * prv.dil + prv.cls; const size_t tok = (size_t)prv.b * SEQ + (size_t)tq; const size_t hrow = (size_t)(((ptrdiff_t)prv.b * NH + prv.head) * SEQ + tq);
            if (mode == 0) { bf16* P = (prv.dil == 16) ? P1 : P2; float* ML = (prv.dil == 16) ? ML1 : ML2;
                (void)store_ot(P + hrow * HD, o, 1.0f / l_prev, h);
                if (h == 0) { ML[hrow * 2] = m_prev; ML[hrow * 2 + 1] = l_prev; }
            } else { float s = store_ot(F.OB + tok * D + prv.head * HD, o, 1.0f, h); s = xhalf_sum(s); if (h == 0) F.ssq[tok * 16 + prv.head] = s; }
        }
        MixPre pre;
        if (mode == 1) { const size_t tok = (size_t)(((ptrdiff_t)cur.b * NH + cur.head) * SEQ + (ptrdiff_t)(256 * cur.g + 32 * wave + r) * cur.dil + cur.cls);
            const bf16* p1 = P1 + tok * HD + 32 * h; const bf16* p2 = P2 + tok * HD + 32 * h;
#pragma unroll
            for (int i = 0; i < 4; ++i) { pre.p1[i] = *(const u32x4*)(p1 + 8 * i); pre.p2[i] = *(const u32x4*)(p2 + 8 * i); }
            pre.ml.x = ML1[tok * 2]; pre.ml.y = ML1[tok * 2 + 1]; pre.ml.z = ML2[tok * 2]; pre.ml.w = ML2[tok * 2 + 1]; }
        const int r2 = (rk + 2 >= 3) ? rk - 1 : rk + 2;
        bf16x8 qn[4];
        if (has_next) { const bf16* qp = QD + hm_off(nxt.b, nxt.head, (ptrdiff_t)(256 * nxt.g + 32 * wave + r) * nxt.dil + nxt.cls) + 8 * h;
#pragma unroll
            for (int d0 = 0; d0 < 4; ++d0) qn[d0] = *(const bf16x8*)(qp + 16 * d0); }
        if (has_next) stage_half_any<true>(KD, F.lds + r2 * REG, nxt, wave, lane);
        const int i0 = 256 * cur.g + 32 * wave; const int nblk = (i0 >= 128) ? 5 : (1 + (i0 >> 5));
        const float slope2d = exp2f(-(float)(cur.head + 1)) * LOG2E * (float)cur.dil;
        const LAS unsigned char* kreg = F.lds + rk * REG;
        u32x4 pk[5][2]; float mref[5]; float mrun = -INFINITY, l = 0.f;
        typedef float f32x2 __attribute__((ext_vector_type(2)));
        f32x2 sl2[8];
#pragma unroll
        for (int k = 0; k < 8; ++k) sl2[k] = (f32x2){slope2d * (float)(2 * k), slope2d * (float)(2 * k + 1)};
#pragma unroll
        for (int it = 0; it < 5; ++it) {
            if (it < nblk) {
                const LAS unsigned char* kimg = kreg + (wave + 4 - it) * 4096;
                const int dbase = 32 * it + r - 16 * h;
                const float c0 = (it == 0) ? (-slope2d * (float)dbase) : (-slope2d * (float)dbase - mrun);
                f32x16 acc;
#pragma unroll
                for (int k = 0; k < 8; ++k) { const f32x2 ci = sl2[k] + (f32x2){c0, c0}; acc[2 * k] = ci.x; acc[2 * k + 1] = ci.y; }
#pragma unroll
                for (int d0 = 0; d0 < 4; ++d0) { const bf16x8 kf = *(const LAS bf16x8*)(kimg + fo.kd[d0]); acc = MFMA32(kf, qf[d0], acc); }
                float bm = -INFINITY;
#pragma unroll
                for (int ii = 0; ii < 16; ++ii) { if (it == 0) { if (ii > dbase) acc[ii] = -INFINITY; } else if (it == 4) { if (ii < dbase - 128) acc[ii] = -INFINITY; }
                    bm = fmaxf(bm, acc[ii]); }
                { auto rr = __builtin_amdgcn_permlane32_swap(__float_as_uint(bm), __float_as_uint(bm), false, false); bm = fmaxf(__uint_as_float(rr[0]), __uint_as_float(rr[1])); }
                if (it == 0) {
                    mrun = bm;
#pragma unroll
                    for (int k = 0; k < 8; ++k) { const f32x2 v = (f32x2){acc[2 * k], acc[2 * k + 1]} - (f32x2){bm, bm}; acc[2 * k] = v.x; acc[2 * k + 1] = v.y; }
                } else if (__any(bm > 8.0f)) {
                    const float dlt = fmaxf(bm, 0.f);
#pragma unroll
                    for (int k = 0; k < 8; ++k) { const f32x2 v = (f32x2){acc[2 * k], acc[2 * k + 1]} - (f32x2){dlt, dlt}; acc[2 * k] = v.x; acc[2 * k + 1] = v.y; }
                    mrun += dlt; l *= __builtin_amdgcn_exp2f(-dlt);
                }
                mref[it] = mrun;
                f32x2 ls2 = {0.f, 0.f};
#pragma unroll
                for (int k = 0; k < 8; ++k) { acc[2 * k] = __builtin_amdgcn_exp2f(acc[2 * k]); acc[2 * k + 1] = __builtin_amdgcn_exp2f(acc[2 * k + 1]); ls2 += (f32x2){acc[2 * k], acc[2 * k + 1]}; }
                l += ls2.x + ls2.y;
#pragma unroll
                for (int s = 0; s < 2; ++s) { pk[it][s].x = cvtpk(acc[8 * s + 0], acc[8 * s + 1]); pk[it][s].y = cvtpk(acc[8 * s + 2], acc[8 * s + 3]);
                    pk[it][s].z = cvtpk(acc[8 * s + 4], acc[8 * s + 5]); pk[it][s].w = cvtpk(acc[8 * s + 6], acc[8 * s + 7]); }
            } else { mref[it] = mrun; pk[it][0] = (u32x4){0u, 0u, 0u, 0u}; pk[it][1] = (u32x4){0u, 0u, 0u, 0u}; }
        }
        const float m = mrun;
        l = xhalf_sum(l);
        if (has_next) asm volatile("s_waitcnt vmcnt(6)" ::: "memory"); else asm volatile("s_waitcnt vmcnt(0)" ::: "memory");
        asm volatile("s_waitcnt lgkmcnt(0)\n\ts_barrier" ::: "memory");
        if (has_next) {
#pragma unroll
            for (int d0 = 0; d0 < 4; ++d0) qf[d0] = qn[d0]; }
        asm volatile("" :: "v"(qf[0]), "v"(qf[1]), "v"(qf[2]), "v"(qf[3]));
        if (has_next) stage_half_any<false>(VD, F.lds + rk * REG, nxt, wave, lane);

        const int rv = (rk + 1 >= 3) ? 0 : rk + 1;
        const LAS unsigned char* vreg = F.lds + rv * REG;
#pragma unroll
        for (int db = 0; db < 2; ++db)
#pragma unroll
            for (int ii = 0; ii < 16; ++ii) o[db][ii] = 0.f;
#pragma unroll
        for (int it = 0; it < 5; ++it) {
            if (it < nblk) {
                if (it > 0) { const float f = __builtin_amdgcn_exp2f(mref[it - 1] - mref[it]);
                    if (__any(f != 1.0f)) {
#pragma unroll
                        for (int db = 0; db < 2; ++db)
#pragma unroll
                            for (int ii = 0; ii < 16; ++ii) o[db][ii] *= f; } }
                pv_block_lds_pk(o, pk[it], vreg + (wave + 4 - it) * 4096, fo);
            }
        }
        if (mode == 1) {
            const float m1 = pre.ml.x, l1 = pre.ml.y, m2 = pre.ml.z, l2 = pre.ml.w;
            const float mm = fmaxf(fmaxf(m1, m2), m);
            const float w1 = l1 * exp2f(m1 - mm), w2 = l2 * exp2f(m2 - mm), e3 = exp2f(m - mm);
            const float inv = 1.0f / (w1 + w2 + l * e3);
            const float a1 = w1 * inv, a2 = w2 * inv, a3 = e3 * inv;
#pragma unroll
            for (int db = 0; db < 2; ++db)
#pragma unroll
                for (int gp = 0; gp < 2; ++gp) { const u32x4 w1_ = pre.p1[2 * db + gp], w2_ = pre.p2[2 * db + gp];
#pragma unroll
                    for (int k = 0; k < 4; ++k) { const unsigned a_ = w1_[k], b_ = w2_[k];
                        o[db][8 * gp + 2 * k] = a3 * o[db][8 * gp + 2 * k] + a1 * __uint_as_float(a_ << 16) + a2 * __uint_as_float(b_ << 16);
                        o[db][8 * gp + 2 * k + 1] = a3 * o[db][8 * gp + 2 * k + 1] + a1 * __uint_as_float(a_ & 0xffff0000u) + a2 * __uint_as_float(b_ & 0xffff0000u); } }
        }
        m_prev = m; l_prev = l; prv = cur; cur = nxt; have_prev = true;
        rk = r2;
    }
    { const ptrdiff_t tq = (ptrdiff_t)(256 * prv.g + 32 * wave + r) * prv.dil + prv.cls; const size_t tok = (size_t)prv.b * SEQ + (size_t)tq; const size_t hrow = (size_t)(((ptrdiff_t)prv.b * NH + prv.head) * SEQ + tq);
      if (mode == 0) { bf16* P = (prv.dil == 16) ? P1 : P2; float* ML = (prv.dil == 16) ? ML1 : ML2;
          (void)store_ot(P + hrow * HD, o, 1.0f / l_prev, h);
          if (h == 0) { ML[hrow * 2] = m_prev; ML[hrow * 2 + 1] = l_prev; }
      } else { float s = store_ot(F.OB + tok * D + prv.head * HD, o, 1.0f, h); s = xhalf_sum(s); if (h == 0) F.ssq[tok * 16 + prv.head] = s; } }
    asm volatile("s_waitcnt lgkmcnt(0)\n\ts_barrier" ::: "memory");
}
__device__ __forceinline__ void phase_attn_a(Frame& F, bool dry, bool skip_sb = false) {
    const bf16* QD = F.QKV; const bf16* KD = F.QKV + (size_t)M * DH; const bf16* VD = F.QKV + (size_t)2 * M * DH;
    const bf16* QS = F.QKV + (size_t)3 * M * DH; const bf16* KS = F.QKV + (size_t)4 * M * DH; const bf16* VS = F.QKV + (size_t)5 * M * DH;
    bf16* P1 = (bf16*)(F.ws + WS_PART); bf16* P2 = P1 + (size_t)M * DH;
    float* ML1 = (float*)(F.ws + WS_PART + (size_t)2 * M * DH * 2); float* ML2 = ML1 + (size_t)2 * M * NH;
    const int lane = F.lane, r = lane & 31, h = lane >> 5;
    const FragOff fo = frag_offsets(lane);
    const int nx = (F.G % 32 == 0) ? F.G / 32 : 1, wpx = F.G / nx, xc = F.vcu / wpx, jx = F.vcu % wpx;
    const int bh_per_x = 64 / ((nx <= 64 && 64 % nx == 0) ? nx : 1), nxe = 64 / bh_per_x;
    const bool piped = (DIL_PIPE != 0) && (F.G == 256);
    for (int k = 0; xc < nxe && k < bh_per_x * 3; ++k) {
      if (piped && (k % 3) != 2) continue;
      for (int rem = (k % 3) * 32 + jx; rem < (k % 3) * 32 + 32; rem += wpx) {
        const int bh = xc * bh_per_x + k / 3, b = bh >> 3, head = bh & 7;
        if (rem < 32) {
            f32x16 o[2]; float m_, l_;
            const int cls3 = rem >> 1, g3 = rem & 1;
            dil_unit_wg<16>(F, QD, KD, VD, fo, b, head, cls3, g3, o, m_, l_);
            const size_t tok = (size_t)(((ptrdiff_t)b * NH + head) * SEQ + (ptrdiff_t)(256 * g3 + 32 * F.wave + r) * 16 + cls3);
            (void)store_ot(P1 + tok * HD, o, 1.0f / l_, h);
            if (h == 0) { ML1[tok * 2] = m_; ML1[tok * 2 + 1] = l_; }
        } else if (rem < 64) {
            const int cls = (rem - 32) >> 3, g = (rem - 32) & 7;
            f32x16 o[2]; float m_, l_;
            dil_unit_wg<4>(F, QD, KD, VD, fo, b, head, cls, g, o, m_, l_);
            const size_t tok = (size_t)(((ptrdiff_t)b * NH + head) * SEQ + (ptrdiff_t)(256 * g + 32 * F.wave + r) * 4 + cls);
            (void)store_ot(P2 + tok * HD, o, 1.0f / l_, h);
            if (h == 0) { ML2[tok * 2] = m_; ML2[tok * 2 + 1] = l_; }
        } else if (!skip_sb) {
            if (PROBE_PHASE == 35) sb_unit_wg(F, QS, KS, VS, fo, b, head, rem - 64, true);
            sb_unit_wg(F, QS, KS, VS, fo, b, head, rem - 64, dry);
        }
      }
    }
    __syncthreads();
    if (piped) dil_pipeline(F, 0, dry);
}
__device__ __forceinline__ void phase_attn_b(Frame& F, bool dry) {
    const bf16* QD = F.QKV; const bf16* KD = F.QKV + (size_t)M * DH; const bf16* VD = F.QKV + (size_t)2 * M * DH;
    const bf16* P1 = (const bf16*)(F.ws + WS_PART); const bf16* P2 = P1 + (size_t)M * DH;
    const float* ML1 = (const float*)(F.ws + WS_PART + (size_t)2 * M * DH * 2); const float* ML2 = ML1 + (size_t)2 * M * NH;
    const int lane = F.lane, r = lane & 31, h = lane >> 5;
    const FragOff fo = frag_offsets(lane);
    const int nx = (F.G % 32 == 0) ? F.G / 32 : 1, wpx = F.G / nx, xc = F.vcu / wpx, jx = F.vcu % wpx;
    const int bh_per_x = 64 / ((nx <= 64 && 64 % nx == 0) ? nx : 1), nxe = 64 / bh_per_x;
    if ((DIL_PIPE != 0) && (F.G == 256)) { dil_pipeline(F, 1, dry); return; }
    for (int k = 0; xc < nxe && k < bh_per_x; ++k) {
      for (int rem = jx; rem < 32; rem += wpx) {
        const int bh = xc * bh_per_x + k, b = bh >> 3, head = bh & 7;
        f32x16 o[2]; float m3, l3;
        MixPre pre;
        dil_unit_wg<1>(F, QD, KD, VD, fo, b, head, 0, rem, o, m3, l3, P1, P2, ML1, ML2, &pre);
        const size_t tok = (size_t)b * SEQ + (size_t)(256 * rem + 32 * F.wave + r);
        const float m1 = pre.ml.x, l1 = pre.ml.y, m2 = pre.ml.z, l2 = pre.ml.w;
        const float mm = fmaxf(fmaxf(m1, m2), m3);
        const float w1 = l1 * exp2f(m1 - mm), w2 = l2 * exp2f(m2 - mm), e3 = exp2f(m3 - mm);
        const float inv = 1.0f / (w1 + w2 + l3 * e3);
        const float a1 = w1 * inv, a2 = w2 * inv, a3 = e3 * inv;
#pragma unroll
        for (int db = 0; db < 2; ++db)
#pragma unroll
            for (int gp = 0; gp < 2; ++gp) { const u32x4 w1_ = pre.p1[2 * db + gp], w2_ = pre.p2[2 * db + gp];
#pragma unroll
                for (int k = 0; k < 4; ++k) { const unsigned a_ = w1_[k], b_ = w2_[k];
                    o[db][8 * gp + 2 * k] = a3 * o[db][8 * gp + 2 * k] + a1 * __uint_as_float(a_ << 16) + a2 * __uint_as_float(b_ << 16);
                    o[db][8 * gp + 2 * k + 1] = a3 * o[db][8 * gp + 2 * k + 1] + a1 * __uint_as_float(a_ & 0xffff0000u) + a2 * __uint_as_float(b_ & 0xffff0000u); } }
        float s = store_ot(F.OB + tok * D + head * HD, o, 1.0f, h);
        s = xhalf_sum(s);
        if (h == 0) F.ssq[tok * 16 + head] = s;
      }
    }
    __syncthreads();
}

__device__ __forceinline__ void phase_outproj_simple(Frame& F) {
    const int r = F.lane & 31, h = F.lane >> 5, wm = F.wave >> 1, wn = F.wave & 1;
    constexpr int NPN = D / 128;
    bf16* x1 = F.XB;
    for (int u = F.vcu; u < (M / 256) * NPN; u += F.G) {
        const int pm = u / NPN, pn = u % NPN, m0 = pm * 256 + wm * 64, n0 = pn * 128 + wn * 64;
        const bf16* pa[2] = {F.OB + (size_t)(m0 + r) * D + 8 * h, F.OB + (size_t)(m0 + 32 + r) * D + 8 * h};
        const bf16* pb[2] = {F.WoutT + (size_t)(n0 + r) * D + 8 * h, F.WoutT + (size_t)(n0 + 32 + r) * D + 8 * h};
        float rsd[2], rss[2];
#pragma unroll
        for (int mi = 0; mi < 2; ++mi) { const int m = m0 + 32 * mi + r; float sd = 0.f, ss = 0.f; for (int q = 0; q < 8; ++q) { sd += F.ssq[(size_t)m * 16 + q]; ss += F.ssq[(size_t)m * 16 + 8 + q]; } rsd[mi] = 1.0f / sqrtf(sd * (1.f / DH) + NORM_EPS); rss[mi] = 1.0f / sqrtf(ss * (1.f / DH) + NORM_EPS); }
        f32x16 acc[2][2]; sg_zero<2>(acc);
        sg_mainloop<2>(acc, pa, pb, 0, DH);
#pragma unroll
        for (int ni = 0; ni < 2; ++ni)
#pragma unroll
            for (int mi = 0; mi < 2; ++mi) acc[ni][mi] = acc[ni][mi] * (rsd[mi] / rss[mi]);
        sg_mainloop<2>(acc, pa, pb, DH, D);
        const int b = m0 / SEQ;
#pragma unroll
        for (int ni = 0; ni < 2; ++ni)
#pragma unroll
            for (int mi = 0; mi < 2; ++mi)
#pragma unroll
                for (int g = 0; g < 4; ++g) {
                    const int n = n0 + 32 * ni + 8 * g + 4 * h; const int m = m0 + 32 * mi + r;
                    const f32x4 gate = *(const f32x4*)(F.mod + b * 6144 + 2048 + n), xv = *(const f32x4*)(F.x + (size_t)m * D + n);
                    f32x4 a; a.x = acc[ni][mi][4 * g]; a.y = acc[ni][mi][4 * g + 1]; a.z = acc[ni][mi][4 * g + 2]; a.w = acc[ni][mi][4 * g + 3];
                    const f32x4 rv = xv + gate * (a * rss[mi]); u32x2 w; w.x = pk2(rv.x, rv.y); w.y = pk2(rv.z, rv.w);
                    *(u32x2*)(x1 + (size_t)m * (1 * D) + n) = w;
                }
    }
}

struct RouteOut { int e1, e2; float w1, w2; };
__device__ __forceinline__ RouteOut route_row(Frame& F, const LAS float* WR, const f32x4 (&wgr)[16], const f32x4 (&gs)[4], const f32x4 (&sh)[4], const u32x2 (&xw)[4], size_t m) {
    f32x4 v[4]; float s = 0.f;
#pragma unroll
    for (int j = 0; j < 4; ++j) { v[j].x = __uint_as_float(xw[j].x << 16); v[j].y = __uint_as_float(xw[j].x & 0xffff0000u); v[j].z = __uint_as_float(xw[j].y << 16); v[j].w = __uint_as_float(xw[j].y & 0xffff0000u); }
#pragma unroll
    for (int j = 0; j < 4; ++j) s += (v[j].x * v[j].x + v[j].y * v[j].y) + (v[j].z * v[j].z + v[j].w * v[j].w);
    const float rs = 1.0f / sqrtf(wave_sum(s) * (1.f / D) + NORM_EPS);
    unsigned long long* o8 = (unsigned long long*)(F.HB + m * D) + F.lane;
    typedef float f32x2 __attribute__((ext_vector_type(2)));
    f32x2 g01 = {0.f, 0.f}, g23 = {0.f, 0.f};
#pragma unroll
    for (int j = 0; j < 4; ++j) { v[j] = v[j] * rs * gs[j] + sh[j];
        o8[64 * j] = (unsigned long long)pk2(v[j].x, v[j].y) | ((unsigned long long)pk2(v[j].z, v[j].w) << 32);
#pragma unroll
        for (int i = 0; i < 4; ++i) { const f32x4 w = wgr[j * 4 + i]; const f32x2 hv = {v[j][i], v[j][i]};
            g01 += hv * (f32x2){w.x, w.y}; g23 += hv * (f32x2){w.z, w.w}; } }
    float gl[4] = {g01.x, g01.y, g23.x, g23.y};
    wave_sum4(gl);
    int grp = 0; float gmax = gl[0];
#pragma unroll
    for (int i = 1; i < 4; ++i) if (gl[i] > gmax) { gmax = gl[i]; grp = i; }
    float gden = 0.f;
#pragma unroll
    for (int i = 0; i < 4; ++i) gden += __expf(gl[i] - gmax);
    const float ggate = 1.0f / gden;
    grp = __builtin_amdgcn_readfirstlane(grp);
    f32x2 e01 = {0.f, 0.f}, e23 = {0.f, 0.f}, e45 = {0.f, 0.f}, e67 = {0.f, 0.f};
    const int sw = (F.lane >> 1) & 7;
#pragma unroll
    for (int j = 0; j < 4; ++j)
#pragma unroll
        for (int i = 0; i < 4; ++i) { const LAS float* wp = WR + ((j * 4 + i) * 64 + F.lane) * 32; const f32x4 w0 = *(const LAS f32x4*)(wp + 4 * ((2 * grp) ^ sw)), w1 = *(const LAS f32x4*)(wp + 4 * ((2 * grp + 1) ^ sw)); const f32x2 hv = {v[j][i], v[j][i]};
            e01 += hv * (f32x2){w0.x, w0.y}; e23 += hv * (f32x2){w0.z, w0.w}; e45 += hv * (f32x2){w1.x, w1.y}; e67 += hv * (f32x2){w1.z, w1.w}; }
    float el[8] = {e01.x, e01.y, e23.x, e23.y, e45.x, e45.y, e67.x, e67.y};
    wave_sum8(el);
    int i1 = 0; float l1 = el[0];
#pragma unroll
    for (int i = 1; i < 8; ++i) if (el[i] > l1) { l1 = el[i]; i1 = i; }
    int i2 = -1; float l2 = -INFINITY;
#pragma unroll
    for (int i = 0; i < 8; ++i) if (i != i1 && el[i] > l2) { l2 = el[i]; i2 = i; }
    if (i2 < 0) i2 = (i1 + 1) & 7;
    const float p2 = 1.0f / (1.0f + __expf(l1 - l2)), p1 = 1.0f - p2;
    RouteOut o; o.e1 = grp * 8 + i1; o.e2 = grp * 8 + i2; o.w1 = ggate * p1; o.w2 = ggate * p2; return o;
}
constexpr int RT_BYTES = 1024 * 32 * 4, CONV_SCR = 64 * 33 * 4;
constexpr int N_PRE_ITEMS = 16 * 96 + 16 * 32, N_ALL_ITEMS = N_PRE_ITEMS + NE * (2 * 16 * 16 + 8 * 32);
static_assert(RT_BYTES + 3 * CONV_SCR <= LDS_MAIN, "router table + copy tiles");
__device__ __forceinline__ void router_fill(Frame& F) {
    LAS float* WR = (LAS float*)F.lds;
    {
        f32x4 we[16];
#pragma unroll
        for (int u = 0; u < 16; ++u) we[u] = ((const f32x4*)F.w_expert)[F.tid + u * NTHREADS];
#pragma unroll
        for (int u = 0; u < 16; ++u) { const int i = F.tid + u * NTHREADS, k = i >> 3, c4 = i & 7; const int slot = ((k >> 8) * 4 + (k & 3)) * 64 + ((k >> 2) & 63);
            *(LAS f32x4*)(WR + slot * 32 + 4 * (c4 ^ ((slot >> 1) & 7))) = we[u]; }
    }
}
__device__ __forceinline__ void phase_router(Frame& F, bool dry, bool prefilled = false) {
    LAS float* WR = (LAS float*)F.lds;
    if (!prefilled) router_fill(F);
    __syncthreads();
    const bf16* x1 = F.XB;
    const int NRW = F.G * 4;
    bool copies_done = false;
    for (int c0 = 0; c0 < M / 64; c0 += NRW) {
        const int c64 = c0 + F.vcu * 4 + (F.wave & 3); const bool have = (F.wave < 4) && (c64 < M / 64);
        int my_e1 = 0, my_e2 = 0; float my_w1 = 0.f, my_w2 = 0.f;
        if (have) {
            const int b = c64 / (SEQ / 64);
            f32x4 wgr[16];
#pragma unroll
            for (int q = 0; q < 16; ++q) wgr[q] = ((const f32x4*)F.w_group)[256 * (q >> 2) + 4 * F.lane + (q & 3)];
            f32x4 gs[4], sh[4];
#pragma unroll
            for (int j = 0; j < 4; ++j) { const int col = 4 * F.lane + 256 * j;
                const f32x4 g = *(const f32x4*)(F.g_ffn + col), scl = *(const f32x4*)(F.mod + b * 6144 + 4096 + col); sh[j] = *(const f32x4*)(F.mod + b * 6144 + 3072 + col);
                gs[j] = g * (scl + 1.0f); }
            u32x2 vnA[4], vnB[4];
            { const u32x2* xa = (const u32x2*)(x1 + (size_t)c64 * 64 * (1 * D)) + F.lane; const u32x2* xb = xa + 32 * (1 * D) / 4;
#pragma unroll
              for (int j = 0; j < 4; ++j) { vnA[j] = __builtin_nontemporal_load(&xa[64 * j]); vnB[j] = __builtin_nontemporal_load(&xb[64 * j]); } }
            __builtin_amdgcn_s_waitcnt(0x0F70);
            for (int rr = 0; rr < 32; ++rr) {
                const size_t mA = (size_t)c64 * 64 + rr, mB = mA + 32;
                u32x2 cA[4], cB[4];
#pragma unroll
                for (int j = 0; j < 4; ++j) { cA[j] = vnA[j]; cB[j] = vnB[j]; }
                if (rr < 31) { const u32x2* xa = (const u32x2*)(x1 + (mA + 1) * (1 * D)) + F.lane; const u32x2* xb = (const u32x2*)(x1 + (mB + 1) * (1 * D)) + F.lane;
#pragma unroll
                    for (int j = 0; j < 4; ++j) { vnA[j] = __builtin_nontemporal_load(&xa[64 * j]); vnB[j] = __builtin_nontemporal_load(&xb[64 * j]); } }
                const RouteOut ra = route_row(F, WR, wgr, gs, sh, cA, mA), rb = route_row(F, WR, wgr, gs, sh, cB, mB);
                if (F.lane == rr) { my_e1 = ra.e1; my_e2 = ra.e2; my_w1 = ra.w1; my_w2 = ra.w2; }
                if (F.lane == rr + 32) { my_e1 = rb.e1; my_e2 = rb.e2; my_w1 = rb.w1; my_w2 = rb.w2; }
            }
        } else if (F.wave >= 4 && F.wave < 7 && !copies_done) {
            copies_done = true;
            weights_items<2>(F, (LAS float*)(F.lds + RT_BYTES + (F.wave - 4) * CONV_SCR), F.vcu * 3 + (F.wave - 4), NE * 512, F.G * 3);
        }
        if (!dry) {
            volatile LAS unsigned* lcnt = F.MISC + 64; volatile LAS unsigned* lbase = F.MISC + 96;
            if (F.tid < 32) lcnt[F.tid] = 0u;
            __syncthreads();
            int lp1 = 0, lp2 = 0;
            if (have) { lp1 = (int)__hip_atomic_fetch_add((LAS unsigned*)(F.MISC + 64) + my_e1, 1u, __ATOMIC_RELAXED, __HIP_MEMORY_SCOPE_WORKGROUP); lp2 = (int)__hip_atomic_fetch_add((LAS unsigned*)(F.MISC + 64) + my_e2, 1u, __ATOMIC_RELAXED, __HIP_MEMORY_SCOPE_WORKGROUP); }
            __syncthreads();
            if (F.tid < 32) { const unsigned n = lcnt[F.tid]; lbase[F.tid] = n ? atomicAdd(F.cnt + 64 * F.tid, n) : 0u; }
            __syncthreads();
            if (have) {
                const int m = c64 * 64 + F.lane;
                const int pos1 = (int)lbase[my_e1] + lp1, pos2 = (int)lbase[my_e2] + lp2;
                F.list[(size_t)my_e1 * LIST_CAP + pos1] = m; F.list[(size_t)my_e2 * LIST_CAP + pos2] = m;
                i32x4 ts; ts.x = my_e1; ts.y = pos1; ts.z = my_e2; ts.w = pos2; F.tokslot[m] = ts;
                F.tokw[2 * m] = my_w1; F.tokw[2 * m + 1] = my_w2;
            }
            __syncthreads();
        }
    }
}

__device__ __forceinline__ void build_tiles(Frame& F) {
    __syncthreads();
    if (F.tid < 64) {
        const unsigned cntv = (F.lane < NE) ? __hip_atomic_load(F.cnt + 64 * F.lane, __ATOMIC_RELAXED, __HIP_MEMORY_SCOPE_AGENT) : 0u;
        const unsigned n = (cntv + 255u) >> 8;
        unsigned incl = n;
#pragma unroll
        for (int d = 1; d < 32; d <<= 1) { const unsigned t = __shfl_up(incl, d); if (F.lane >= d) incl += t; }
        if (F.lane < NE) { F.MISC[F.lane] = incl - n; F.MISC[128 + F.lane] = cntv; }
        if (F.lane == NE - 1) F.MISC[NE] = incl;
    }
    __syncthreads();
}
__device__ __forceinline__ int find_expert(Frame& F, int tile) { int e = 0;
#pragma unroll 1
    for (int i = 1; i < NE; ++i) if ((int)F.MISC[i] <= tile) e = i; else break;
    return e; }

__device__ __forceinline__ void phase_moe1_simple(Frame& F) {
    build_tiles(F);
    const int r = F.lane & 31, h = F.lane >> 5, wm = F.wave >> 1, wn = F.wave & 1;
    const int T = (int)F.MISC[NE];
    for (int u = F.vcu; u < T * 8; u += F.G) {
        const int tile = u >> 3, cn = u & 7, e = find_expert(F, tile), jt = tile - (int)F.MISC[e];
        const int cnt = (int)__hip_atomic_load(F.cnt + 64 * e, __ATOMIC_RELAXED, __HIP_MEMORY_SCOPE_AGENT);
        const bf16* pa[2];
#pragma unroll
        for (int mi = 0; mi < 2; ++mi) { const int pos = jt * 256 + wm * 64 + 32 * mi + r; const int tok = (pos < cnt) ? F.list[(size_t)e * LIST_CAP + pos] : 0; pa[mi] = F.HB + (size_t)tok * D + 8 * h; }
        const int j0 = cn * 64 + wn * 32, jj = j0 + r;
        const bf16* Wb = F.WguT + (size_t)e * D * D;
        const bf16* pb[2] = {Wb + (size_t)(8 * (jj >> 2) + (jj & 3)) * D + 8 * h, Wb + (size_t)(8 * (jj >> 2) + 4 + (jj & 3)) * D + 8 * h};
        f32x16 acc[2][2]; sg_zero<2>(acc);
        sg_mainloop<2>(acc, pa, pb, 0, D);
#pragma unroll
        for (int mi = 0; mi < 2; ++mi)
#pragma unroll
            for (int g = 0; g < 4; ++g) {
                const size_t row = (size_t)tile * 256 + wm * 64 + 32 * mi + r; const int col = j0 + 8 * g + 4 * h;
                float hv[4];
#pragma unroll
                for (int i = 0; i < 4; ++i) { const float ga = acc[0][mi][4 * g + i], up = acc[1][mi][4 * g + i]; hv[i] = ga / (1.0f + __expf(-ga)) * up; }
                u32x2 w; w.x = pk2(hv[0], hv[1]); w.y = pk2(hv[2], hv[3]);
                *(u32x2*)(F.HM + row * DFF + col) = w;
            }
    }
}
__device__ __forceinline__ void phase_moe2_simple(Frame& F) {
    build_tiles(F);
    const int r = F.lane & 31, h = F.lane >> 5, wm = F.wave >> 1, wn = F.wave & 1;
    const int T = (int)F.MISC[NE];
    for (int u = F.vcu; u < T * 8; u += F.G) {
        const int tile = u >> 3, pn = u & 7, e = find_expert(F, tile);
        const size_t row0 = (size_t)tile * 256 + wm * 64; const int n0 = pn * 128 + wn * 64;
        const bf16* pa[2] = {F.HM + (row0 + r) * DFF + 8 * h, F.HM + (row0 + 32 + r) * DFF + 8 * h};
        const bf16* Wb = F.WdT + (size_t)e * D * DFF;
        const bf16* pb[2] = {Wb + (size_t)(n0 + r) * DFF + 8 * h, Wb + (size_t)(n0 + 32 + r) * DFF + 8 * h};
        f32x16 acc[2][2]; sg_zero<2>(acc);
        sg_mainloop<2>(acc, pa, pb, 0, DFF);
#pragma unroll
        for (int ni = 0; ni < 2; ++ni)
#pragma unroll
            for (int mi = 0; mi < 2; ++mi)
#pragma unroll
                for (int g = 0; g < 4; ++g) {
                    const size_t row = row0 + 32 * mi + r; const int n = n0 + 32 * ni + 8 * g + 4 * h;
                    u32x2 w; w.x = pk2(acc[ni][mi][4 * g], acc[ni][mi][4 * g + 1]); w.y = pk2(acc[ni][mi][4 * g + 2], acc[ni][mi][4 * g + 3]);
                    *(u32x2*)(F.YB + row * D + n) = w;
                }
    }
}
__device__ __forceinline__ void phase_final(Frame& F, bool dry, bool have_tiles = false) {
    if (!have_tiles) build_tiles(F);
    const int gw = F.vcu * NWAVES + F.wave, NGW = F.G * NWAVES;
    for (int ch = gw; ch < M / 32; ch += NGW) {
        const int b = ch / (SEQ / 32);
        f32x4 gate[4], gf[4];
#pragma unroll
        for (int j = 0; j < 4; ++j) { const int col = 4 * F.lane + 256 * j; gate[j] = *(const f32x4*)(F.mod + b * 6144 + 5120 + col); gf[j] = *(const f32x4*)(F.g_final + col); }
        for (int rr = 0; rr < 32; ++rr) {
            const size_t m = (size_t)ch * 32 + rr;
            const i32x4 ts = F.tokslot[m]; const float w1 = F.tokw[2 * m], w2 = F.tokw[2 * m + 1];
            const size_t ra = (size_t)F.MISC[ts.x] * 256 + ts.y, rb = (size_t)F.MISC[ts.z] * 256 + ts.w;
            f32x4* xr = (f32x4*)(F.out + m * D) + F.lane; const u32x2* xb = (const u32x2*)(F.XB + m * D) + F.lane;
            f32x4 v[4]; float s = 0.f; u32x2 xw[4];
#pragma unroll
            for (int j = 0; j < 4; ++j) xw[j] = __builtin_nontemporal_load(&xb[64 * j]);
#pragma unroll
            for (int j = 0; j < 4; ++j) { const int col = 4 * F.lane + 256 * j;
                const f32x4 ya = ld_bf4(F.YB + ra * D + col), yb = ld_bf4(F.YB + rb * D + col);
                f32x4 xv; xv.x = __uint_as_float(xw[j].x << 16); xv.y = __uint_as_float(xw[j].x & 0xffff0000u); xv.z = __uint_as_float(xw[j].y << 16); xv.w = __uint_as_float(xw[j].y & 0xffff0000u);
                v[j] = xv + gate[j] * (ya * w1 + yb * w2);
                s += (v[j].x * v[j].x + v[j].y * v[j].y) + (v[j].z * v[j].z + v[j].w * v[j].w); }
            const float rs = 1.0f / sqrtf(wave_sum(s) * (1.f / D) + NORM_EPS);
            f32x4* wr_ = dry ? ((f32x4*)((float*)(F.ws + WS_H) + (m & 16383) * D) + F.lane) : xr;
#pragma unroll
            for (int j = 0; j < 4; ++j) __builtin_nontemporal_store(v[j] * rs * gf[j], &wr_[64 * j]);
        }
    }
}

__device__ __forceinline__ void phase_qkv_fast(Frame& F) {
    pg8::Gemm g{F.HB, F.WinT, D}; pg8::StaticOrder S; S.init(M, 3 * D, F.G, (int)blockIdx.x);
    pg8::EpiQKV E{F.QKV};
    pg8::gemm_phase<pg8::EpiQKV, pg8::StaticOrder, 0>(F.lds, g, S, E);
}
__device__ __forceinline__ void phase_outproj_fast(Frame& F) {
    pg8::StaticOrder S; S.init(M, D, F.G, (int)blockIdx.x);
    LAS float* side = (LAS float*)(F.lds + pg8::SIDE_OFF);
    { f32x4 q[4][4]; unsigned okm = 0u; const int hsel = F.tid >> 8, row = F.tid & 255;
#pragma unroll
      for (int k = 0; k < 4; ++k) { pg8::Unit u; u.pm = 0; u.pn = 0; u.pb = 0; u.li = 0; const bool ok = S.next(2 * k + hsel, u); okm |= ok ? (1u << k) : 0u;
          const float* sp = F.ssq + (size_t)((ok ? u.pm : 0) * 256 + row) * 16;
#pragma unroll
          for (int j = 0; j < 4; ++j) q[k][j] = *(const f32x4*)(sp + 4 * j); }
#pragma unroll
      for (int k = 0; k < 4; ++k) if ((okm >> k) & 1u) { const int i = 2 * k + hsel; const f32x4 q0 = q[k][0], q1 = q[k][1], q2 = q[k][2], q3 = q[k][3];
          const float sd = ((q0.x + q0.y) + (q0.z + q0.w)) + ((q1.x + q1.y) + (q1.z + q1.w)), ss = ((q2.x + q2.y) + (q2.z + q2.w)) + ((q3.x + q3.y) + (q3.z + q3.w));
          const float rsd = 1.0f / sqrtf(sd * (1.f / DH) + NORM_EPS), rss = 1.0f / sqrtf(ss * (1.f / DH) + NORM_EPS);
          side[(i * 256 + row) * 2] = rsd / rss; side[(i * 256 + row) * 2 + 1] = rss; } }
    __syncthreads();
    pg8::Gemm g{F.OB, F.WoutT, D};
    pg8::EpiOutProj E{F.x, F.XB, F.mod, (const LAS float*)side};
    pg8::gemm_phase<pg8::EpiOutProj, pg8::StaticOrder, 2>(F.lds, g, S, E);
}
struct PanelOrder {
    int G, c;
    __device__ __forceinline__ bool next(int i, pg8::Unit& u) const { const int pm = c + (i >> 2) * G; if (pm >= M / 256) return false; u.pm = pm; u.pn = i & 3; u.pb = u.pn; u.li = i; return true; }
};
__device__ __forceinline__ void phase_outproj_router(Frame& F, bool dry) {
    PanelOrder S{F.G, (int)blockIdx.x};
    LAS float* side = (LAS float*)(F.lds + pg8::SIDE_OFF);
    { f32x4 q[4][4]; unsigned okm = 0u; const int hsel = F.tid >> 8, row = F.tid & 255;
#pragma unroll
      for (int k = 0; k < 4; ++k) { pg8::Unit u; u.pm = 0; u.pn = 0; u.pb = 0; u.li = 0; const bool ok = S.next(2 * k + hsel, u); okm |= ok ? (1u << k) : 0u;
          const float* sp = F.ssq + (size_t)((ok ? u.pm : 0) * 256 + row) * 16;
#pragma unroll
          for (int j = 0; j < 4; ++j) q[k][j] = *(const f32x4*)(sp + 4 * j); }
#pragma unroll
      for (int k = 0; k < 4; ++k) if ((okm >> k) & 1u) { const int i = 2 * k + hsel; const f32x4 q0 = q[k][0], q1 = q[k][1], q2 = q[k][2], q3 = q[k][3];
          const float sd = ((q0.x + q0.y) + (q0.z + q0.w)) + ((q1.x + q1.y) + (q1.z + q1.w)), ss = ((q2.x + q2.y) + (q2.z + q2.w)) + ((q3.x + q3.y) + (q3.z + q3.w));
          const float rsd = 1.0f / sqrtf(sd * (1.f / DH) + NORM_EPS), rss = 1.0f / sqrtf(ss * (1.f / DH) + NORM_EPS);
          side[(i * 256 + row) * 2] = rsd / rss; side[(i * 256 + row) * 2 + 1] = rss; } }
    __syncthreads();
    pg8::Gemm g{F.OB, F.WoutT, D};
    pg8::EpiOutProj E{F.x, F.XB, F.mod, (const LAS float*)side};
    pg8::gemm_phase<pg8::EpiOutProj, PanelOrder, 2>(F.lds, g, S, E);
    asm volatile("s_waitcnt vmcnt(0)" ::: "memory");
    __syncthreads();
    phase_router(F, dry);
}
struct MoeOrder {
    const volatile LAS unsigned* ts; int T4, G, c; bool rev;
    __device__ __forceinline__ bool next(int i, pg8::Unit& u) const {
        const int L0 = i * G + c; const bool ok = L0 < T4;
        const int L = ok ? (rev ? (T4 - 1 - L0) : L0) : 0;
        const int tile = L >> 2, pn = L & 3, lane = (int)(threadIdx.x & 63);
        const int e = __popcll(__ballot((lane < NE) && ((int)ts[lane & (NE - 1)] <= tile))) - 1;
        u.pm = tile; u.pn = pn; u.pb = e * 4 + pn; u.li = i; return ok;
    }
};
__device__ __forceinline__ void phase_moe1_fast(Frame& F) {
    build_tiles(F);
    MoeOrder S{F.MISC, 4 * (int)F.MISC[NE], F.G, F.vcu, false};
    LAS int* idxtab = (LAS int*)(F.lds + pg8::SIDE_OFF);
    int vals[16]; unsigned okmask = 0u;
#pragma unroll
    for (int i = 0; i < 16; ++i) { pg8::Unit u; const bool ok = S.next(i, u); okmask |= ok ? (1u << i) : 0u;
        const int e = u.pb >> 2, jt = u.pm - (int)F.MISC[e], cnt = ok ? (int)F.MISC[128 + e] : 0;
        const int pos = jt * 256 + (F.tid & 255), posc = pos < 0 ? 0 : (pos < LIST_CAP ? pos : LIST_CAP - 1);
        const int idx = F.list[(size_t)e * LIST_CAP + posc];
        vals[i] = (pos < cnt) ? idx : 0; }
#pragma unroll
    for (int i = 0; i < 16; ++i) if (((okmask >> i) & 1u) && F.tid < 256) idxtab[i * 256 + F.tid] = vals[i];
    __syncthreads();
    pg8::Gemm g{F.HB, F.WguT, D};
    pg8::EpiSwiGLU E{F.HM};
    pg8::gemm_phase<pg8::EpiSwiGLU, MoeOrder, 1>(F.lds, g, S, E);
    { const int T4 = S.T4, rmax = (T4 + F.G - 1) / F.G, rem = T4 - (rmax > 0 ? rmax - 1 : 0) * F.G;
      const int c0 = (rem <= 0 || rem >= F.G) ? 0 : rem, ni = F.G - c0;
      if (F.vcu >= c0) weights_items<1>(F, (LAS float*)(F.lds + F.wave * 16384), (F.vcu - c0) * NWAVES + F.wave, NE * 256, ni * NWAVES); }
}
__device__ __forceinline__ void phase_moe2_fast(Frame& F, bool have_tiles = false) {
    if (!have_tiles) build_tiles(F);
    MoeOrder S{F.MISC, 4 * (int)F.MISC[NE], F.G, F.vcu, true};
    pg8::Gemm g{F.HM, F.WdT, DFF};
    pg8::EpiY E{F.YB, D};
    pg8::gemm_phase<pg8::EpiY, MoeOrder, 0>(F.lds, g, S, E);
}

constexpr int N_PHASES = 9;
struct Args { const float* in[16]; float* out; unsigned char* ws; int ph_lo, ph_hi; };
__global__ void __launch_bounds__(NTHREADS, 2) mk_fwd(Args args) {
    extern __shared__ __attribute__((aligned(16))) unsigned char lds[];
    Frame F;
    F.lds = (LAS unsigned char*)lds; F.MISC = (volatile LAS unsigned*)(F.lds + MISC_OFF);
    F.tid = threadIdx.x; F.lane = F.tid & 63; F.wave = __builtin_amdgcn_readfirstlane(F.tid >> 6);
    F.G = gridDim.x; { const int bx = blockIdx.x; F.vcu = (F.G % 8 == 0) ? (bx % 8) * (F.G / 8) + bx / 8 : bx; }
    unsigned char* ws = args.ws; F.ws = ws; F.ctl = (unsigned*)(ws + WS_CTL);
    F.x = args.in[0]; F.c = args.in[1]; F.w_ada = args.in[2]; F.b_ada = args.in[3]; F.g_mix = args.in[4]; F.w_in = args.in[5]; F.g_dil = args.in[6]; F.g_sb = args.in[7];
    F.w_out = args.in[8]; F.g_ffn = args.in[9]; F.w_group = args.in[10]; F.w_expert = args.in[11]; F.w_gate = args.in[12]; F.w_up = args.in[13]; F.w_down = args.in[14]; F.g_final = args.in[15];
    F.out = args.out;
    F.mod = (float*)(ws + WS_MOD); F.WinT = (bf16*)(ws + WS_WIN); F.WoutT = (bf16*)(ws + WS_WOUT); F.WguT = (bf16*)(ws + WS_WGU); F.WdT = (bf16*)(ws + WS_WD);
    F.HB = (bf16*)(ws + WS_H); F.QKV = (bf16*)(ws + WS_QKV); F.OB = (bf16*)(ws + WS_O); F.HM = (bf16*)(ws + WS_PART); F.YB = (bf16*)(ws + WS_QKV); F.XB = (bf16*)(ws + WS_X1);
    F.list = (int*)(ws + WS_LIST); F.tokslot = (i32x4*)(ws + WS_TOKSLOT); F.tokw = (float*)(ws + WS_TOKW); F.ssq = (float*)(ws + WS_SSQP); F.cnt = F.ctl + CW_CNT;
    for (int u = F.tid; u < 64; u += NTHREADS) F.MISC[u] = 0u;
    __syncthreads();
    const int lo = args.ph_lo, hi = args.ph_hi;
    XcdBarrier bar; bar.bar = F.ctl + CW_BAR; bar.x = 0; bar.st = nullptr;
    if (hi - lo > 1) bar = xcd_barrier_post(F.ctl + CW_BAR, F.MISC + 40);
    const unsigned xcc = xb_xcc_id();
    if (F.tid == 0 && (xcc != (unsigned)(blockIdx.x & 7) || F.G != 256)) atomicOr(F.ctl + CW_IRREG, 1u);
    bool regular = false;
#define IN(k) (lo <= (k) && (k) < hi)
#define SEAM(k) do { if (IN(k) && IN((k) + 1)) { \
        if (PROBE_PHASE == 201) { asm volatile("s_waitcnt vmcnt(0)" ::: "memory"); __syncthreads(); if (F.tid == 0) atomicMax((unsigned long long*)(F.ctl + 1024) + 8 * (k), (unsigned long long)__builtin_amdgcn_s_memrealtime()); } \
        xcd_barrier(bar); if (PROBE_PHASE == 200) xcd_barrier(bar); \
        if (PROBE_PHASE == 201) { const unsigned long long la_ = __hip_atomic_load((unsigned long long*)(F.ctl + 1024) + 8 * (k), __ATOMIC_RELAXED, __HIP_MEMORY_SCOPE_AGENT); const unsigned long long t1_ = __builtin_amdgcn_s_memrealtime(); \
            while (__builtin_amdgcn_s_memrealtime() - t1_ < t1_ - la_) __builtin_amdgcn_s_sleep(8); } } } while (0)
#define SEAMG(k) do { if (IN(k) && IN((k) + 1)) { if (regular) group_barrier(F.ctl, xcc, 32u); else xcd_barrier(bar); } } while (0)
#define RPT(k) (PROBE_PHASE == (k))
#define TMD(k, call) do { if (PROBE_PHASE == 100 + (k)) { const unsigned long long t0_ = __builtin_amdgcn_s_memrealtime(); call; asm volatile("s_waitcnt vmcnt(0)" ::: "memory"); const unsigned long long t1_ = __builtin_amdgcn_s_memrealtime(); \
        while (__builtin_amdgcn_s_memrealtime() - t1_ < t1_ - t0_) __builtin_amdgcn_s_sleep(8); } else { call; } } while (0)
    if (IN(0)) { TMD(0, phase_p0(F)); if (RPT(0)) { phase_p0(F); } } SEAM(0);
    if (IN(0) && IN(1) && IN(5) && FAST_QKV && FAST_OUT && FAST_ATTN == 2 && DIL_PIPE && !FUSE_OUT_ROUTER) {
        if (F.tid == 0) F.MISC[44] = xb_ld(F.ctl + CW_IRREG);
        __syncthreads();
        regular = (F.MISC[44] == 0u);
    }
    if (IN(1)) { TMD(1, phase_h(F)); if (RPT(1)) phase_h(F); } SEAMG(1);
    if (IN(2)) { { TMD(2, phase_qkv_fast(F)); if (RPT(2)) phase_qkv_fast(F); } } SEAMG(2);
    if (IN(3)) { if (RPT(3)) { phase_attn_a(F, true); phase_attn_b(F, true); } if (RPT(31)) phase_attn_a(F, true); if (RPT(36)) phase_attn_a(F, true, true); if (RPT(32)) phase_attn_b(F, true); TMD(31, phase_attn_a(F, false)); if (regular) group_barrier(F.ctl, xcc, 32u); else xcd_barrier(bar); TMD(32, phase_attn_b(F, false)); } SEAMG(3);
    if (FUSE_OUT_ROUTER) { if (IN(4)) { if (RPT(4)) phase_outproj_router(F, true); phase_outproj_router(F, false); } if (IN(4) && IN(6)) xcd_barrier(bar); }
    else {
    const bool rt_pre = IN(4) && IN(5);
    if (IN(4)) { if (FAST_OUT) { TMD(4, phase_outproj_fast(F)); if (RPT(4)) phase_outproj_fast(F); } else phase_outproj_simple(F); }
    if (rt_pre) { __syncthreads(); router_fill(F); }
    SEAMG(4);
    if (IN(5)) { if (RPT(5)) phase_router(F, true, rt_pre); TMD(5, phase_router(F, false, rt_pre)); } SEAM(5);
    }
    if (IN(6)) { if (FAST_MOE1) { TMD(6, phase_moe1_fast(F)); if (RPT(6)) phase_moe1_fast(F); } else phase_moe1_simple(F); } SEAM(6);
    if (IN(7)) { if (FAST_MOE2) { TMD(7, phase_moe2_fast(F, IN(6) && FAST_MOE1)); if (RPT(7)) phase_moe2_fast(F, IN(6) && FAST_MOE1); } else phase_moe2_simple(F); } SEAM(7);
    if (IN(8)) { if (RPT(8)) phase_final(F, true, IN(6) && FAST_MOE1); TMD(8, phase_final(F, false, IN(6) && FAST_MOE1)); }
#undef RPT
#undef TMD
#undef IN
#undef SEAM
}

extern "C" void kernel_launch(void* const* d_in, const int* in_sizes, int n_in, void* d_out, int out_size, void* d_ws, size_t ws_size, hipStream_t stream) {
    static int grid = 0;
    if (grid == 0) {
        if (n_in != 16 || in_sizes[0] != M * D || out_size != M * D || ws_size < WS_END) { fprintf(stderr, "kernel_launch: unexpected shapes / workspace (n_in %d, ws %zu)\n", n_in, ws_size); grid = -1; return; }
        int dev = 0, cus = 0;
        if (hipGetDevice(&dev) != hipSuccess || hipDeviceGetAttribute(&cus, hipDeviceAttributeMultiprocessorCount, dev) != hipSuccess) { grid = -1; return; }
        if (hipFuncSetAttribute((const void*)mk_fwd, hipFuncAttributeMaxDynamicSharedMemorySize, LDS_BYTES) != hipSuccess) { fprintf(stderr, "kernel_launch: hipFuncSetAttribute failed\n"); grid = -1; return; }
        int per_cu = 0;
        if (hipOccupancyMaxActiveBlocksPerMultiprocessor(&per_cu, (const void*)mk_fwd, NTHREADS, LDS_BYTES) != hipSuccess || per_cu < 1) fprintf(stderr, "kernel_launch: occupancy query says %d\n", per_cu);
        (void)hipGetLastError();
        grid = cus;
    }
    if (grid < 0) return;
    (void)hipMemsetAsync((char*)d_ws + WS_CTL, 0, CTL_ZERO_BYTES, stream);
    Args a{};
    for (int i = 0; i < 16; ++i) a.in[i] = (const float*)d_in[i];
    a.out = (float*)d_out; a.ws = (unsigned char*)d_ws;
    constexpr int NL = MK_N_LAUNCHES;
    for (int li = 0; li < NL; ++li) {
        a.ph_lo = (NL == N_PHASES) ? li : (li * N_PHASES) / NL; a.ph_hi = (NL == N_PHASES) ? li + 1 : ((li + 1) * N_PHASES) / NL;
        hipLaunchKernelGGL(mk_fwd, dim3(grid), dim3(NTHREADS), LDS_BYTES, stream, a);
    }
}
```
